# Optimizing an MI355X kernel written in HIP

```python
import math
import jax, jax.numpy as jnp
from jax import lax
import numpy as np

D_MODEL = 2048
BATCH = 2
SEQ = 4096
DEPTH = 4

GRID_W = 64
CTX_LEN = 256

FOURIER_GROUPS = 4
FOURIER_GROUP_W = D_MODEL // 16
FOURIER_W = FOURIER_GROUPS * FOURIER_GROUP_W
CONV_W = D_MODEL // 4
N_HEADS = 8
HEAD_DIM = D_MODEL // (4 * N_HEADS)
VAL_DIM = 2 * HEAD_DIM
ATTN_QK_W = N_HEADS * 2 * HEAD_DIM
ATTN_V_W = N_HEADS * VAL_DIM
ROPE_THETA = 10000.0
Q_BLOCK = 128
ATTN_SCALE = HEAD_DIM ** -0.5
SUBLN_EPS = 1e-5
N_BRANCH = 3
Q_OFF = FOURIER_W + 3 * CONV_W
K_OFF = Q_OFF + ATTN_QK_W
V_END = K_OFF + ATTN_QK_W + ATTN_V_W
N_IN = V_END + N_BRANCH * D_MODEL
D_FF = ((8 * D_MODEL // 3 + 255) // 256) * 256
EPS = 1e-6

kernel_name = "hybrid_fourier_shortconv_diffattn_prefix_dit"


def rmsnorm(x, g, eps=EPS):
    xf = x.astype(jnp.float32)
    y = xf * lax.rsqrt(jnp.mean(xf * xf, axis=-1, keepdims=True) + eps)
    return (y * g.astype(jnp.float32)).astype(x.dtype)


def modulate(x, shift, scale):
    return x * (1.0 + scale) + shift


def dwconv3(x, w):
    xp = jnp.pad(x, ((0, 0), (1, 1), (0, 0)))
    return xp[:, :-2] * w[0] + xp[:, 1:-1] * w[1] + xp[:, 2:] * w[2]


def split_in(p):
    sizes = (FOURIER_W, CONV_W, CONV_W, CONV_W, ATTN_QK_W, ATTN_QK_W, ATTN_V_W,
             D_MODEL, D_MODEL, D_MODEL)
    return jnp.split(p, [int(s) for s in np.cumsum(sizes)[:-1]], axis=-1)


def fourier_mix(u):
    b, l, _ = u.shape
    ug = u.reshape(b, l, FOURIER_GROUPS, FOURIER_GROUP_W).astype(jnp.float32)
    f = jnp.fft.fft2(ug, axes=(1, 3), norm="ortho")
    return jnp.real(f).reshape(b, l, FOURIER_W).astype(u.dtype)


def axial_rope_tables(length):
    rows = length // GRID_W
    row = jnp.repeat(jnp.arange(rows), GRID_W).astype(jnp.float32)
    col = jnp.tile(jnp.arange(GRID_W), rows).astype(jnp.float32)
    n_freq = HEAD_DIM // 4
    inv = ROPE_THETA ** (-(2.0 * jnp.arange(n_freq, dtype=jnp.float32)) / (HEAD_DIM // 2))
    ang = jnp.stack([row[:, None] * inv, col[:, None] * inv], axis=1)
    return jnp.cos(ang), jnp.sin(ang)


def rope2d(x, cos, sin):
    b, l, h, c, d = x.shape
    xr = x.reshape(b, l, h, c, 2, 2, d // 4).astype(jnp.float32)
    x1, x2 = xr[..., 0, :], xr[..., 1, :]
    cs = cos[None, :, None, None]
    sn = sin[None, :, None, None]
    out = jnp.stack([x1 * cs - x2 * sn, x2 * cs + x1 * sn], axis=-2)
    return out.reshape(b, l, h, c, d).astype(x.dtype)


def diff_lambda(lam, lam_init):
    lf = lam.astype(jnp.float32)
    return jnp.exp(jnp.sum(lf[0] * lf[1])) - jnp.exp(jnp.sum(lf[2] * lf[3])) + lam_init


def diff_attend(q, k, v, lam, subln_g, lam_init):
    s = jnp.einsum('bqhcd,bkhcd->bhcqk', q.astype(jnp.float32), k.astype(jnp.float32)) * ATTN_SCALE
    p = jax.nn.softmax(s, axis=-1)
    a = p[:, :, 0] - lam * p[:, :, 1]
    o = jnp.einsum('bhqk,bkhe->bqhe', a, v.astype(jnp.float32))
    o = o * lax.rsqrt(jnp.mean(o * o, axis=-1, keepdims=True) + SUBLN_EPS)
    o = o * subln_g.astype(jnp.float32) * (1.0 - lam_init)
    return o.reshape(o.shape[0], o.shape[1], N_HEADS * VAL_DIM).astype(v.dtype)


def diff_attend_blocks(q, k, v, lam, subln_g, lam_init):
    b, l = q.shape[0], q.shape[1]
    nblk = l // Q_BLOCK
    qb = q.reshape(b, nblk, Q_BLOCK, N_HEADS, 2, HEAD_DIM).transpose(1, 0, 2, 3, 4, 5)
    ob = lax.map(lambda qq: diff_attend(qq, k, v, lam, subln_g, lam_init), qb)
    return ob.transpose(1, 0, 2, 3).reshape(b, l, N_HEADS * VAL_DIM)


def merge_branches(f_in, cb, cc, cx, attn_o, g_f, g_c, g_a, conv_w, w_bf, w_bc, w_ba, w_o):
    y_f = fourier_mix(f_in) @ w_bf
    y_c = (cb * dwconv3(cc * cx, conv_w)) @ w_bc
    y_a = attn_o @ w_ba
    merged = jax.nn.sigmoid(g_f) * y_f + jax.nn.sigmoid(g_c) * y_c + jax.nn.sigmoid(g_a) * y_a
    return merged @ w_o


def conv_ffn(xm, w_up, conv_w, w_down):
    u = dwconv3(xm @ w_up, conv_w)
    a, v = jnp.split(u, 2, axis=-1)
    return (jax.nn.silu(a) * v) @ w_down


def setup_inputs(seed: int = 0) -> dict:
    key = jax.random.key(seed)
    ks = jax.random.split(key, 20)
    f32 = jnp.float32
    nrm = lambda k, shape, s: jax.random.normal(k, shape, f32) * s
    return {
        "x": nrm(ks[0], (BATCH, SEQ, D_MODEL), 1.0),
        "c": nrm(ks[1], (BATCH, D_MODEL), 1.0),
        "ctx": nrm(ks[2], (BATCH, CTX_LEN, D_MODEL), 1.0),
        "c_ctx": nrm(ks[3], (D_MODEL,), 1.0),
        "w_mod": nrm(ks[4], (DEPTH, D_MODEL, 6 * D_MODEL), 0.5 * D_MODEL ** -0.5),
        "b_mod": nrm(ks[5], (DEPTH, 6 * D_MODEL), 0.01),
        "g_norm1": 1.0 + nrm(ks[6], (DEPTH, D_MODEL), 0.02),
        "g_norm2": 1.0 + nrm(ks[7], (DEPTH, D_MODEL), 0.02),
        "w_in": nrm(ks[8], (DEPTH, D_MODEL, N_IN), D_MODEL ** -0.5),
        "conv_mix_w": nrm(ks[9], (DEPTH, 3, CONV_W), 3 ** -0.5),
        "lambdas": nrm(ks[10], (DEPTH, 4, HEAD_DIM), 0.1),
        "subln_g": 1.0 + nrm(ks[11], (DEPTH, VAL_DIM), 0.02),
        "w_br_fourier": nrm(ks[12], (DEPTH, FOURIER_W, D_MODEL), FOURIER_W ** -0.5),
        "w_br_conv": nrm(ks[13], (DEPTH, CONV_W, D_MODEL), CONV_W ** -0.5),
        "w_br_attn": nrm(ks[14], (DEPTH, ATTN_V_W, D_MODEL), ATTN_V_W ** -0.5),
        "w_out": nrm(ks[15], (DEPTH, D_MODEL, D_MODEL), D_MODEL ** -0.5),
        "w_ffn_up": nrm(ks[16], (DEPTH, D_MODEL, 2 * D_FF), D_MODEL ** -0.5),
        "ffn_conv_w": nrm(ks[17], (DEPTH, 3, 2 * D_FF), 3 ** -0.5),
        "w_ffn_down": nrm(ks[18], (DEPTH, D_FF, D_MODEL), D_FF ** -0.5),
        "g_final": 1.0 + nrm(ks[19], (D_MODEL,), 0.02),
    }


def reference(x, c, ctx, c_ctx, w_mod, b_mod, g_norm1, g_norm2, w_in, conv_mix_w, lambdas,
              subln_g, w_br_fourier, w_br_conv, w_br_attn, w_out, w_ffn_up, ffn_conv_w,
              w_ffn_down, g_final):
    b, l, _ = x.shape
    n_ctx = ctx.shape[1]
    cos, sin = axial_rope_tables(l)
    silu_c = jax.nn.silu(c)
    silu_cc = jax.nn.silu(c_ctx)
    h, hc = x, ctx
    for i in range(DEPTH):
        last = i == DEPTH - 1
        lam_init = 0.8 - 0.6 * math.exp(-0.3 * i)
        lam = diff_lambda(lambdas[i], lam_init)
        sh1, sc1, gt1, sh2, sc2, gt2 = jnp.split((silu_c @ w_mod[i] + b_mod[i])[:, None, :], 6, axis=-1)
        shc1, scc1, gtc1, shc2, scc2, gtc2 = jnp.split(silu_cc @ w_mod[i] + b_mod[i], 6, axis=-1)

        xc = modulate(rmsnorm(hc, g_norm1[i]), shc1, scc1)
        if last:
            kc, vc = jnp.split(xc @ w_in[i][:, K_OFF:V_END], [ATTN_QK_W], axis=-1)
        else:
            fc, cbc, ccc, cxc, qc, kc, vc, gfc, gcc, gac = split_in(xc @ w_in[i])
        kc = kc.reshape(b, n_ctx, N_HEADS, 2, HEAD_DIM)
        vc = vc.reshape(b, n_ctx, N_HEADS, VAL_DIM)

        xl = modulate(rmsnorm(h, g_norm1[i]), sh1, sc1)
        fl, cbl, ccl, cxl, ql, kl, vl, gfl, gcl, gal = split_in(xl @ w_in[i])
        ql = rope2d(ql.reshape(b, l, N_HEADS, 2, HEAD_DIM), cos, sin)
        kl = rope2d(kl.reshape(b, l, N_HEADS, 2, HEAD_DIM), cos, sin)
        k_all = jnp.concatenate([kc, kl], axis=1)
        v_all = jnp.concatenate([vc, vl.reshape(b, l, N_HEADS, VAL_DIM)], axis=1)
        ol = diff_attend_blocks(ql, k_all, v_all, lam, subln_g[i], lam_init)
        h = h + gt1 * merge_branches(fl, cbl, ccl, cxl, ol, gfl, gcl, gal, conv_mix_w[i],
                                     w_br_fourier[i], w_br_conv[i], w_br_attn[i], w_out[i])
        h = h + gt2 * conv_ffn(modulate(rmsnorm(h, g_norm2[i]), sh2, sc2),
                               w_ffn_up[i], ffn_conv_w[i], w_ffn_down[i])

        if not last:
            qc = qc.reshape(b, n_ctx, N_HEADS, 2, HEAD_DIM)
            oc = diff_attend(qc, kc, vc, lam, subln_g[i], lam_init)
            hc = hc + gtc1 * merge_branches(fc, cbc, ccc, cxc, oc, gfc, gcc, gac, conv_mix_w[i],
                                            w_br_fourier[i], w_br_conv[i], w_br_attn[i], w_out[i])
            hc = hc + gtc2 * conv_ffn(modulate(rmsnorm(hc, g_norm2[i]), shc2, scc2),
                                      w_ffn_up[i], ffn_conv_w[i], w_ffn_down[i])
    return rmsnorm(h, g_final)
```

```cpp
#include <hip/hip_runtime.h>
#include <cstdio>
#include <cstdint>

#ifndef MK_ONE_LAUNCH
#define MK_ONE_LAUNCH 1
#endif
#ifndef MK_SIMPLE_GEMM
#define MK_SIMPLE_GEMM 0
#endif
#ifndef MK_FUSE_ACT
#define MK_FUSE_ACT (!MK_SIMPLE_GEMM)
#endif
#ifndef MK_FFT
#define MK_FFT (!MK_SIMPLE_GEMM)
#endif
#ifndef PROBE_STEP
#define PROBE_STEP (-1)
#endif
#ifndef PROBE_REP
#define PROBE_REP 1
#endif
#ifndef MK_SIMPLE_ATTN
#define MK_SIMPLE_ATTN 0
#endif

#define LAS __attribute__((address_space(3)))
#define GAS __attribute__((address_space(1)))
typedef unsigned short bf16;
typedef short bf16x8 __attribute__((ext_vector_type(8)));
typedef float f32x4 __attribute__((ext_vector_type(4)));
typedef float f32x16 __attribute__((ext_vector_type(16)));
typedef unsigned u32x4 __attribute__((ext_vector_type(4)));
typedef unsigned u32x2 __attribute__((ext_vector_type(2)));

constexpr int DM = 2048, NBATCH = 2, SEQ = 4096, CTXL = 256, DEPTH = 4;
constexpr int ML = NBATCH * SEQ, MC = NBATCH * CTXL, MROWS = ML + MC;
constexpr int NIN = 11264, DFF = 5632, NUP = 2 * DFF, NMOD = 6 * DM;
constexpr int CB_OFF = 512, CC_OFF = 1024, CX_OFF = 1536, Q_OFF = 2048, K_OFF = 3072, V_OFF = 4096, GF_OFF = 5120, GC_OFF = 7168, GA_OFF = 9216;
constexpr int NH = 8, HD = 64, VD = 128, QKW = 1024, LK = CTXL + SEQ;
constexpr float QSCALE = 0.125f * 1.4426950408889634f;
constexpr float EPS_RMS = 1e-6f, EPS_SUBLN = 1e-5f;

constexpr size_t MiB = 1u << 20;
constexpr size_t WS_CTL = 0, CTL_BYTES = 4 * MiB;
constexpr size_t WS_MOD = 4 * MiB;
constexpr size_t WS_LAM = 5 * MiB;
constexpr size_t WS_ROPE = WS_LAM + 256;
constexpr size_t WS_CS128 = WS_LAM + 65536;
constexpr size_t WS_DC = WS_CS128 + 131072;
constexpr size_t WS_FWA = WS_DC + 262144;
constexpr size_t WS_FWC = WS_FWA + 32768;
constexpr size_t WS_FTW = WS_FWC + 16384;
constexpr size_t WS_DL = 6 * MiB;
constexpr size_t WS_G8 = WS_DL;
constexpr int NG8 = 3 * DM;
constexpr size_t WS_H = 70 * MiB;
constexpr size_t WS_XN = 138 * MiB;
constexpr size_t WS_P = 172 * MiB;
constexpr size_t WS_QR = 359 * MiB;
constexpr size_t WS_KC = 376 * MiB;
constexpr size_t WS_VT = 393 * MiB;
constexpr size_t WS_T = 410 * MiB;
constexpr size_t WS_TC = 426 * MiB;
constexpr size_t WS_BR = 427 * MiB;
constexpr size_t WS_MACC = 461 * MiB;
constexpr size_t WS_HALO = 501 * MiB;
constexpr size_t WS_MRG = 529 * MiB;
constexpr size_t WS_ACT = 563 * MiB;
constexpr size_t WS_W = 657 * MiB;
constexpr size_t W_IN = 0, W_BM = 44 * MiB, W_OUT = 52 * MiB, W_UP = 60 * MiB, W_DOWN = 104 * MiB, W_LAYER = 126 * MiB;
constexpr size_t WS_END = WS_W + 4 * W_LAYER;

struct Params { const float* in[20]; float* out; unsigned char* ws; };
enum { I_X = 0, I_C, I_CTX, I_CCTX, I_WMOD, I_BMOD, I_G1, I_G2, I_WIN, I_CONVW, I_LAMB, I_SUBG, I_WBF, I_WBC, I_WBA, I_WOUT, I_WUP, I_FCONVW, I_WDOWN, I_GFIN };

__host__ __device__ __forceinline__ unsigned f2bf(float f) { unsigned u = __builtin_bit_cast(unsigned, f); return (u + 0x7fffu + ((u >> 16) & 1u)) >> 16; }
typedef float f32x2_t __attribute__((ext_vector_type(2))); typedef __bf16 bf16x2_t __attribute__((ext_vector_type(2)));
__device__ __forceinline__ unsigned pk2(float lo, float hi) { f32x2_t v = {lo, hi}; bf16x2_t b = __builtin_convertvector(v, bf16x2_t); return __builtin_bit_cast(unsigned, b); }
__device__ __forceinline__ float bflo(unsigned w) { return __uint_as_float(w << 16); }
__device__ __forceinline__ float bfhi(unsigned w) { return __uint_as_float(w & 0xffff0000u); }
__device__ __forceinline__ void unpack8(const u32x4 w, float* f) { f[0] = bflo(w.x); f[1] = bfhi(w.x); f[2] = bflo(w.y); f[3] = bfhi(w.y); f[4] = bflo(w.z); f[5] = bfhi(w.z); f[6] = bflo(w.w); f[7] = bfhi(w.w); }
__device__ __forceinline__ u32x4 pack8(const float* f) { u32x4 w; w.x = pk2(f[0], f[1]); w.y = pk2(f[2], f[3]); w.z = pk2(f[4], f[5]); w.w = pk2(f[6], f[7]); return w; }
#define DPP_ADD(v, ctrl) v += __builtin_bit_cast(float, __builtin_amdgcn_mov_dpp(__builtin_bit_cast(int, v), ctrl, 0xf, 0xf, true))
__device__ __forceinline__ float wave_sum(float v) {
    DPP_ADD(v, 0xB1); DPP_ADD(v, 0x4E); DPP_ADD(v, 0x141); DPP_ADD(v, 0x140);
    { auto rr = __builtin_amdgcn_permlane16_swap(__float_as_uint(v), __float_as_uint(v), false, false); v = __uint_as_float(rr[0]) + __uint_as_float(rr[1]); }
    { auto rr = __builtin_amdgcn_permlane32_swap(__float_as_uint(v), __float_as_uint(v), false, false); v = __uint_as_float(rr[0]) + __uint_as_float(rr[1]); }
    return v;
}
__device__ __forceinline__ float wave_max(float v) {
#pragma unroll
    for (int o = 1; o < 64; o <<= 1) v = fmaxf(v, __shfl_xor(v, o));
    return v;
}
__device__ __forceinline__ float sigmoidf_(float x) { return 1.0f / (1.0f + __expf(-x)); }
__device__ __forceinline__ int lane_id_opaque() { unsigned m = ~0u; asm volatile("" : "+s"(m)); return (int)__builtin_amdgcn_mbcnt_hi(m, __builtin_amdgcn_mbcnt_lo(m, 0u)); }
struct RowInfo { int b, pos, L, mrow, kv; bool ctx; };
__host__ __device__ __forceinline__ RowInfo row_info(int row) {
    RowInfo r;
    if (row < ML) { r.b = row >> 12; r.pos = row & (SEQ - 1); r.L = SEQ; r.mrow = r.b; r.kv = CTXL + r.pos; r.ctx = false; }
    else { const int rr = row - ML; r.b = rr >> 8; r.pos = rr & (CTXL - 1); r.L = CTXL; r.mrow = 2; r.kv = r.pos; r.ctx = true; }
    return r;
}

struct GemmJob { const bf16* A; const bf16* Bt; int lda, ldb, M, N, K, Z, zdiv, pad; long sA1, sA2, sB1, sB2; };
__host__ __device__ __forceinline__ long job_aoff(const GemmJob& j, int z) { return (long)(z / j.zdiv) * j.sA1 + (long)(z % j.zdiv) * j.sA2; }
__host__ __device__ __forceinline__ long job_boff(const GemmJob& j, int z) { return (long)(z / j.zdiv) * j.sB1 + (long)(z % j.zdiv) * j.sB2; }

struct EStore {
    static constexpr bool HAS_MID = false, WHOLE = false, PERM = true;
    bf16* C; int ldc, pad; long sC;
    __device__ __forceinline__ void apply8(int z, int row, int col, f32x4 v0, f32x4 v1) const {
        u32x4 w; w.x = pk2(v0[0], v0[1]); w.y = pk2(v0[2], v0[3]); w.z = pk2(v1[0], v1[1]); w.w = pk2(v1[2], v1[3]);
        *(u32x4*)(C + (size_t)z * sC + (size_t)row * ldc + col) = w;
    }
};
struct ETr {
    static constexpr bool HAS_MID = false, WHOLE = false, PERM = true;
    bf16* T; int L, pad;
    __device__ __forceinline__ void apply8(int z, int row, int col, f32x4 v0, f32x4 v1) const {
        u32x4 w; w.x = pk2(v0[0], v0[1]); w.y = pk2(v0[2], v0[3]); w.z = pk2(v1[0], v1[1]); w.w = pk2(v1[2], v1[3]);
        const int b = z >> 2, g = z & 3;
        *(u32x4*)(T + ((size_t)(b * 512 + g * 128 + (row & 127)) * (size_t)(2 * L) + (size_t)(row >> 7) * L + col)) = w;
    }
};
struct EMerge {
    static constexpr bool HAS_MID = false, WHOLE = false, PERM = true;
    const bf16* P; float* macc; bf16* mrg; int goff, pass;
    __device__ __forceinline__ void apply8(int, int row, int col, f32x4 v0, f32x4 v1) const {
        const u32x4 gw = *(const u32x4*)(P + (size_t)row * NIN + goff + col);
        float g[8]; unpack8(gw, g);
        float v[8] = {v0[0], v0[1], v0[2], v0[3], v1[0], v1[1], v1[2], v1[3]};
        float* mp = macc + (size_t)row * DM + col;
        if (pass > 0) { const f32x4 a = *(const f32x4*)mp, b = *(const f32x4*)(mp + 4);
#pragma unroll
            for (int i = 0; i < 4; ++i) { v[i] = sigmoidf_(g[i]) * v[i] + a[i]; v[4 + i] = sigmoidf_(g[4 + i]) * v[4 + i] + b[i]; } }
        else {
#pragma unroll
            for (int i = 0; i < 8; ++i) v[i] = sigmoidf_(g[i]) * v[i]; }
        if (pass < 2) { *(f32x4*)mp = (f32x4){v[0], v[1], v[2], v[3]}; *(f32x4*)(mp + 4) = (f32x4){v[4], v[5], v[6], v[7]}; }
        else *(u32x4*)(mrg + (size_t)row * DM + col) = pack8(v);
    }
};
struct EMerge1 {
    static constexpr bool HAS_MID = true, WHOLE = false, PERM = true; static constexpr int MID0 = 512 / 64, MID1 = 1024 / 64;
    const unsigned char* g8; bf16* mrg;
    __device__ __forceinline__ void mid8(int seg, int row, int col, f32x4& v0, f32x4& v1) const {
        const unsigned char* gp = g8 + (size_t)row * NG8 + col + (seg == 0 ? 0 : DM);
        const u32x2 qa = *(const u32x2*)gp, qb = *(const u32x2*)(gp + DM);
#pragma unroll
        for (int i = 0; i < 8; ++i) { const unsigned wa = i < 4 ? qa.x : qa.y, wb = i < 4 ? qb.x : qb.y;
            const float r = (float)((wa >> (8 * (i & 3))) & 255u) * __builtin_amdgcn_rcpf((float)((wb >> (8 * (i & 3))) & 255u));
            if (i < 4) v0[i] *= r; else v1[i - 4] *= r; }
    }
    __device__ __forceinline__ void apply8(int, int row, int col, f32x4 v0, f32x4 v1) const {
        const u32x2 q = *(const u32x2*)(g8 + (size_t)row * NG8 + 2 * DM + col);
        float v[8];
#pragma unroll
        for (int i = 0; i < 8; ++i) { const unsigned w = i < 4 ? q.x : q.y; v[i] = (i < 4 ? v0[i] : v1[i - 4]) * ((float)((w >> (8 * (i & 3))) & 255u) * (1.0f / 255.0f)); }
        *(u32x4*)(mrg + (size_t)row * DM + col) = pack8(v);
    }
};
struct EWin {
    static constexpr bool HAS_MID = false, WHOLE = false, PERM = true;
    bf16* P; unsigned char* g8;
    __device__ __forceinline__ void apply8(int, int row, int col, f32x4 v0, f32x4 v1) const {
        if (col < GF_OFF) { u32x4 w; w.x = pk2(v0[0], v0[1]); w.y = pk2(v0[2], v0[3]); w.z = pk2(v1[0], v1[1]); w.w = pk2(v1[2], v1[3]); *(u32x4*)(P + (size_t)row * NIN + col) = w; }
        else {
            unsigned q[8];
#pragma unroll
            for (int i = 0; i < 8; ++i) { const float g = i < 4 ? v0[i] : v1[i - 4]; q[i] = (unsigned)fminf(fmaxf(255.0f * __builtin_amdgcn_rcpf(1.0f + __expf(-g)) + 0.5f, 1.0f), 255.0f); }
            u32x2 w; w.x = q[0] | (q[1] << 8) | (q[2] << 16) | (q[3] << 24); w.y = q[4] | (q[5] << 8) | (q[6] << 16) | (q[7] << 24);
            *(u32x2*)(g8 + (size_t)row * NG8 + (col - GF_OFF)) = w; }
    }
};
struct EResid {
    static constexpr bool HAS_MID = false, WHOLE = false, PERM = true;
    bf16* h; const float* modl; const float* xin; const float* cin; int goff, pad;
    __device__ __forceinline__ void apply8(int, int row, int col, f32x4 v0, f32x4 v1) const {
        const RowInfo ri = row_info(row);
        const float* gp = modl + (size_t)ri.mrow * NMOD + goff + col;
        const f32x4 g0 = *(const f32x4*)gp, g1 = *(const f32x4*)(gp + 4);
        bf16* hp = h + (size_t)row * DM + col;
        float a[8];
        if (xin) { const float* sp = row < ML ? xin + (size_t)row * DM + col : cin + (size_t)(row - ML) * DM + col; const f32x4 s0 = *(const f32x4*)sp, s1 = *(const f32x4*)(sp + 4);
#pragma unroll
            for (int i = 0; i < 4; ++i) { a[i] = s0[i]; a[4 + i] = s1[i]; } }
        else unpack8(*(const u32x4*)hp, a);
#pragma unroll
        for (int i = 0; i < 4; ++i) { a[i] += g0[i] * v0[i]; a[4 + i] += g1[i] * v1[i]; }
        *(u32x4*)hp = pack8(a);
    }
};

__device__ __forceinline__ float dpp_shr1(float oldv, float src) { return __builtin_bit_cast(float, __builtin_amdgcn_update_dpp(__builtin_bit_cast(int, oldv), __builtin_bit_cast(int, src), 0x111, 0xf, 0xf, false)); }
__device__ __forceinline__ float dpp_shl1(float oldv, float src) { return __builtin_bit_cast(float, __builtin_amdgcn_update_dpp(__builtin_bit_cast(int, oldv), __builtin_bit_cast(int, src), 0x101, 0xf, 0xf, false)); }
__device__ __forceinline__ float dpp_ror1(float src) { return __builtin_bit_cast(float, __builtin_amdgcn_mov_dpp(__builtin_bit_cast(int, src), 0x121, 0xf, 0xf, true)); }
__device__ __forceinline__ float dpp_ror15(float src) { return __builtin_bit_cast(float, __builtin_amdgcn_mov_dpp(__builtin_bit_cast(int, src), 0x12F, 0xf, 0xf, true)); }
struct EUpAct {
    static constexpr bool HAS_MID = false, WHOLE = true, PERM = true;
    bf16* act; const float* cw; float* halo; LAS float* edge;
    __device__ __forceinline__ void whole(const f32x4 (&acc)[2][2][4][2], int pm, int pn, int wr, int wc, int, int) const {
        const int ln_ = lane_id_opaque(), fr = ln_ & 15, fq = ln_ >> 4;
        int cb = 32 * wc + 8 * fq; asm volatile("" : "+v"(cb));
#pragma unroll
        for (int ai = 0; ai < 2; ++ai) { const int g = 2 * ai + wr;
#pragma unroll
            for (int bj = 0; bj < 2; ++bj)
#pragma unroll
                for (int n = 0; n < 2; ++n) {
                    if (fr == 0) *(LAS f32x4*)(edge + (g * 2 + 0) * 256 + 128 * bj + cb + 4 * n) = acc[ai][bj][0][n];
                    if (fr == 15) *(LAS f32x4*)(edge + (g * 2 + 1) * 256 + 128 * bj + cb + 4 * n) = acc[ai][bj][3][n]; } }
        LAS float* cwl = edge + 2048;
        { const int tid_ = (wr * 4 + wc) * 64 + ln_;
#pragma unroll
          for (int q = 0; q < 2; ++q) { const int idx = tid_ + 512 * q; if (idx < 768) { const int t = idx >> 8, c = idx & 255; cwl[idx] = cw[(size_t)t * NUP + (c >> 7) * DFF + 128 * pn + (c & 127)]; } } }
        asm volatile("s_waitcnt lgkmcnt(0)\n\ts_barrier" ::: "memory");
        const bool seq_first = pm >= 32 || (pm & 15) == 0, seq_last = pm >= 32 || (pm & 15) == 15;
        const int j0 = 128 * pn + cb;
        float* hb = halo + (size_t)pm * 4 * 2 * DFF + j0;
#pragma unroll
        for (int ai = 0; ai < 2; ++ai) { const int g = 2 * ai + wr; unsigned opk[4][2];
#pragma unroll
            for (int n = 0; n < 2; ++n) {
                asm volatile("" ::: "memory");
                f32x4 w[2][3];
#pragma unroll
                for (int bj = 0; bj < 2; ++bj)
#pragma unroll
                    for (int t = 0; t < 3; ++t) w[bj][t] = *(const LAS f32x4*)(cwl + t * 256 + bj * 128 + cb + 4 * n);
                float o[4][4];
#pragma unroll
                for (int e = 0; e < 4; ++e) {
                    float u[2][4];
#pragma unroll
                    for (int bj = 0; bj < 2; ++bj) {
                        float x0 = acc[ai][bj][0][n][e], x1 = acc[ai][bj][1][n][e], x2 = acc[ai][bj][2][n][e], x3 = acc[ai][bj][3][n][e];
                        asm volatile("" : "+v"(x0), "+v"(x1), "+v"(x2), "+v"(x3));
                        const float epv = g > 0 ? edge[((g - 1) * 2 + 1) * 256 + 128 * bj + cb + 4 * n + e] : 0.f, env = g < 3 ? edge[((g + 1) * 2 + 0) * 256 + 128 * bj + cb + 4 * n + e] : 0.f;
                        const float p0 = dpp_shr1(epv, x0), p1 = dpp_shr1(dpp_ror1(x0), x1), p2 = dpp_shr1(dpp_ror1(x1), x2), p3 = dpp_shr1(dpp_ror1(x2), x3);
                        const float q0 = dpp_shl1(dpp_ror15(x1), x0), q1 = dpp_shl1(dpp_ror15(x2), x1), q2 = dpp_shl1(dpp_ror15(x3), x2), q3 = dpp_shl1(env, x3);
                        const float w0 = w[bj][0][e], w1 = w[bj][1][e], w2 = w[bj][2][e];
                        u[bj][0] = w0 * p0 + w1 * x0 + w2 * q0; u[bj][1] = w0 * p1 + w1 * x1 + w2 * q1; u[bj][2] = w0 * p2 + w1 * x2 + w2 * q2; u[bj][3] = w0 * p3 + w1 * x3 + w2 * q3;
                        if (g == 0 && fr == 0 && !seq_first) { hb[(0 * 2 + bj) * DFF + 4 * n + e] = x0; hb[(2 * 2 + bj) * DFF + 4 * n + e] = u[bj][0]; }
                        if (g == 3 && fr == 15 && !seq_last) { hb[(1 * 2 + bj) * DFF + 4 * n + e] = x3; hb[(3 * 2 + bj) * DFF + 4 * n + e] = u[bj][3]; }
                        asm volatile("" : "+v"(u[bj][0]), "+v"(u[bj][1]), "+v"(u[bj][2]), "+v"(u[bj][3]));
                    }
#pragma unroll
                    for (int m = 0; m < 4; ++m) { const float a = u[0][m]; o[m][e] = a * __builtin_amdgcn_rcpf(1.0f + __expf(-a)) * u[1][m]; }
                    asm volatile("" : "+v"(o[0][e]), "+v"(o[1][e]), "+v"(o[2][e]), "+v"(o[3][e]));
                }
                if (n == 0) {
#pragma unroll
                    for (int m = 0; m < 4; ++m) { opk[m][0] = pk2(o[m][0], o[m][1]); opk[m][1] = pk2(o[m][2], o[m][3]); }
                } else {
#pragma unroll
                    for (int m = 0; m < 4; ++m) { u32x4 pw; pw.x = opk[m][0]; pw.y = opk[m][1]; pw.z = pk2(o[m][0], o[m][1]); pw.w = pk2(o[m][2], o[m][3]); *(u32x4*)(act + (size_t)(pm * 256 + ai * 128 + wr * 64 + m * 16 + fr) * DFF + j0) = pw; }
                }
            }
        }
    }
};
__host__ __device__ __forceinline__ const bf16* wl(const Params& p, int layer, size_t off) { return (const bf16*)(p.ws + WS_W + (size_t)layer * W_LAYER + off); }
__host__ __device__ __forceinline__ GemmJob job_win(const Params& p, int l) { return GemmJob{(const bf16*)(p.ws + WS_XN), wl(p, l, W_IN), DM, DM, MROWS, NIN, DM, 1, 1, 0, 0, 0, 0, 0}; }
__host__ __device__ __forceinline__ GemmJob job_up(const Params& p, int l) { return GemmJob{(const bf16*)(p.ws + WS_XN), wl(p, l, W_UP), DM, DM, (l + 1 < DEPTH || MK_SIMPLE_GEMM) ? MROWS : ML, NUP, DM, 1, 1, 0, 0, 0, 0, 0}; }
__host__ __device__ __forceinline__ GemmJob job_out(const Params& p, int l, int M = MROWS) { return GemmJob{(const bf16*)(p.ws + WS_MRG), wl(p, l, W_OUT), DM, DM, M, DM, DM, 1, 1, 0, 0, 0, 0, 0}; }
__host__ __device__ __forceinline__ GemmJob job_down(const Params& p, int l, int M = MROWS) { return GemmJob{(const bf16*)(p.ws + WS_ACT), wl(p, l, W_DOWN), DFF, DFF, M, DM, DFF, 1, 1, 0, 0, 0, 0, 0}; }
__host__ __device__ __forceinline__ GemmJob job_merge1(const Params& p, int l) { return GemmJob{(const bf16*)(p.ws + WS_BR), wl(p, l, W_BM), DM, DM, ML, DM, DM, 1, 1, 0, 0, 0, 0, 0}; }
__host__ __device__ __forceinline__ GemmJob job_merge(const Params& p, int l, int pass) {
    const int koff = pass == 0 ? 0 : (pass == 1 ? 512 : 1024), K = pass == 2 ? 1024 : 512;
    return GemmJob{(const bf16*)(p.ws + WS_BR) + koff, wl(p, l, W_BM) + koff, DM, DM, MROWS, DM, K, 1, 1, 0, 0, 0, 0, 0};
}
__host__ __device__ __forceinline__ GemmJob job_f1(const Params& p, bool ctx) {
    const bf16* P = (const bf16*)(p.ws + WS_P);
    if (!ctx) return GemmJob{(const bf16*)(p.ws + WS_CS128), P, 256, NIN, 256, SEQ, 256, 8, 4, 0, 0, 0, (long)SEQ * NIN, 128};
    return GemmJob{(const bf16*)(p.ws + WS_CS128), P + (size_t)ML * NIN, 256, NIN, 256, CTXL, 256, 8, 4, 0, 0, 0, (long)CTXL * NIN, 128};
}
__host__ __device__ __forceinline__ GemmJob job_f2(const Params& p, bool ctx) {
    if (!ctx) return GemmJob{(const bf16*)(p.ws + WS_DL), (const bf16*)(p.ws + WS_T), 2 * SEQ, 2 * SEQ, SEQ, 512, 2 * SEQ, 2, 1, 0, 0, 0, (long)512 * 2 * SEQ, 0};
    return GemmJob{(const bf16*)(p.ws + WS_DC), (const bf16*)(p.ws + WS_TC), 2 * CTXL, 2 * CTXL, CTXL, 512, 2 * CTXL, 2, 1, 0, 0, 0, (long)512 * 2 * CTXL, 0};
}
__host__ __device__ __forceinline__ EStore epi_p(const Params& p) { return EStore{(bf16*)(p.ws + WS_P), NIN, 0, 0}; }
__host__ __device__ __forceinline__ EStore epi_f2(const Params& p, bool ctx) {
    if (!ctx) return EStore{(bf16*)(p.ws + WS_BR), DM, 0, (long)SEQ * DM};
    return EStore{(bf16*)(p.ws + WS_BR) + (size_t)ML * DM, DM, 0, (long)CTXL * DM};
}
__host__ __device__ __forceinline__ ETr epi_f1(const Params& p, bool ctx) { return ctx ? ETr{(bf16*)(p.ws + WS_TC), CTXL, 0} : ETr{(bf16*)(p.ws + WS_T), SEQ, 0}; }
__host__ __device__ __forceinline__ EMerge epi_merge(const Params& p, int pass) {
    return EMerge{(const bf16*)(p.ws + WS_P), (float*)(p.ws + WS_MACC), (bf16*)(p.ws + WS_MRG), pass == 0 ? GF_OFF : (pass == 1 ? GC_OFF : GA_OFF), pass};
}
__host__ __device__ __forceinline__ EResid epi_resid(const Params& p, int l, int which) {
    const bool first = (l == 0 && which == 0);
    return EResid{(bf16*)(p.ws + WS_H), (const float*)(p.ws + WS_MOD) + (size_t)l * 3 * NMOD, first ? p.in[I_X] : nullptr, first ? p.in[I_CTX] : nullptr, which == 0 ? 2 * DM : 5 * DM, 0};
}

template <class E> __global__ void __launch_bounds__(256) k_sgemm(GemmJob j, E e) {
    __shared__ float As[32][65], Bs[32][65];
    const int z = blockIdx.z, m0 = blockIdx.y * 64, n0 = blockIdx.x * 64, tid = threadIdx.x;
    const bf16* A = j.A + job_aoff(j, z); const bf16* Bt = j.Bt + job_boff(j, z);
    const int lr = tid >> 2, lc = (tid & 3) * 8, ty = tid >> 3, tx = tid & 7;
    float acc[2][8];
#pragma unroll
    for (int a = 0; a < 2; ++a)
#pragma unroll
        for (int b = 0; b < 8; ++b) acc[a][b] = 0.f;
    for (int k0 = 0; k0 < j.K; k0 += 32) {
        const u32x4 aw = *(const u32x4*)(A + (size_t)(m0 + lr) * j.lda + k0 + lc);
        const u32x4 bw = *(const u32x4*)(Bt + (size_t)(n0 + lr) * j.ldb + k0 + lc);
        float af[8], bf[8]; unpack8(aw, af); unpack8(bw, bf);
        __syncthreads();
#pragma unroll
        for (int i = 0; i < 8; ++i) { As[lc + i][lr] = af[i]; Bs[lc + i][lr] = bf[i]; }
        __syncthreads();
#pragma unroll 8
        for (int kk = 0; kk < 32; ++kk) {
            const float a0 = As[kk][2 * ty], a1 = As[kk][2 * ty + 1];
#pragma unroll
            for (int b = 0; b < 8; ++b) { const float bv = Bs[kk][8 * tx + b]; acc[0][b] += a0 * bv; acc[1][b] += a1 * bv; }
        }
    }
#pragma unroll
    for (int a = 0; a < 2; ++a)
        e.apply8(z, m0 + 2 * ty + a, n0 + 8 * tx, (f32x4){acc[a][0], acc[a][1], acc[a][2], acc[a][3]}, (f32x4){acc[a][4], acc[a][5], acc[a][6], acc[a][7]});
}
template <class E> static void launch_sgemm(const GemmJob& j, const E& e, hipStream_t st) {
    hipLaunchKernelGGL((k_sgemm<E>), dim3(j.N / 64, j.M / 64, j.Z), dim3(256), 0, st, j, e);
}

__global__ void __launch_bounds__(64) k_sattn(Params p, int layer) {
    __shared__ float S0[LK], S1[LK], q[128];
    const int row = blockIdx.x >> 3, h = blockIdx.x & 7, lane = threadIdx.x;
    const RowInfo ri = row_info(row);
    const int nk = ri.ctx ? CTXL : LK;
    const bf16* Qr = (const bf16*)(p.ws + WS_QR); const bf16* Kc = (const bf16*)(p.ws + WS_KC); const bf16* Vt = (const bf16*)(p.ws + WS_VT);
    bf16* br = (bf16*)(p.ws + WS_BR);
    const float lam = ((const float*)(p.ws + WS_LAM))[layer];
    const float lam_init = 0.8f - 0.6f * expf(-0.3f * (float)layer);
    q[lane] = __uint_as_float(((unsigned)Qr[(size_t)row * QKW + h * 128 + lane]) << 16);
    q[64 + lane] = __uint_as_float(((unsigned)Qr[(size_t)row * QKW + h * 128 + 64 + lane]) << 16);
    __syncthreads();
    float m0 = -1e30f, m1 = -1e30f;
    for (int j = lane; j < nk; j += 64) {
        const bf16* kp = Kc + ((size_t)(ri.b * LK + j) * QKW + h * 128);
        float s0 = 0.f, s1 = 0.f;
#pragma unroll
        for (int c = 0; c < 8; ++c) { float f[8]; unpack8(*(const u32x4*)(kp + c * 8), f);
#pragma unroll
            for (int i = 0; i < 8; ++i) s0 += q[c * 8 + i] * f[i]; }
#pragma unroll
        for (int c = 0; c < 8; ++c) { float f[8]; unpack8(*(const u32x4*)(kp + 64 + c * 8), f);
#pragma unroll
            for (int i = 0; i < 8; ++i) s1 += q[64 + c * 8 + i] * f[i]; }
        S0[j] = s0; S1[j] = s1; m0 = fmaxf(m0, s0); m1 = fmaxf(m1, s1);
    }
    m0 = wave_max(m0); m1 = wave_max(m1);
    float l0 = 0.f, l1 = 0.f;
    for (int j = lane; j < nk; j += 64) { const float e0 = exp2f(S0[j] - m0), e1 = exp2f(S1[j] - m1); S0[j] = e0; S1[j] = e1; l0 += e0; l1 += e1; }
    l0 = wave_sum(l0); l1 = wave_sum(l1);
    const float i0 = 1.0f / l0, i1 = lam / l1;
    for (int j = lane; j < nk; j += 64) S0[j] = S0[j] * i0 - S1[j] * i1;
    __syncthreads();
    float o[2];
#pragma unroll
    for (int t = 0; t < 2; ++t) {
        const int dv = lane + 64 * t;
        const bf16* vp = Vt + ((size_t)(ri.b * QKW + h * 128 + dv) * LK);
        float s = 0.f;
        for (int j = 0; j < nk; j += 8) { float f[8]; unpack8(*(const u32x4*)(vp + j), f);
#pragma unroll
            for (int i = 0; i < 8; ++i) s += S0[j + i] * f[i]; }
        o[t] = s;
    }
    const float ss = wave_sum(o[0] * o[0] + o[1] * o[1]);
    const float rs = rsqrtf(ss * (1.0f / 128.0f) + EPS_SUBLN) * (1.0f - lam_init);
    const float* sg = p.in[I_SUBG] + layer * VD;
#pragma unroll
    for (int t = 0; t < 2; ++t) { const int dv = lane + 64 * t; br[(size_t)row * DM + 1024 + h * 128 + dv] = (bf16)f2bf(o[t] * rs * sg[dv]); }
}

namespace pg8 {
constexpr int BM = 256, BK = 64, HALF = 128, HTB = HALF * BK * 2, STAGE_BYTES = 8 * HTB, NXCD = 8, WGM = 8;
__host__ __device__ __forceinline__ int lds_byte(int r, int c) { const int st = (r >> 4) * 2 + (c >> 5), rr = r & 15, cc = c & 31, ob = rr * 64 + cc * 2; return st * 1024 + (ob ^ (((ob >> 9) & 1) << 5)); }
__host__ __device__ __forceinline__ void stage_rc(int b, int& R, int& C) { const int st = b / 1024, sb = b % 1024, swz = sb ^ (((sb >> 9) & 1) << 5); R = (st >> 1) * 16 + swz / 64; C = (st & 1) * 32 + (swz % 64) / 2; }
__host__ __device__ __forceinline__ int perm32(int rho) { const int n = rho >> 4, i = rho & 15; return 8 * (i >> 2) + 4 * n + (i & 3); }
struct Unit { int pm, pn, z; size_t aoff, boff; };
struct Sched {
    int nM, nN, tiles, total, G, c, lda, ldb, zdiv; long sA1, sA2, sB1, sB2;
    __device__ __forceinline__ void init(const GemmJob& j, int G_, int c_) { nM = j.M / BM; nN = j.N / BM; tiles = nM * nN; total = tiles * j.Z; G = G_; c = c_; lda = j.lda; ldb = j.ldb; zdiv = j.zdiv; sA1 = j.sA1; sA2 = j.sA2; sB1 = j.sB1; sB2 = j.sB2; }
    __device__ __forceinline__ bool next(int i, Unit& u) const {
        const long L = (long)i * G + c; if (L >= total) return false;
        const int z = (int)(L / tiles); int wgid = (int)(L % tiles);
        { const int q = tiles / NXCD, r = tiles % NXCD, xcd = wgid % NXCD, off = wgid / NXCD; wgid = (xcd < r ? xcd * (q + 1) : r * (q + 1) + (xcd - r) * q) + off; }
        const int nig = WGM * nN, gid = wgid / nig, fm = gid * WGM, gsz = (nM - fm) < WGM ? (nM - fm) : WGM;
        u.pm = fm + ((wgid % nig) % gsz); u.pn = (wgid % nig) / gsz; u.z = z;
        const long z1 = z / zdiv, z2 = z % zdiv;
        u.aoff = (size_t)(z1 * sA1 + z2 * sA2 + (long)u.pm * BM * lda) * 2; u.boff = (size_t)(z1 * sB1 + z2 * sB2 + (long)u.pn * BM * ldb) * 2;
        return true;
    }
};
template <class E> __device__ __forceinline__ void run_epi(const E& e, const f32x4 (&acc)[2][2][4][2], const Unit& u, int wr, int wc, int, int) {
    const int ln_ = lane_id_opaque(), fr = ln_ & 15, fq = ln_ >> 4;
    int row0 = u.pm * BM + wr * 64 + fr, col0 = u.pn * BM + wc * 64 + 8 * fq;
    asm volatile("" : "+v"(row0), "+v"(col0));
    const int colq = col0 - 4 * fq; (void)colq;
#pragma unroll
    for (int ai = 0; ai < 2; ++ai)
#pragma unroll
        for (int m = 0; m < 4; ++m)
#pragma unroll
            for (int bj = 0; bj < 2; ++bj) {
                if constexpr (E::PERM) e.apply8(u.z, row0 + ai * HALF + m * 16, col0 + bj * 32, acc[ai][bj][m][0], acc[ai][bj][m][1]);
                else { e.apply4(u.z, row0 + ai * HALF + m * 16, colq + bj * 32, acc[ai][bj][m][0]); e.apply4(u.z, row0 + ai * HALF + m * 16, colq + bj * 32 + 16, acc[ai][bj][m][1]); } }
}
template <class E> __device__ __forceinline__ void run_mid(const E& e, f32x4 (&acc)[2][2][4][2], const Unit& u, int seg, int wr, int wc, int, int) {
    const int ln_ = lane_id_opaque(), fr = ln_ & 15, fq = ln_ >> 4;
    int row0 = u.pm * BM + wr * 64 + fr, col0 = u.pn * BM + wc * 64 + 8 * fq;
    asm volatile("" : "+v"(row0), "+v"(col0));
#pragma unroll
    for (int ai = 0; ai < 2; ++ai)
#pragma unroll
        for (int m = 0; m < 4; ++m)
#pragma unroll
            for (int bj = 0; bj < 2; ++bj) e.mid8(seg, row0 + ai * HALF + m * 16, col0 + bj * 32, acc[ai][bj][m][0], acc[ai][bj][m][1]);
}
template <class E>
__device__ __forceinline__ void gemm_phase(LAS unsigned char* lds, const GemmJob g, const Sched& S, const E& e, int wave_) {
    int tid = wave_ * 64 + lane_id_opaque(); asm volatile("" : "+v"(tid));
    const int wid = wave_, lane = tid & 63, wr = wid >> 2, wc = wid & 3, fr = lane & 15, fq = lane >> 4;
    const int K = g.K, nt = K / BK;
    unsigned voffA[2], voffB[2];
#pragma unroll
    for (int i = 0; i < 2; ++i) { int R, C; stage_rc(tid * 16 + i * 8192, R, C); const int Rb = (R >> 5) * 64 + (E::PERM ? perm32(R & 31) : (R & 31));
        voffA[i] = (unsigned)(R * g.lda + C) * 2u; voffB[i] = (unsigned)(Rb * g.ldb + C) * 2u; }
    const size_t kstep = (size_t)(BK * 2);
    const size_t hstepA = (size_t)HALF * g.lda * 2, hstepB = (size_t)32 * g.ldb * 2;
    const unsigned ldsw = (unsigned)wid * 1024u;
    const int aoff = lds_byte(wr * 64 + fr, fq * 8), boff = lds_byte(wc * 32 + fr, fq * 8);
#define PG8_SA(b, h) (((b) * 2 + (h)) * HTB)
#define PG8_SB(b, h) ((4 + (b) * 2 + (h)) * HTB)
#define PG8_STAGE(bufoff, gbase, voff) do { _Pragma("unroll") for (int _i = 0; _i < 2; ++_i) \
        __builtin_amdgcn_global_load_lds((const unsigned*)((const char*)(gbase) + (voff)[_i]), (LAS unsigned*)(lds + (bufoff) + ldsw + _i * 8192), 16, 0, 0); } while (0)
#define PG8_LDA(dst, b, h) do { _Pragma("unroll") for (int m = 0; m < 4; ++m) _Pragma("unroll") for (int k = 0; k < 2; ++k) dst[m][k] = *(const LAS bf16x8*)(lds + PG8_SA(b, h) + aoff + m * 2048 + k * 1024); } while (0)
#define PG8_LDB(dst, b, h) do { _Pragma("unroll") for (int n = 0; n < 2; ++n) _Pragma("unroll") for (int k = 0; k < 2; ++k) dst[n][k] = *(const LAS bf16x8*)(lds + PG8_SB(b, h) + boff + n * 2048 + k * 1024); } while (0)
#define PG8_MMA(ai, bj, At, Bt) do { __builtin_amdgcn_s_setprio(1); _Pragma("unroll") for (int m = 0; m < 4; ++m) _Pragma("unroll") for (int n = 0; n < 2; ++n) _Pragma("unroll") for (int k = 0; k < 2; ++k) \
        acc[ai][bj][m][n] = __builtin_amdgcn_mfma_f32_16x16x32_bf16(Bt[n][k], At[m][k], acc[ai][bj][m][n], 0, 0, 0); __builtin_amdgcn_s_setprio(0); } while (0)
#define PG8_WAIT_V(n) asm volatile("s_waitcnt vmcnt(" #n ")" ::: "memory")
#define PG8_WAIT_L(n) asm volatile("s_waitcnt lgkmcnt(" #n ")" ::: "memory")
#define PG8_BAR __builtin_amdgcn_s_barrier()
#define PG8_SCHED __builtin_amdgcn_sched_barrier(0)
    Unit cur, nxt; int ui = 0;
    if (!S.next(0, cur)) return;
    f32x4 acc[2][2][4][2];
#pragma unroll
    for (int a = 0; a < 2; ++a)
#pragma unroll
        for (int b = 0; b < 2; ++b)
#pragma unroll
            for (int m = 0; m < 4; ++m)
#pragma unroll
                for (int n = 0; n < 2; ++n) acc[a][b][m][n] = (f32x4){0.f, 0.f, 0.f, 0.f};
    bf16x8 At[4][2], B0[2][2], B1[2][2];
    const char* cA = (const char*)g.A + cur.aoff; const char* cB = (const char*)g.Bt + cur.boff;
    PG8_STAGE(PG8_SB(0, 0), cB, voffB); PG8_STAGE(PG8_SB(0, 1), cB + hstepB, voffB); PG8_STAGE(PG8_SA(0, 0), cA, voffA); PG8_STAGE(PG8_SA(0, 1), cA + hstepA, voffA);
    if (wr == 1) PG8_BAR;
    PG8_WAIT_V(2); PG8_BAR;
    PG8_STAGE(PG8_SB(1, 0), cB + kstep, voffB); PG8_STAGE(PG8_SA(1, 0), cA + kstep, voffA); PG8_STAGE(PG8_SB(1, 1), cB + hstepB + kstep, voffB);
    PG8_WAIT_V(6); PG8_BAR;
    for (;;) {
        const bool has_next = S.next(ui + 1, nxt);
        const char* nA = has_next ? (const char*)g.A + nxt.aoff : cA; const char* nB = has_next ? (const char*)g.Bt + nxt.boff : cB;
        for (int t = 0; t < nt; t += 2) {
            const bool last = (t == nt - 2);
            const char* a1 = cA + (size_t)(t + 1) * kstep;
            const char* a2 = last ? nA : cA + (size_t)(t + 2) * kstep; const char* b2 = last ? nB : cB + (size_t)(t + 2) * kstep;
            const char* a3 = a2 + kstep; const char* b3 = b2 + kstep;
            PG8_LDB(B0, 0, 0); PG8_LDB(B1, 0, 1); PG8_SCHED; PG8_LDA(At, 0, 0); PG8_STAGE(PG8_SA(1, 1), a1 + hstepA, voffA);
            PG8_WAIT_V(8); PG8_WAIT_L(0); PG8_BAR; PG8_MMA(0, 0, At, B0); PG8_MMA(0, 1, At, B1); PG8_BAR; PG8_SCHED;
            PG8_LDA(At, 0, 1); PG8_STAGE(PG8_SB(0, 0), b2, voffB); PG8_STAGE(PG8_SB(0, 1), b2 + hstepB, voffB); PG8_STAGE(PG8_SA(0, 0), a2, voffA);
            PG8_WAIT_V(8); PG8_WAIT_L(0); PG8_BAR; PG8_MMA(1, 0, At, B0); PG8_MMA(1, 1, At, B1); PG8_BAR; PG8_SCHED;
            PG8_LDB(B0, 1, 0); PG8_LDB(B1, 1, 1); PG8_SCHED; PG8_LDA(At, 1, 0); PG8_STAGE(PG8_SA(0, 1), a2 + hstepA, voffA);
            PG8_WAIT_V(8); PG8_WAIT_L(0); PG8_BAR; PG8_MMA(0, 0, At, B0); PG8_MMA(0, 1, At, B1); PG8_BAR; PG8_SCHED;
            PG8_LDA(At, 1, 1); PG8_STAGE(PG8_SB(1, 0), b3, voffB); PG8_STAGE(PG8_SB(1, 1), b3 + hstepB, voffB); PG8_STAGE(PG8_SA(1, 0), a3, voffA);
            PG8_WAIT_V(8); PG8_WAIT_L(0); PG8_BAR; PG8_MMA(1, 0, At, B0); PG8_MMA(1, 1, At, B1); PG8_BAR; PG8_SCHED;
            if constexpr (E::HAS_MID) { if (t + 2 == E::MID0 || t + 2 == E::MID1) run_mid(e, acc, cur, (t + 2 == E::MID0) ? 0 : 1, wr, wc, fr, fq); }
        }
        if (wr == 0) PG8_BAR;
        if constexpr (E::WHOLE) e.whole(acc, cur.pm, cur.pn, wr, wc, fr, fq); else run_epi(e, acc, cur, wr, wc, fr, fq);
        if (!has_next) break;
#pragma unroll
        for (int a = 0; a < 2; ++a)
#pragma unroll
            for (int b = 0; b < 2; ++b)
#pragma unroll
                for (int m = 0; m < 4; ++m)
#pragma unroll
                    for (int n = 0; n < 2; ++n) acc[a][b][m][n] = (f32x4){0.f, 0.f, 0.f, 0.f};
        cur = nxt; cA = nA; cB = nB; ++ui;
        if (wr == 1) PG8_BAR;
    }
    PG8_WAIT_V(0);
    PG8_BAR;
#undef PG8_SA
#undef PG8_SB
#undef PG8_STAGE
#undef PG8_LDA
#undef PG8_LDB
#undef PG8_MMA
#undef PG8_WAIT_V
#undef PG8_WAIT_L
#undef PG8_BAR
#undef PG8_SCHED
}
}

#define XB_TMO      128
#define XB_XCNT(j)  (256  + 64 * (j))
#define XB_XSUB(j)  (1280 + 64 * (j))
#define XB_XGEN(j)  (2304 + 64 * (j))
#define XB_TOP      3328
#define XB_TOPGEN   3392
#define XCD_BAR_WORDS 3456
#define XB_SPIN_CAP (1u << 18)
__device__ __forceinline__ unsigned xb_ld(unsigned* p)              { return __hip_atomic_load(p, __ATOMIC_RELAXED, __HIP_MEMORY_SCOPE_AGENT); }
__device__ __forceinline__ unsigned xb_add(unsigned* p, unsigned v) { return __hip_atomic_fetch_add(p, v, __ATOMIC_RELAXED, __HIP_MEMORY_SCOPE_AGENT); }
__device__ __forceinline__ unsigned xb_xcc_id() { return (unsigned)__builtin_amdgcn_s_getreg((3 << 11) | 20) & 0xFu; }
#define XB_SPIN(cond, bar) do { unsigned _sp = 0; while (cond) { __builtin_amdgcn_s_sleep(1); \
    if ((++_sp & 255u) == 0u) { if (xb_ld(&(bar)[XB_TMO])) break; if (_sp > XB_SPIN_CAP) { atomicAdd(&(bar)[XB_TMO], 1u); break; } } } } while (0)
struct XcdBarrier { unsigned* bar; unsigned x; volatile LAS unsigned* st; };
__device__ __forceinline__ XcdBarrier xcd_barrier_post(unsigned* bar, volatile LAS unsigned* st) {
    XcdBarrier b; b.bar = bar; b.x = xb_xcc_id(); b.st = st;
    if (threadIdx.x == 0) (void)xb_add(&bar[XB_XCNT(b.x)], 1u);
    return b;
}
__device__ __forceinline__ void xcd_barrier_complete(unsigned* bar, unsigned x, unsigned& nloc, unsigned& nx) {
    const unsigned G = gridDim.x * gridDim.y * gridDim.z;
    unsigned sum, cnt, mine, sp = 0u;
    for (;;) {
        sum = 0u; cnt = 0u; mine = 0u;
#pragma unroll
        for (unsigned j = 0; j < 16; ++j) { const unsigned c = xb_ld(&bar[XB_XCNT(j)]); sum += c; cnt += (c > 0u) ? 1u : 0u; mine = (j == x) ? c : mine; }
        if (sum == G) break;
        __builtin_amdgcn_s_sleep(1);
        if ((++sp & 255u) == 0u) { if (xb_ld(&bar[XB_TMO])) break; if (sp > XB_SPIN_CAP) { atomicAdd(&bar[XB_TMO], 1u); break; } }
    }
    nloc = mine > 0u ? mine : 1u; nx = cnt > 0u ? cnt : 1u;
}
__device__ __forceinline__ void xcd_barrier(const XcdBarrier& b) {
    asm volatile("s_waitcnt vmcnt(0)" ::: "memory");
    __syncthreads();
    if (threadIdx.x == 0) {
        unsigned* bar = b.bar;
        __builtin_amdgcn_s_waitcnt(0);
        unsigned nloc = b.st[0], nx = b.st[1];
        if (nloc == 0u) { xcd_barrier_complete(bar, b.x, nloc, nx); b.st[0] = nloc; b.st[1] = nx; }
        const unsigned old = xb_add(&bar[XB_XSUB(b.x)], 1u);
        const unsigned gen = old / nloc;
        if (old + 1u == (gen + 1u) * nloc) {
            __builtin_amdgcn_fence(__ATOMIC_RELEASE, "agent");
            asm volatile("s_waitcnt vmcnt(0)" ::: "memory");
            const unsigned og = xb_add(&bar[XB_TOP], 1u);
            const unsigned tg = og / nx;
            if (og + 1u == (tg + 1u) * nx) xb_add(&bar[XB_TOPGEN], 1u);
            else XB_SPIN(xb_ld(&bar[XB_TOPGEN]) == tg, bar);
            __builtin_amdgcn_fence(__ATOMIC_ACQUIRE, "agent");
            xb_add(&bar[XB_XGEN(b.x)], 1u);
            asm volatile("s_waitcnt vmcnt(0)" ::: "memory");
        } else {
            XB_SPIN(xb_ld(&bar[XB_XGEN(b.x)]) == gen, bar);
            __builtin_amdgcn_fence(__ATOMIC_ACQUIRE, "agent");
            asm volatile("s_waitcnt vmcnt(0)" ::: "memory");
        }
    }
    __syncthreads();
}

constexpr int NWAVES = 8, NTHR = 512;
constexpr int RING_BYTES = 131072, MISC_OFF = RING_BYTES, LDS_BYTES = 147456;
constexpr int CW_BAR = 4096;
#define LDS_WAIT() asm volatile("s_waitcnt lgkmcnt(0)" ::: "memory")

struct Ctx { LAS unsigned char* lds; int tid, lane, wave, vcu, G; };
__device__ __forceinline__ Ctx fresh(const Ctx& F0) { Ctx F = F0; int v = F0.vcu, w = F0.wave; asm volatile("" : "+s"(v), "+s"(w)); int t = w * 64 + lane_id_opaque(); asm volatile("" : "+v"(t)); F.tid = t; F.lane = t & 63; F.vcu = v; F.wave = w; return F; }

template <bool UPPERM = false> __device__ __forceinline__ void transpose_item(const float* W, int N, bf16* WT, int ldt, int col_off, LAS float* scr, int item, int lane) {
    const int nblk = N / 32, kb = item / nblk, nb = item % nblk, k0 = 64 * kb, n0 = 32 * nb;
    { const int kr = lane >> 3, c4 = lane & 7;
      f32x4 v[8];
#pragma unroll
      for (int i = 0; i < 8; ++i) v[i] = *(const f32x4*)(W + (size_t)(k0 + 8 * i + kr) * N + n0 + 4 * c4);
#pragma unroll
      for (int i = 0; i < 8; ++i)
#pragma unroll
          for (int j = 0; j < 4; ++j) scr[(8 * i + kr) * 33 + 4 * c4 + j] = v[i][j]; }
    LDS_WAIT(); asm volatile("" ::: "memory");
    const int c = lane & 7;
#pragma unroll
    for (int j = 0; j < 4; ++j) { const int n = (lane >> 3) + 8 * j; const LAS float* s = scr + (8 * c) * 33 + n;
        u32x4 o; o.x = pk2(s[0 * 33], s[1 * 33]); o.y = pk2(s[2 * 33], s[3 * 33]); o.z = pk2(s[4 * 33], s[5 * 33]); o.w = pk2(s[6 * 33], s[7 * 33]);
        int nr = n0 + n; if (UPPERM) { const int av = nr >= DFF, j = nr - av * DFF; nr = (j >> 7) * 256 + ((j >> 5) & 3) * 64 + av * 32 + (j & 31); }
        *(u32x4*)(WT + (size_t)nr * ldt + col_off + k0 + 8 * c) = o; }
    LDS_WAIT(); asm volatile("" ::: "memory");
}
__device__ __forceinline__ void prologue(const Params& p, const Ctx& F0) {
    const Ctx F = fresh(F0);
    const int gw = F.vcu * NWAVES + F.wave, NGW = F.G * NWAVES;
    const int gt = F.vcu * NTHR + F.tid, NGT = F.G * NTHR;
    {
        LAS float* sv = (LAS float*)F.lds;
        LAS float* red = (LAS float*)(F.lds + 24576);
        for (int i = F.tid; i < 3 * DM; i += NTHR) { const int r = i / DM, k = i % DM; const float x = r < 2 ? p.in[I_C][r * DM + k] : p.in[I_CCTX][k]; sv[i] = x / (1.0f + __expf(-x)); }
        __syncthreads();
        const int ng = F.tid & 15, ks = F.tid >> 4;
        float* mod = (float*)(p.ws + WS_MOD);
        for (int it = F.vcu; it < DEPTH * (NMOD / 64); it += F.G) {
            const int l = it / (NMOD / 64), n0 = (it % (NMOD / 64)) * 64;
            const float* W = p.in[I_WMOD] + ((size_t)l * DM + ks * 64) * NMOD + n0 + 4 * ng;
            f32x4 a0 = {0, 0, 0, 0}, a1 = {0, 0, 0, 0}, a2 = {0, 0, 0, 0};
#pragma unroll 8
            for (int kk = 0; kk < 64; ++kk) { const f32x4 w = *(const f32x4*)(W + (size_t)kk * NMOD); const int k = ks * 64 + kk; a0 += sv[k] * w; a1 += sv[DM + k] * w; a2 += sv[2 * DM + k] * w; }
            *(LAS f32x4*)(red + (ks * 3 + 0) * 64 + 4 * ng) = a0; *(LAS f32x4*)(red + (ks * 3 + 1) * 64 + 4 * ng) = a1; *(LAS f32x4*)(red + (ks * 3 + 2) * 64 + 4 * ng) = a2;
            __syncthreads();
            if (F.tid < 192) { const int r = F.tid >> 6, n = F.tid & 63; float s = p.in[I_BMOD][(size_t)l * NMOD + n0 + n];
                for (int q = 0; q < 32; ++q) s += red[(q * 3 + r) * 64 + n];
                mod[((size_t)l * 3 + r) * NMOD + n0 + n] = s; }
            __syncthreads();
        }
    }
    {
        LAS float* scr = (LAS float*)(F.lds + F.wave * 16384);
        constexpr int I_IN = (DM / 64) * (NIN / 32), I_BF = (512 / 64) * (DM / 32), I_BA = (1024 / 64) * (DM / 32), I_OUT = (DM / 64) * (DM / 32), I_DN = (DFF / 64) * (DM / 32);
        constexpr int PER_LAYER = 2 * I_IN + 2 * I_BF + I_BA + I_OUT + I_DN;
        for (int it = gw; it < DEPTH * PER_LAYER; it += NGW) {
            const int l = it / PER_LAYER; int r = it % PER_LAYER;
            unsigned char* wb = p.ws + WS_W + (size_t)l * W_LAYER;
            if (r < I_IN) { transpose_item(p.in[I_WIN] + (size_t)l * DM * NIN, NIN, (bf16*)(wb + W_IN), DM, 0, scr, r, F.lane); continue; } r -= I_IN;
            if (r < I_IN) { transpose_item<MK_FUSE_ACT != 0>(p.in[I_WUP] + (size_t)l * DM * NUP, NUP, (bf16*)(wb + W_UP), DM, 0, scr, r, F.lane); continue; } r -= I_IN;
            if (r < I_BF) { transpose_item(p.in[I_WBF] + (size_t)l * 512 * DM, DM, (bf16*)(wb + W_BM), DM, 0, scr, r, F.lane); continue; } r -= I_BF;
            if (r < I_BF) { transpose_item(p.in[I_WBC] + (size_t)l * 512 * DM, DM, (bf16*)(wb + W_BM), DM, 512, scr, r, F.lane); continue; } r -= I_BF;
            if (r < I_BA) { transpose_item(p.in[I_WBA] + (size_t)l * 1024 * DM, DM, (bf16*)(wb + W_BM), DM, 1024, scr, r, F.lane); continue; } r -= I_BA;
            if (r < I_OUT) { transpose_item(p.in[I_WOUT] + (size_t)l * DM * DM, DM, (bf16*)(wb + W_OUT), DM, 0, scr, r, F.lane); continue; } r -= I_OUT;
            transpose_item(p.in[I_WDOWN] + (size_t)l * DFF * DM, DM, (bf16*)(wb + W_DOWN), DFF, 0, scr, r, F.lane);
        }
    }
    {
#if MK_FFT
        { bf16* WA = (bf16*)(p.ws + WS_FWA); bf16* WC = (bf16*)(p.ws + WS_FWC); float2* tw = (float2*)(p.ws + WS_FTW);
          for (int it = gt; it < 128 * 128; it += NGT) { const int r = it >> 7, k = it & 127, pr = r >> 6, ap = r & 63, pk = k >> 6, a = k & 63; float sn, cs; sincospif((float)((ap * a) & 63) * (1.0f / 32.0f), &sn, &cs);
              const float v = (pr == 0 ? (pk == 0 ? cs : -sn) : (pk == 0 ? -sn : -cs)) * 0.125f; WA[it] = (bf16)f2bf(v); }
          for (int it = gt; it < 64 * 128; it += NGT) { const int bp = it >> 7, k = it & 127, pk = k >> 6, b = k & 63; float sn, cs; sincospif((float)((bp * b) & 63) * (1.0f / 32.0f), &sn, &cs); WC[it] = (bf16)f2bf((pk == 0 ? cs : sn) * 0.125f); }
          for (int it = gt; it < 4096; it += NGT) { float sn, cs; sincospif((float)it * (1.0f / 2048.0f), &sn, &cs); tw[it] = make_float2(cs, sn); } }
#else
        bf16* DL = (bf16*)(p.ws + WS_DL);
        for (int it = gt; it < SEQ * 1024; it += NGT) {
            const int lp = it >> 10, j0 = (it & 1023) * 8; float v[8];
#pragma unroll
            for (int e = 0; e < 8; ++e) { const int j = j0 + e, l = j & (SEQ - 1); const int m = (lp * l) & (SEQ - 1); float s, c; sincospif((float)m * (1.0f / 2048.0f), &s, &c); v[e] = (j < SEQ ? c : -s) * (1.0f / 64.0f); }
            *(u32x4*)(DL + (size_t)lp * (2 * SEQ) + j0) = pack8(v);
        }
#endif
        bf16* DC = (bf16*)(p.ws + WS_DC);
        for (int it = gt; it < CTXL * 64; it += NGT) {
            const int lp = it >> 6, j0 = (it & 63) * 8; float v[8];
#pragma unroll
            for (int e = 0; e < 8; ++e) { const int j = j0 + e, l = j & (CTXL - 1); const int m = (lp * l) & (CTXL - 1); float s, c; sincospif((float)m * (1.0f / 128.0f), &s, &c); v[e] = (j < CTXL ? c : -s) * (1.0f / 16.0f); }
            *(u32x4*)(DC + (size_t)lp * (2 * CTXL) + j0) = pack8(v);
        }
        bf16* CS = (bf16*)(p.ws + WS_CS128);
        for (int it = gt; it < 256 * 32; it += NGT) {
            const int row = it >> 5, k0 = (it & 31) * 8, cs = row >> 7, cp = row & 127; float v[8];
#pragma unroll
            for (int e = 0; e < 8; ++e) { const int k = k0 + e; const int m = (cp * k) & 127; float s, c; sincospif((float)m * (1.0f / 64.0f), &s, &c); v[e] = k < 128 ? (cs == 0 ? c : s) * 0.08838834764831845f : 0.f; }
            *(u32x4*)(CS + (size_t)row * 256 + k0) = pack8(v);
        }
        float2* rope = (float2*)(p.ws + WS_ROPE);
        for (int it = gt; it < 64 * 16; it += NGT) { const int pos = it >> 4, j = it & 15; const float inv = powf(10000.0f, -(float)j * (1.0f / 16.0f)); const float a = (float)pos * inv; rope[it] = make_float2(cosf(a), sinf(a)); }
        if (gt < DEPTH) { const float* lm = p.in[I_LAMB] + gt * 4 * HD; float s0 = 0.f, s1 = 0.f; for (int d = 0; d < HD; ++d) { s0 += lm[d] * lm[HD + d]; s1 += lm[2 * HD + d] * lm[3 * HD + d]; }
            ((float*)(p.ws + WS_LAM))[gt] = expf(s0) - expf(s1) + (0.8f - 0.6f * expf(-0.3f * (float)gt)); }
    }
}

__device__ __forceinline__ void norm_row_finish(const LAS float* tab, bf16* xrow, const float (&f)[4][8], int lane) {
    float ss = 0.f;
#pragma unroll
    for (int j = 0; j < 4; ++j)
#pragma unroll
        for (int i = 0; i < 8; i += 2) ss += f[j][i] * f[j][i] + f[j][i + 1] * f[j][i + 1];
    const float rstd = rsqrtf(wave_sum(ss) * (1.0f / DM) + EPS_RMS);
#pragma unroll
    for (int j = 0; j < 4; ++j) { const int ci = 4 * (lane + 64 * j); float o[8];
        const f32x4 ae = *(const LAS f32x4*)(tab + ci), ao = *(const LAS f32x4*)(tab + 1024 + ci), be = *(const LAS f32x4*)(tab + 2048 + ci), bo = *(const LAS f32x4*)(tab + 3072 + ci);
#pragma unroll
        for (int i = 0; i < 4; ++i) { o[i] = (f[j][i] * rstd) * ae[i] + be[i]; o[4 + i] = (f[j][4 + i] * rstd) * ao[i] + bo[i]; }
        *(u32x4*)(xrow + 8 * (lane + 64 * j)) = pack8(o); }
}
template <int NR> __device__ __forceinline__ void norm_rows_bf16(const bf16* h, bf16* xn, const LAS float* tab, int row0, int lane) {
    u32x4 raw[NR][4];
#pragma unroll
    for (int r = 0; r < NR; ++r) { const u32x4* xr = (const u32x4*)(h + (size_t)(row0 + r) * DM) + lane;
#pragma unroll
        for (int j = 0; j < 4; ++j) raw[r][j] = xr[64 * j]; }
#pragma unroll
    for (int r = 0; r < NR; ++r) { float f[4][8];
#pragma unroll
        for (int j = 0; j < 4; ++j) unpack8(raw[r][j], f[j]);
        norm_row_finish(tab, xn + (size_t)(row0 + r) * DM, f, lane); }
}
__device__ __forceinline__ void norm_row_f32(const float* src, bf16* xrow, const LAS float* tab, int lane) {
    const f32x4* xr = (const f32x4*)src + 2 * lane; float f[4][8];
#pragma unroll
    for (int j = 0; j < 4; ++j) { const f32x4 a = xr[128 * j], b = xr[128 * j + 1]; f[j][0] = a[0]; f[j][1] = a[1]; f[j][2] = a[2]; f[j][3] = a[3]; f[j][4] = b[0]; f[j][5] = b[1]; f[j][6] = b[2]; f[j][7] = b[3]; }
    norm_row_finish(tab, xrow, f, lane);
}
__device__ __forceinline__ void norm_mod_phase(const Params& p, const Ctx& F0, int layer, int which) {
    const Ctx F = fresh(F0);
    const bf16* h = (const bf16*)(p.ws + WS_H); bf16* xn = (bf16*)(p.ws + WS_XN);
    const float* g = p.in[which == 0 ? I_G1 : I_G2] + (size_t)layer * DM;
    const float* modl = (const float*)(p.ws + WS_MOD) + (size_t)layer * 3 * NMOD;
    const int shoff = which == 0 ? 0 : 3 * DM, scoff = shoff + DM;
    LAS float* tab = (LAS float*)F.lds;
    for (int u = F.vcu; u < 256; u += F.G) {
        __syncthreads();
        { const int c4 = 4 * F.tid, li = (F.tid & 1) * 1024 + 4 * (F.tid >> 1);
          const f32x4 gg = *(const f32x4*)(g + c4);
#pragma unroll
          for (int s2 = 0; s2 < 2; ++s2) { const float* md = modl + (size_t)(s2 == 0 ? (u >> 7) : 2) * NMOD;
              const f32x4 sc = *(const f32x4*)(md + scoff + c4), sh = *(const f32x4*)(md + shoff + c4);
              *(LAS f32x4*)(tab + s2 * 4096 + li) = gg * (1.0f + sc); *(LAS f32x4*)(tab + s2 * 4096 + 2048 + li) = sh; } }
        __syncthreads();
        const int row0 = 32 * u + 4 * F.wave;
        if (layer == 0 && which == 0) {
            for (int r = 0; r < 4; ++r) norm_row_f32(p.in[I_X] + (size_t)(row0 + r) * DM, xn + (size_t)(row0 + r) * DM, tab, F.lane);
            if (F.wave < 2) norm_row_f32(p.in[I_CTX] + (size_t)(2 * u + F.wave) * DM, xn + (size_t)(ML + 2 * u + F.wave) * DM, tab + 4096, F.lane);
        } else {
            norm_rows_bf16<4>(h, xn, tab, row0, F.lane);
            if (F.wave < 2 && !(which == 1 && layer + 1 == DEPTH)) norm_rows_bf16<1>(h, xn, tab + 4096, ML + 2 * u + F.wave, F.lane);
        }
    }
}
__device__ __forceinline__ void mixer_prep_phase(const Params& p, const Ctx& F0, int layer) {
    const Ctx F = fresh(F0);
    const int gw = F.vcu * NWAVES + F.wave, NGW = F.G * NWAVES;
    const int gt = F.vcu * NTHR + F.tid, NGT = F.G * NTHR;
    const bf16* P = (const bf16*)(p.ws + WS_P);
    bf16* Qr = (bf16*)(p.ws + WS_QR); bf16* Kc = (bf16*)(p.ws + WS_KC); bf16* Vt = (bf16*)(p.ws + WS_VT); bf16* br = (bf16*)(p.ws + WS_BR);
    const float2* rope = (const float2*)(p.ws + WS_ROPE);
    for (int it = gt; it < MROWS * 128; it += NGT) {
        const int row = it >> 7, w = it & 127, tens = w >> 6, sub = w & 63, hh = sub >> 3, cc = (sub >> 2) & 1, ax = (sub >> 1) & 1, jh = sub & 1;
        const int base = hh * 128 + cc * 64 + ax * 32 + jh * 8;
        const RowInfo ri = row_info(row);
        const bf16* src = P + (size_t)row * NIN + (tens == 0 ? Q_OFF : K_OFF) + base;
        float x1[8], x2[8]; unpack8(*(const u32x4*)src, x1); unpack8(*(const u32x4*)(src + 16), x2);
        float o1[8], o2[8];
        if (!ri.ctx) { const int pa = ax == 0 ? (ri.pos >> 6) : (ri.pos & 63);
#pragma unroll
            for (int e = 0; e < 8; ++e) { const float2 cs = rope[pa * 16 + jh * 8 + e]; o1[e] = x1[e] * cs.x - x2[e] * cs.y; o2[e] = x2[e] * cs.x + x1[e] * cs.y; } }
        else {
#pragma unroll
            for (int e = 0; e < 8; ++e) { o1[e] = x1[e]; o2[e] = x2[e]; } }
        bf16* dst;
        if (tens == 0) {
#pragma unroll
            for (int e = 0; e < 8; ++e) { o1[e] *= QSCALE; o2[e] *= QSCALE; }
            dst = Qr + (size_t)row * QKW + base; }
        else dst = Kc + ((size_t)(ri.b * LK + ri.kv) * QKW + base);
        *(u32x4*)dst = pack8(o1); *(u32x4*)(dst + 16) = pack8(o2);
    }
    const float* cw = p.in[I_CONVW] + (size_t)layer * 3 * 512;
    for (int it = gt; it < MROWS * 64; it += NGT) {
        const int row = it >> 6, j0 = (it & 63) * 8; const RowInfo ri = row_info(row);
        const bf16* pr = P + (size_t)row * NIN + j0;
        float cb[8], a[8], b[8], acc[8];
        unpack8(*(const u32x4*)(pr + CB_OFF), cb);
        unpack8(*(const u32x4*)(pr + CC_OFF), a); unpack8(*(const u32x4*)(pr + CX_OFF), b);
#pragma unroll
        for (int e = 0; e < 8; ++e) acc[e] = a[e] * b[e] * cw[512 + j0 + e];
        if (ri.pos > 0) { unpack8(*(const u32x4*)(pr - NIN + CC_OFF), a); unpack8(*(const u32x4*)(pr - NIN + CX_OFF), b);
#pragma unroll
            for (int e = 0; e < 8; ++e) acc[e] += a[e] * b[e] * cw[j0 + e]; }
        if (ri.pos + 1 < ri.L) { unpack8(*(const u32x4*)(pr + NIN + CC_OFF), a); unpack8(*(const u32x4*)(pr + NIN + CX_OFF), b);
#pragma unroll
            for (int e = 0; e < 8; ++e) acc[e] += a[e] * b[e] * cw[1024 + j0 + e]; }
#pragma unroll
        for (int e = 0; e < 8; ++e) acc[e] *= cb[e];
        *(u32x4*)(br + (size_t)row * DM + 512 + j0) = pack8(acc);
    }
    LAS bf16* scr = (LAS bf16*)(F.lds + F.wave * 16384);
    for (int it = gw; it < (MROWS / 64) * 16; it += NGW) {
        const int tt = it >> 4, ct = it & 15, row0 = tt * 64; const RowInfo ri = row_info(row0);
#pragma unroll
        for (int i = 0; i < 8; ++i) { const int t = i * 8 + (F.lane >> 3), ch = F.lane & 7;
            const u32x4 w = *(const u32x4*)(P + (size_t)(row0 + t) * NIN + V_OFF + ct * 64 + ch * 8);
            const unsigned ww[4] = {w.x, w.y, w.z, w.w};
#pragma unroll
            for (int e = 0; e < 8; ++e) scr[(ch * 8 + e) * 72 + t] = (bf16)((ww[e >> 1] >> ((e & 1) * 16)) & 0xffffu); }
        LDS_WAIT(); asm volatile("" ::: "memory");
#pragma unroll
        for (int i = 0; i < 8; ++i) { const int col = i * 8 + (F.lane >> 3), ch = F.lane & 7;
            const u32x4 w = *(const LAS u32x4*)(scr + col * 72 + ch * 8);
            *(u32x4*)(Vt + ((size_t)(ri.b * QKW + ct * 64 + col) * LK + ri.kv + ch * 8)) = w; }
        LDS_WAIT(); asm volatile("" ::: "memory");
    }
}
__device__ __forceinline__ void ffn_act_phase(const Params& p, const Ctx& F0, int layer) {
    const Ctx F = fresh(F0);
    const int gt = F.vcu * NTHR + F.tid, NGT = F.G * NTHR;
    const bf16* Y = (const bf16*)(p.ws + WS_P); bf16* act = (bf16*)(p.ws + WS_ACT);
    const float* cw = p.in[I_FCONVW] + (size_t)layer * 3 * NUP;
    for (int it = gt; it < MROWS * (DFF / 8); it += NGT) {
        const int row = it / (DFF / 8), j0 = (it % (DFF / 8)) * 8; const RowInfo ri = row_info(row);
        const bf16* pr = Y + (size_t)row * NUP + j0;
        float a[8], v[8], ua[8], uv[8];
        unpack8(*(const u32x4*)pr, a); unpack8(*(const u32x4*)(pr + DFF), v);
#pragma unroll
        for (int e = 0; e < 8; ++e) { ua[e] = a[e] * cw[NUP + j0 + e]; uv[e] = v[e] * cw[NUP + DFF + j0 + e]; }
        if (ri.pos > 0) { unpack8(*(const u32x4*)(pr - NUP), a); unpack8(*(const u32x4*)(pr - NUP + DFF), v);
#pragma unroll
            for (int e = 0; e < 8; ++e) { ua[e] += a[e] * cw[j0 + e]; uv[e] += v[e] * cw[DFF + j0 + e]; } }
        if (ri.pos + 1 < ri.L) { unpack8(*(const u32x4*)(pr + NUP), a); unpack8(*(const u32x4*)(pr + NUP + DFF), v);
#pragma unroll
            for (int e = 0; e < 8; ++e) { ua[e] += a[e] * cw[2 * NUP + j0 + e]; uv[e] += v[e] * cw[2 * NUP + DFF + j0 + e]; } }
        float o[8];
#pragma unroll
        for (int e = 0; e < 8; ++e) o[e] = ua[e] * sigmoidf_(ua[e]) * uv[e];
        *(u32x4*)(act + (size_t)row * DFF + j0) = pack8(o);
    }
}
__device__ __forceinline__ void act_fix_phase(const Params& p, const Ctx& F0, int layer) {
    const Ctx F = fresh(F0);
    const int gt = F.vcu * NTHR + F.tid, NGT = F.G * NTHR;
    const float* halo = (const float*)(p.ws + WS_HALO); bf16* act = (bf16*)(p.ws + WS_ACT);
    const float* cw = p.in[I_FCONVW] + (size_t)layer * 3 * NUP;
    for (int it = gt; it < 30 * 2 * DFF; it += NGT) {
        const int j = it % DFF, rb = it / DFF, side = rb & 1, bi = rb >> 1, pm = bi + bi / 15;
        float ua, uv; int row;
        if (side == 0) {
            const float* hp = halo + (size_t)pm * 8 * DFF, *hn = halo + (size_t)(pm + 1) * 8 * DFF;
            ua = hp[(3 * 2 + 0) * DFF + j] + cw[2 * NUP + j] * hn[(0 * 2 + 0) * DFF + j]; uv = hp[(3 * 2 + 1) * DFF + j] + cw[2 * NUP + DFF + j] * hn[(0 * 2 + 1) * DFF + j]; row = pm * 256 + 255;
        } else {
            const float* hp = halo + (size_t)pm * 8 * DFF, *hn = halo + (size_t)(pm + 1) * 8 * DFF;
            ua = hn[(2 * 2 + 0) * DFF + j] + cw[j] * hp[(1 * 2 + 0) * DFF + j]; uv = hn[(2 * 2 + 1) * DFF + j] + cw[DFF + j] * hp[(1 * 2 + 1) * DFF + j]; row = (pm + 1) * 256;
        }
        act[(size_t)row * DFF + j] = (bf16)pk2(ua * sigmoidf_(ua) * uv, 0.f);
    }
}
__device__ __forceinline__ void final_norm_phase(const Params& p, const Ctx& F0) {
    const Ctx F = fresh(F0);
    const int gw = F.vcu * NWAVES + F.wave, NGW = F.G * NWAVES;
    const bf16* h = (const bf16*)(p.ws + WS_H); const float* g = p.in[I_GFIN];
    for (int row = gw; row < ML; row += NGW) {
        const u32x4* xr = (const u32x4*)(h + (size_t)row * DM) + F.lane;
        float v[4][8]; float ss = 0.f;
#pragma unroll
        for (int j = 0; j < 4; ++j) { unpack8(xr[64 * j], v[j]);
#pragma unroll
            for (int e = 0; e < 8; ++e) ss += v[j][e] * v[j][e]; }
        const float rstd = rsqrtf(wave_sum(ss) * (1.0f / DM) + EPS_RMS);
#pragma unroll
        for (int j = 0; j < 4; ++j) { const int col = 8 * (F.lane + 64 * j); const f32x4 g0 = *(const f32x4*)(g + col), g1 = *(const f32x4*)(g + col + 4);
            f32x4* orow = (f32x4*)(p.out + (size_t)row * DM + col);
            orow[0] = (f32x4){v[j][0], v[j][1], v[j][2], v[j][3]} * rstd * g0; orow[1] = (f32x4){v[j][4], v[j][5], v[j][6], v[j][7]} * rstd * g1; }
    }
}

constexpr float AT_TRIG = 65536.0f;
constexpr int AT_KP = 144;
constexpr int AT_K0 = 0, AT_K1 = 64 * AT_KP, AT_V = 2 * 64 * AT_KP, AT_STG = AT_V + 128 * AT_KP;
__device__ __forceinline__ float swap32_max(float v) { auto rr = __builtin_amdgcn_permlane32_swap(__float_as_uint(v), __float_as_uint(v), false, false); return fmaxf(__uint_as_float(rr[0]), __uint_as_float(rr[1])); }
__device__ __forceinline__ float swap32_sum(float v) { auto rr = __builtin_amdgcn_permlane32_swap(__float_as_uint(v), __float_as_uint(v), false, false); return __uint_as_float(rr[0]) + __uint_as_float(rr[1]); }
__device__ __forceinline__ void attn_unit(const Params& p, const Ctx& F0, int layer, int b, int h, int qrow0, int nk) {
    const Ctx F = fresh(F0);
    const bf16* Qr = (const bf16*)(p.ws + WS_QR); const bf16* Kc = (const bf16*)(p.ws + WS_KC) + (size_t)b * LK * QKW + h * 128; const bf16* Vt = (const bf16*)(p.ws + WS_VT) + (size_t)(b * QKW + h * 128) * LK;
    bf16* br = (bf16*)(p.ws + WS_BR);
    const int tid = F.tid, lane = F.lane, wid = F.wave, comp = wid >> 2, qw = wid & 3, r32 = lane & 31, hi = lane >> 5;
    LAS unsigned char* lds = F.lds;
    const int srow = tid >> 3, sch = tid & 7;
    const bf16* gk = Kc + (size_t)srow * QKW + sch * 8;
    const bf16* gv = Vt + (size_t)srow * LK + sch * 8;
    const int sk = srow * AT_KP + sch * 16;
    u32x4 st0, st1, st2, st3;
#define AT_LOAD(t) do { const bf16* k_ = gk + (size_t)(t) * 64 * QKW; const bf16* v_ = gv + (t) * 64; st0 = *(const u32x4*)k_; st1 = *(const u32x4*)(k_ + 64); st2 = *(const u32x4*)v_; st3 = *(const u32x4*)(v_ + (size_t)64 * LK); } while (0)
#define AT_STORE(s) do { LAS unsigned char* d_ = lds + (s) * AT_STG; *(LAS u32x4*)(d_ + AT_K0 + sk) = st0; *(LAS u32x4*)(d_ + AT_K1 + sk) = st1; *(LAS u32x4*)(d_ + AT_V + sk) = st2; *(LAS u32x4*)(d_ + AT_V + 64 * AT_KP + sk) = st3; } while (0)
    const int nt = nk / 64;
    AT_LOAD(0);
    bf16x8 qf[4];
    { const bf16* qp = Qr + (size_t)(qrow0 + qw * 32 + r32) * QKW + h * 128 + comp * 64 + hi * 8;
#pragma unroll
      for (int d0 = 0; d0 < 4; ++d0) qf[d0] = *(const bf16x8*)(qp + d0 * 16); }
    AT_STORE(0);
    f32x16 ot[4];
#pragma unroll
    for (int i = 0; i < 4; ++i)
#pragma unroll
        for (int r = 0; r < 16; ++r) ot[i][r] = 0.f;
    float mrun = 0.f, lrun = 0.f;
    const int krow = (r32 & 19) | ((r32 & 4) << 1) | ((r32 & 8) >> 1);
    const int kfo = (comp ? AT_K1 : AT_K0) + krow * AT_KP + hi * 16;
    const int vfo = AT_V + r32 * AT_KP + hi * 16;
    bf16x8 pprev[4];
#pragma unroll
    for (int i = 0; i < 4; ++i) pprev[i] = (bf16x8){0, 0, 0, 0, 0, 0, 0, 0};
    bf16x8 va0, va1, va2, va3, vb0, vb1, vb2, vb3;
    va0 = va1 = va2 = va3 = (bf16x8){0, 0, 0, 0, 0, 0, 0, 0};
#define AT_VRD(vb_, f_) (*(const LAS bf16x8*)((vb_) + ((f_) & 3) * 32 * AT_KP + ((f_) >> 2) * 32))
#define AT_SB() __builtin_amdgcn_sched_barrier(0)
#define AT_PVPRE(stage_) do { const LAS unsigned char* vb_ = lds + (stage_) * AT_STG + vfo; va0 = AT_VRD(vb_, 0); va1 = AT_VRD(vb_, 1); va2 = AT_VRD(vb_, 2); va3 = AT_VRD(vb_, 3); } while (0)
#define AT_MF(i_, v_, g_, pf_) ot[i_] = __builtin_amdgcn_mfma_f32_32x32x16_bf16(v_, pf_[g_], ot[i_], 0, 0, 0)
#define AT_PV(stage_, pf_) do { const LAS unsigned char* vb_ = lds + (stage_) * AT_STG + vfo; AT_SB(); \
        vb0 = AT_VRD(vb_, 4);  AT_MF(0, va0, 0, pf_); AT_SB(); vb1 = AT_VRD(vb_, 5);  AT_MF(1, va1, 0, pf_); AT_SB(); vb2 = AT_VRD(vb_, 6);  AT_MF(2, va2, 0, pf_); AT_SB(); vb3 = AT_VRD(vb_, 7);  AT_MF(3, va3, 0, pf_); AT_SB(); \
        va0 = AT_VRD(vb_, 8);  AT_MF(0, vb0, 1, pf_); AT_SB(); va1 = AT_VRD(vb_, 9);  AT_MF(1, vb1, 1, pf_); AT_SB(); va2 = AT_VRD(vb_, 10); AT_MF(2, vb2, 1, pf_); AT_SB(); va3 = AT_VRD(vb_, 11); AT_MF(3, vb3, 1, pf_); AT_SB(); \
        vb0 = AT_VRD(vb_, 12); AT_MF(0, va0, 2, pf_); AT_SB(); vb1 = AT_VRD(vb_, 13); AT_MF(1, va1, 2, pf_); AT_SB(); vb2 = AT_VRD(vb_, 14); AT_MF(2, va2, 2, pf_); AT_SB(); vb3 = AT_VRD(vb_, 15); AT_MF(3, va3, 2, pf_); AT_SB(); \
        AT_MF(0, vb0, 3, pf_); AT_MF(1, vb1, 3, pf_); AT_MF(2, vb2, 3, pf_); AT_MF(3, vb3, 3, pf_); AT_SB(); } while (0)
    __syncthreads();
    int s_prev = 2, s_cur = 0, s_next = 1;
    for (int t = 0; t < nt; ++t) {
        if (t + 1 < nt) AT_LOAD(t + 1);
        bf16x8 kf[8];
        { const LAS unsigned char* kb_ = lds + s_cur * AT_STG + kfo;
#pragma unroll
          for (int f = 0; f < 8; ++f) kf[f] = *(const LAS bf16x8*)(kb_ + (f >> 2) * 32 * AT_KP + (f & 3) * 32); }
        if (comp && t > 0) AT_PV(s_prev, pprev);
        const LAS unsigned char* sb = lds + s_cur * AT_STG;
        f32x16 sc[2];
        const bool ref0 = !__any(mrun != 0.f);
#define AT_QK() do { AT_SB(); _Pragma("unroll") for (int d0 = 0; d0 < 4; ++d0) { sc[0] = __builtin_amdgcn_mfma_f32_32x32x16_bf16(kf[d0], qf[d0], sc[0], 0, 0, 0); sc[1] = __builtin_amdgcn_mfma_f32_32x32x16_bf16(kf[4 + d0], qf[d0], sc[1], 0, 0, 0); } AT_SB(); } while (0)
        if (ref0) {
#pragma unroll
            for (int r = 0; r < 16; ++r) { sc[0][r] = 0.f; sc[1][r] = 0.f; }
            AT_QK();
        } else {
#pragma unroll
            for (int r = 0; r < 16; ++r) { sc[0][r] = -mrun; sc[1][r] = -mrun; }
            AT_QK();
        }
#undef AT_QK
        if (!comp) AT_PVPRE(s_cur);
        f32x16 ex[2];
#pragma unroll
        for (int kh = 0; kh < 2; ++kh)
#pragma unroll
            for (int r = 0; r < 16; ++r) ex[kh][r] = __builtin_amdgcn_exp2f(sc[kh][r]);
        float ps;
        { float a0 = ex[0][0], a1 = ex[1][0];
#pragma unroll
          for (int r = 1; r < 16; ++r) { a0 += ex[0][r]; if ((r & 3) == 3) asm volatile("" : "+v"(a0)); }
#pragma unroll
          for (int r = 1; r < 16; ++r) { a1 += ex[1][r]; if ((r & 3) == 1) asm volatile("" : "+v"(a1)); }
          ps = a0 + a1; }
        const float pst = swap32_sum(ps);
        if (t == 0 || __any(!(pst < AT_TRIG))) {
            float mx = fmaxf(sc[0][0], sc[1][0]);
#pragma unroll
            for (int r = 1; r < 16; ++r) mx = fmaxf(mx, fmaxf(sc[0][r], sc[1][r]));
            mx = swap32_max(mx);
            const float dl = (!(pst < AT_TRIG) || (t == 0 && fabsf(mx) > 16.f)) ? mx : 0.f;
            mrun += dl;
            const float alpha = __builtin_amdgcn_exp2f(-dl);
            lrun *= alpha;
            ps = 0.f;
#pragma unroll
            for (int kh = 0; kh < 2; ++kh)
#pragma unroll
                for (int r = 0; r < 16; ++r) { const float e = __builtin_amdgcn_exp2f(sc[kh][r] - dl); ex[kh][r] = e; ps += e; }
            if (t > 0) {
#pragma unroll
                for (int i = 0; i < 4; ++i)
#pragma unroll
                    for (int r = 0; r < 16; ++r) ot[i][r] *= alpha;
            }
        }
        lrun += ps;
#pragma unroll
        for (int kh = 0; kh < 2; ++kh)
#pragma unroll
            for (int s2 = 0; s2 < 2; ++s2) {
                u32x4 pw; pw.x = pk2(ex[kh][8 * s2 + 0], ex[kh][8 * s2 + 1]); pw.y = pk2(ex[kh][8 * s2 + 2], ex[kh][8 * s2 + 3]); pw.z = pk2(ex[kh][8 * s2 + 4], ex[kh][8 * s2 + 5]); pw.w = pk2(ex[kh][8 * s2 + 6], ex[kh][8 * s2 + 7]);
                pprev[kh * 2 + s2] = __builtin_bit_cast(bf16x8, pw);
            }
        if (!comp) AT_PV(s_cur, pprev);
        if (t + 1 < nt) AT_STORE(s_next);
        if (comp) AT_PVPRE(s_cur);
        __syncthreads();
        { const int tmp = s_prev; s_prev = s_cur; s_cur = s_next; s_next = tmp; }
    }
    if (comp) AT_PV(s_prev, pprev);
    __syncthreads();
#undef AT_PV
#undef AT_PVPRE
#undef AT_MF
#undef AT_VRD
    const float ltot = swap32_sum(lrun);
    const float lam = ((const float*)(p.ws + WS_LAM))[layer];
    const float inv = comp ? lam / ltot : 1.0f / ltot;
    LAS float* xb = (LAS float*)lds;
    if (comp) {
#pragma unroll
        for (int i = 0; i < 4; ++i)
#pragma unroll
            for (int r = 0; r < 16; ++r) xb[(qw * 64 + i * 16 + r) * 64 + lane] = ot[i][r] * inv;
    }
    __syncthreads();
    if (!comp) {
        float ss = 0.f;
#pragma unroll
        for (int i = 0; i < 4; ++i)
#pragma unroll
            for (int r = 0; r < 16; ++r) { const float o = ot[i][r] * inv - xb[(qw * 64 + i * 16 + r) * 64 + lane]; ot[i][r] = o; ss += o * o; }
        ss = swap32_sum(ss);
        const float lam_init = 0.8f - 0.6f * __expf(-0.3f * (float)layer);
        const float rs = rsqrtf(ss * (1.0f / 128.0f) + EPS_SUBLN) * (1.0f - lam_init);
        const float* sg = p.in[I_SUBG] + layer * VD;
        bf16* op = br + (size_t)(qrow0 + qw * 32 + r32) * DM + 1024 + h * 128;
#pragma unroll
        for (int i = 0; i < 4; ++i)
#pragma unroll
            for (int g4 = 0; g4 < 4; ++g4) { const int dv = 32 * i + 8 * g4 + 4 * hi; const f32x4 gg = *(const f32x4*)(sg + dv);
                u32x2 w; w.x = pk2(ot[i][4 * g4 + 0] * rs * gg[0], ot[i][4 * g4 + 1] * rs * gg[1]); w.y = pk2(ot[i][4 * g4 + 2] * rs * gg[2], ot[i][4 * g4 + 3] * rs * gg[3]);
                *(u32x2*)(op + dv) = w; }
    }
    __syncthreads();
#undef AT_LOAD
#undef AT_STORE
}
__device__ __forceinline__ void attn_phase(const Params& p, const Ctx& F, int layer) {
    const int nunit = layer + 1 < DEPTH ? 512 + 32 : 512;
    for (int u = F.vcu; u < nunit; u += F.G) {
        if (u < 512) { const int bh = u >> 5, qb = u & 31, b = bh >> 3, h = bh & 7; attn_unit(p, F, layer, b, h, b * SEQ + qb * 128, LK); }
        else { const int v = u - 512, bh = v >> 1, qb = v & 1, b = bh >> 3, h = bh & 7; attn_unit(p, F, layer, b, h, ML + b * CTXL + qb * 128, CTXL); }
    }
}

constexpr int FM_PITCH = 288, FM_WA = 0, FM_WC = 128 * FM_PITCH, FM_IMG = FM_WC + 64 * FM_PITCH, FM_IMGB = 64 * FM_PITCH;
__device__ __forceinline__ void fmix_phase(const Params& p, const Ctx& F0) {
    const Ctx F = fresh(F0);
    LAS unsigned char* lds = F.lds;
    const bf16* T = (const bf16*)(p.ws + WS_T); bf16* br = (bf16*)(p.ws + WS_BR); const float2* tw = (const float2*)(p.ws + WS_FTW);
    for (int idx = F.tid; idx < 128 * 16; idx += NTHR) { const int r = idx >> 4, ch = idx & 15; *(LAS u32x4*)(lds + FM_WA + r * FM_PITCH + ch * 16) = *(const u32x4*)((const bf16*)(p.ws + WS_FWA) + r * 128 + ch * 8); }
    for (int idx = F.tid; idx < 64 * 16; idx += NTHR) { const int r = idx >> 4, ch = idx & 15; *(LAS u32x4*)(lds + FM_WC + r * FM_PITCH + ch * 16) = *(const u32x4*)((const bf16*)(p.ws + WS_FWC) + r * 128 + ch * 8); }
    const int c = F.wave >> 1, h = F.wave & 1, l15 = F.lane & 15, kq = F.lane >> 4;
    LAS unsigned char* img = lds + FM_IMG + c * FM_IMGB;
    for (int u = F.vcu; u < 256; u += F.G) {
        const int batch = u >> 7, n0 = (u & 127) * 4;
        __syncthreads();
#pragma unroll
        for (int it = 0; it < 8; ++it) { const int cc = it >> 1, part = it & 1, a = F.lane, bg = F.wave;
            const u32x4 w = *(const u32x4*)(T + ((size_t)(batch * 512 + n0 + cc) * (2 * SEQ) + part * SEQ + 64 * a + 8 * bg));
            LAS bf16* d = (LAS bf16*)(lds + FM_IMG + cc * FM_IMGB + (8 * bg) * FM_PITCH + (part * 64 + a) * 2);
            const unsigned ww[4] = {w.x, w.y, w.z, w.w};
#pragma unroll
            for (int e = 0; e < 8; ++e) d[e * (FM_PITCH / 2)] = (bf16)((ww[e >> 1] >> ((e & 1) * 16)) & 0xffffu); }
        __syncthreads();
        f32x4 ya[4][4];
#pragma unroll
        for (int mi = 0; mi < 4; ++mi)
#pragma unroll
            for (int nt = 0; nt < 4; ++nt) ya[mi][nt] = (f32x4){0.f, 0.f, 0.f, 0.f};
#pragma unroll
        for (int ks = 0; ks < 4; ++ks) {
            bf16x8 af[4], bfr[4];
#pragma unroll
            for (int mi = 0; mi < 4; ++mi) { const int mt = (mi >> 1) * 4 + 2 * h + (mi & 1); af[mi] = *(const LAS bf16x8*)(lds + FM_WA + (16 * mt + l15) * FM_PITCH + (32 * ks + 8 * kq) * 2); }
#pragma unroll
            for (int nt = 0; nt < 4; ++nt) bfr[nt] = *(const LAS bf16x8*)(img + (16 * nt + l15) * FM_PITCH + (32 * ks + 8 * kq) * 2);
#pragma unroll
            for (int mi = 0; mi < 4; ++mi)
#pragma unroll
                for (int nt = 0; nt < 4; ++nt) ya[mi][nt] = __builtin_amdgcn_mfma_f32_16x16x32_bf16(af[mi], bfr[nt], ya[mi][nt], 0, 0, 0);
        }
        __syncthreads();
#pragma unroll
        for (int mi = 0; mi < 2; ++mi)
#pragma unroll
            for (int nt = 0; nt < 4; ++nt)
#pragma unroll
                for (int r = 0; r < 4; ++r) { const int ap = 16 * (2 * h + mi) + 4 * kq + r, b = 16 * nt + l15; const float2 cs = tw[ap * b];
                    const float yre = ya[mi][nt][r], yim = ya[2 + mi][nt][r];
                    LAS bf16* d = (LAS bf16*)(img + ap * FM_PITCH + b * 2);
                    d[0] = (bf16)f2bf(yre * cs.x + yim * cs.y); d[64] = (bf16)f2bf(yim * cs.x - yre * cs.y); }
        __syncthreads();
        f32x4 xa[2][4];
#pragma unroll
        for (int mi = 0; mi < 2; ++mi)
#pragma unroll
            for (int nt = 0; nt < 4; ++nt) xa[mi][nt] = (f32x4){0.f, 0.f, 0.f, 0.f};
#pragma unroll
        for (int ks = 0; ks < 4; ++ks) {
            bf16x8 af[2], bfr[4];
#pragma unroll
            for (int mi = 0; mi < 2; ++mi) af[mi] = *(const LAS bf16x8*)(img + (16 * (2 * h + mi) + l15) * FM_PITCH + (32 * ks + 8 * kq) * 2);
#pragma unroll
            for (int nt = 0; nt < 4; ++nt) bfr[nt] = *(const LAS bf16x8*)(lds + FM_WC + (16 * nt + l15) * FM_PITCH + (32 * ks + 8 * kq) * 2);
#pragma unroll
            for (int mi = 0; mi < 2; ++mi)
#pragma unroll
                for (int nt = 0; nt < 4; ++nt) xa[mi][nt] = __builtin_amdgcn_mfma_f32_16x16x32_bf16(af[mi], bfr[nt], xa[mi][nt], 0, 0, 0);
        }
        __syncthreads();
        LAS bf16* xs = (LAS bf16*)(lds + FM_IMG);
#pragma unroll
        for (int mi = 0; mi < 2; ++mi)
#pragma unroll
            for (int nt = 0; nt < 4; ++nt)
#pragma unroll
                for (int r = 0; r < 4; ++r) { const int ap = 16 * (2 * h + mi) + 4 * kq + r, bp = 16 * nt + l15; xs[(ap + 64 * bp) * 4 + c] = (bf16)f2bf(xa[mi][nt][r]); }
        __syncthreads();
#pragma unroll
        for (int it = 0; it < 8; ++it) { const int lp = F.tid + NTHR * it; *(u32x2*)(br + (size_t)(batch * SEQ + lp) * DM + n0) = *(const LAS u32x2*)(xs + lp * 4); }
    }
    __syncthreads();
}

constexpr int CG_STG = 32768, CG_B = 16384;
template <int MODE> __device__ __forceinline__ void ctx_gemm(const Params& p, const Ctx& F0, int layer) {
    const Ctx F = fresh(F0);
    const bf16* A; const bf16* Bt; int lda, K;
    if (MODE == 0) { A = (const bf16*)(p.ws + WS_BR); Bt = wl(p, layer, W_BM); lda = DM; K = DM; }
    else if (MODE == 1) { A = (const bf16*)(p.ws + WS_MRG); Bt = wl(p, layer, W_OUT); lda = DM; K = DM; }
    else if (MODE == 2) { A = (const bf16*)(p.ws + WS_ACT); Bt = wl(p, layer, W_DOWN); lda = DFF; K = DFF; }
    else { A = (const bf16*)(p.ws + WS_DC); Bt = (const bf16*)(p.ws + WS_TC); lda = 2 * CTXL; K = 2 * CTXL; }
    const int NU = MODE == 3 ? 64 : 256;
    const int ldb = lda, fr = F.lane & 15, fq = F.lane >> 4, nch = K / 128;
    LAS unsigned char* lds = F.lds;
    const int rb = F.wave >> 1, cb0 = 2 * (F.wave & 1);
    const int dr = 8 * F.wave + (F.lane >> 4), dp = F.lane & 15;
    for (int u = F.vcu; u < NU; u += F.G) {
        int row0 = ML + (u & 7) * 64, col0 = ((u >> 5) * 4 + ((u >> 3) & 3)) * 64;
        size_t arow = (size_t)row0, brow = (size_t)col0;
        if (MODE == 3) { const int b3 = u >> 5, rk = (u >> 3) & 3, ck = u & 7; row0 = ML + b3 * CTXL + rk * 64; col0 = ck * 64; arow = (size_t)rk * 64; brow = (size_t)b3 * 512 + ck * 64; }
        const bf16* ga0 = A + (size_t)(arow + dr) * lda + ((dp ^ (dr & 15)) << 3); const bf16* ga1 = A + (size_t)(arow + dr + 4) * lda + ((dp ^ ((dr + 4) & 15)) << 3);
        const bf16* gb0 = Bt + (size_t)(brow + dr) * ldb + ((dp ^ (dr & 15)) << 3); const bf16* gb1 = Bt + (size_t)(brow + dr + 4) * ldb + ((dp ^ ((dr + 4) & 15)) << 3);
#define CG_DMA(t) do { LAS unsigned char* d_ = lds + ((t) & 3) * CG_STG + F.wave * 2048; const int ko_ = (t) * 128; \
        __builtin_amdgcn_global_load_lds((const unsigned*)(ga0 + ko_), (LAS unsigned*)(d_), 16, 0, 0); __builtin_amdgcn_global_load_lds((const unsigned*)(ga1 + ko_), (LAS unsigned*)(d_ + 1024), 16, 0, 0); \
        __builtin_amdgcn_global_load_lds((const unsigned*)(gb0 + ko_), (LAS unsigned*)(d_ + CG_B), 16, 0, 0); __builtin_amdgcn_global_load_lds((const unsigned*)(gb1 + ko_), (LAS unsigned*)(d_ + CG_B + 1024), 16, 0, 0); } while (0)
        asm volatile("s_waitcnt vmcnt(0) lgkmcnt(0)\n\ts_barrier" ::: "memory");
        const int nsc = nch / 2;
        CG_DMA(0); CG_DMA(1);
        f32x4 acc[2] = {{0.f, 0.f, 0.f, 0.f}, {0.f, 0.f, 0.f, 0.f}}, tot[2] = {{0.f, 0.f, 0.f, 0.f}, {0.f, 0.f, 0.f, 0.f}};
        asm volatile("s_waitcnt vmcnt(0)\n\ts_barrier" ::: "memory");
        const int ao = (16 * rb + fr) * 256, bo = CG_B + (16 * cb0 + fr) * 256;
        for (int sc = 0; sc < nsc; ++sc) {
            if (sc + 1 < nsc) { CG_DMA(2 * sc + 2); CG_DMA(2 * sc + 3); }
#pragma unroll
            for (int hh = 0; hh < 2; ++hh) {
                const LAS unsigned char* sb = lds + ((2 * sc + hh) & 3) * CG_STG;
#pragma unroll
                for (int ks = 0; ks < 4; ++ks) { const int po = ((4 * ks + fq) ^ fr) << 4;
                    const bf16x8 af = *(const LAS bf16x8*)(sb + ao + po), b0 = *(const LAS bf16x8*)(sb + bo + po), b1 = *(const LAS bf16x8*)(sb + bo + 16 * 256 + po);
                    acc[0] = __builtin_amdgcn_mfma_f32_16x16x32_bf16(b0, af, acc[0], 0, 0, 0); acc[1] = __builtin_amdgcn_mfma_f32_16x16x32_bf16(b1, af, acc[1], 0, 0, 0); }
            }
            if (MODE == 0 && (sc == 1 || sc == 3 || sc == 7)) {
                const int goff = sc == 1 ? 0 : (sc == 3 ? DM : 2 * DM);
#pragma unroll
                for (int j = 0; j < 2; ++j) { const unsigned gw = *(const unsigned*)((const unsigned char*)(p.ws + WS_G8) + (size_t)(row0 + 16 * rb + fr) * NG8 + goff + col0 + 16 * (cb0 + j) + 4 * fq);
#pragma unroll
                    for (int i = 0; i < 4; ++i) { tot[j][i] += ((float)((gw >> (8 * i)) & 255u) * (1.0f / 255.0f)) * acc[j][i]; acc[j][i] = 0.f; } }
            }
            asm volatile("s_waitcnt vmcnt(0) lgkmcnt(0)\n\ts_barrier" ::: "memory");
        }
#undef CG_DMA
#pragma unroll
        for (int j = 0; j < 2; ++j) { const int row = row0 + 16 * rb + fr, col = col0 + 16 * (cb0 + j) + 4 * fq;
            if (MODE == 0) { u32x2 w; w.x = pk2(tot[j][0], tot[j][1]); w.y = pk2(tot[j][2], tot[j][3]); *(u32x2*)((bf16*)(p.ws + WS_MRG) + (size_t)row * DM + col) = w; }
            else if (MODE == 3) { u32x2 w; w.x = pk2(acc[j][0], acc[j][1]); w.y = pk2(acc[j][2], acc[j][3]); *(u32x2*)((bf16*)(p.ws + WS_BR) + (size_t)row * DM + col) = w; }
            else { const f32x4 gt = *(const f32x4*)((const float*)(p.ws + WS_MOD) + ((size_t)layer * 3 + 2) * NMOD + (MODE == 1 ? 2 * DM : 5 * DM) + col);
                bf16* hp = (bf16*)(p.ws + WS_H) + (size_t)row * DM + col;
                f32x4 sv;
                if (MODE == 1 && layer == 0) sv = *(const f32x4*)(p.in[I_CTX] + (size_t)(row - ML) * DM + col);
                else { const u32x2 hw = *(const u32x2*)hp; sv = (f32x4){bflo(hw.x), bfhi(hw.x), bflo(hw.y), bfhi(hw.y)}; }
                const f32x4 r = sv + gt * acc[j];
                u32x2 w; w.x = pk2(r[0], r[1]); w.y = pk2(r[2], r[3]); *(u32x2*)hp = w; } }
    }
    asm volatile("s_waitcnt vmcnt(0) lgkmcnt(0)" ::: "memory");
    __syncthreads();
}

constexpr int STEPS_PER_LAYER = 10, N_STEPS = 1 + DEPTH * STEPS_PER_LAYER + 1;
enum { SK_GEMM = 1, SK_ATTN = 2 };
struct Args { Params p; int lo, hi, li, skip; };
template <class E> __device__ __forceinline__ void run_gemm(const Ctx& F, const GemmJob& j, const E& e, int rot) {
    int c = (int)((blockIdx.x + (unsigned)rot) % (unsigned)F.G); asm volatile("" : "+s"(c));
    pg8::Sched S; S.init(j, F.G, c);
    int wv = F.wave; asm volatile("" : "+s"(wv));
    pg8::gemm_phase<E>(F.lds, j, S, e, wv);
}
__global__ void __launch_bounds__(NTHR, 2) mega(Args a) {
    extern __shared__ __attribute__((aligned(16))) unsigned char lds_raw[];
    Ctx F; F.lds = (LAS unsigned char*)lds_raw; F.tid = threadIdx.x; F.lane = F.tid & 63; F.wave = __builtin_amdgcn_readfirstlane(F.tid >> 6);
    F.G = gridDim.x; { const int bx = blockIdx.x; F.vcu = (F.G % 8 == 0) ? (bx % 8) * (F.G / 8) + bx / 8 : bx; }
    const Params& p = a.p;
    volatile LAS unsigned* MISC = (volatile LAS unsigned*)(F.lds + MISC_OFF);
    if (F.tid < 64) MISC[F.tid] = 0u;
    __syncthreads();
    XcdBarrier bar; bar.bar = (unsigned*)(p.ws + WS_CTL) + CW_BAR + a.li * 4096; bar.x = 0; bar.st = MISC + 8;
    if (a.hi - a.lo > 1) bar = xcd_barrier_post(bar.bar, MISC + 8);
    const int lo = a.lo, hi = a.hi;
    const bool do_gemm = !(a.skip & SK_GEMM), do_attn = !(a.skip & SK_ATTN);
#define IN(k) (lo <= (k) && (k) < hi)
#define SEAM(k) do { if (IN(k) && IN((k) + 1)) xcd_barrier(bar); } while (0)
#define REPEAT(k, body) do { _Pragma("nounroll") for (int r_ = 0; r_ < ((PROBE_STEP == (k)) ? 1 + PROBE_REP : 1); ++r_) { const bool first_ = (r_ == 0); (void)first_; body; if (r_ + 1 < ((PROBE_STEP == (k)) ? 1 + PROBE_REP : 1)) xcd_barrier(bar); } } while (0)
    if (IN(0)) REPEAT(10, { prologue(p, F); __syncthreads(); });
    SEAM(0);
    for (int l = 0; l < DEPTH; ++l) {
        const int s0 = 1 + l * STEPS_PER_LAYER;
        if (IN(s0 + 0)) REPEAT(0, norm_mod_phase(p, F, l, 0));
        SEAM(s0 + 0);
        if (IN(s0 + 1) && do_gemm) REPEAT(1, run_gemm(F, job_win(p, l), EWin{(bf16*)(p.ws + WS_P), (unsigned char*)(p.ws + WS_G8)}, 0));
        SEAM(s0 + 1);
        if (IN(s0 + 2)) REPEAT(2, {
            mixer_prep_phase(p, F, l); __syncthreads();
            if (do_gemm) { run_gemm(F, job_f1(p, false), epi_f1(p, false), 0); run_gemm(F, job_f1(p, true), epi_f1(p, true), F.G - 128); }
        });
        SEAM(s0 + 2);
        if (IN(s0 + 3)) {
#if MK_FFT
            REPEAT(30, { if (do_gemm) { fmix_phase(p, F); if (l + 1 < DEPTH) ctx_gemm<3>(p, F, l); } });
#else
            REPEAT(30, { if (do_gemm) { run_gemm(F, job_f2(p, false), epi_f2(p, false), 0); run_gemm(F, job_f2(p, true), epi_f2(p, true), F.G - 64); } });
#endif
            REPEAT(31, { if (do_attn) attn_phase(p, F, l); });
        }
        SEAM(s0 + 3);
        if (IN(s0 + 4) && do_gemm) REPEAT(4, { run_gemm(F, job_merge1(p, l), EMerge1{(const unsigned char*)(p.ws + WS_G8), (bf16*)(p.ws + WS_MRG)}, 0); if (l + 1 < DEPTH) ctx_gemm<0>(p, F, l); });
        SEAM(s0 + 4);
        if (IN(s0 + 5) && do_gemm) REPEAT(5, { if (first_) { run_gemm(F, job_out(p, l, ML), epi_resid(p, l, 0), 0); if (l + 1 < DEPTH) ctx_gemm<1>(p, F, l); } else run_gemm(F, job_out(p, l, ML), EStore{(bf16*)(p.ws + WS_MACC), DM, 0, 0}, 0); });
        SEAM(s0 + 5);
        if (IN(s0 + 6)) REPEAT(6, norm_mod_phase(p, F, l, 1));
        SEAM(s0 + 6);
#if MK_FUSE_ACT
        if (IN(s0 + 7) && do_gemm) REPEAT(7, run_gemm(F, job_up(p, l), EUpAct{(bf16*)(p.ws + WS_ACT), p.in[I_FCONVW] + (size_t)l * 3 * NUP, (float*)(p.ws + WS_HALO), (LAS float*)(F.lds + MISC_OFF + 1024)}, 0));
#else
        if (IN(s0 + 7) && do_gemm) REPEAT(7, run_gemm(F, job_up(p, l), epi_p(p), 0));
#endif
        SEAM(s0 + 7);
#if MK_FUSE_ACT
        if (IN(s0 + 8)) REPEAT(8, act_fix_phase(p, F, l));
#else
        if (IN(s0 + 8)) REPEAT(8, ffn_act_phase(p, F, l));
#endif
        SEAM(s0 + 8);
        if (IN(s0 + 9) && do_gemm) REPEAT(9, { if (first_) { run_gemm(F, job_down(p, l, ML), epi_resid(p, l, 1), 0); if (l + 1 < DEPTH) ctx_gemm<2>(p, F, l); } else run_gemm(F, job_down(p, l, ML), EStore{(bf16*)(p.ws + WS_MACC), DM, 0, 0}, 0); });
        SEAM(s0 + 9);
    }
    if (IN(N_STEPS - 1)) final_norm_phase(p, F);
#undef REPEAT
#undef IN
#undef SEAM
}

extern "C" void kernel_launch(void* const* d_in, const int* in_sizes, int n_in, void* d_out, int out_size, void* d_ws, size_t ws_size, hipStream_t stream) {
    static int grid = 0;
    if (grid == 0) {
        if (n_in != 20 || out_size != ML * DM || ws_size < WS_END) { fprintf(stderr, "kernel_launch: unexpected shapes (n_in %d out %d ws %zu)\n", n_in, out_size, ws_size); grid = -1; return; }
        int dev = 0, cus = 0, per_cu = 0;
        if (hipGetDevice(&dev) != hipSuccess || hipDeviceGetAttribute(&cus, hipDeviceAttributeMultiprocessorCount, dev) != hipSuccess) { grid = -1; return; }
        if (hipFuncSetAttribute((const void*)mega, hipFuncAttributeMaxDynamicSharedMemorySize, LDS_BYTES) != hipSuccess) { fprintf(stderr, "kernel_launch: hipFuncSetAttribute failed\n"); grid = -1; return; }
        if (hipOccupancyMaxActiveBlocksPerMultiprocessor(&per_cu, (const void*)mega, NTHR, LDS_BYTES) != hipSuccess || per_cu < 1) fprintf(stderr, "kernel_launch: occupancy query says %d\n", per_cu);
        (void)hipGetLastError();
        grid = cus;
    }
    if (grid < 0) return;
    (void)hipMemsetAsync((char*)d_ws + WS_CTL, 0, CTL_BYTES, stream);
    Args a{};
    for (int i = 0; i < 20; ++i) a.p.in[i] = (const float*)d_in[i];
    a.p.out = (float*)d_out; a.p.ws = (unsigned char*)d_ws;
    const Params& p = a.p;
#if MK_ONE_LAUNCH
    a.lo = 0; a.hi = N_STEPS; a.li = 0; a.skip = 0;
    hipLaunchKernelGGL(mega, dim3(grid), dim3(NTHR), LDS_BYTES, stream, a);
#else
    a.skip = (MK_SIMPLE_GEMM ? SK_GEMM : 0) | (MK_SIMPLE_ATTN ? SK_ATTN : 0);
    int li = 0;
    for (int s = 0; s < N_STEPS; ++s) {
        a.lo = s; a.hi = s + 1; a.li = li++;
        const int l = (s - 1) / STEPS_PER_LAYER, k = (s - 1) % STEPS_PER_LAYER;
        const bool layer_step = s >= 1 && s < N_STEPS - 1;
        const bool pure_gemm = layer_step && (k == 1 || k == 4 || k == 5 || k == 7 || k == 9);
        if (!(pure_gemm && MK_SIMPLE_GEMM)) hipLaunchKernelGGL(mega, dim3(grid), dim3(NTHR), LDS_BYTES, stream, a);
        if (!layer_step) continue;
        if (MK_SIMPLE_GEMM) {
            if (k == 1) launch_sgemm(job_win(p, l), epi_p(p), stream);
            if (k == 2) { launch_sgemm(job_f1(p, false), epi_f1(p, false), stream); launch_sgemm(job_f1(p, true), epi_f1(p, true), stream); }
            if (k == 3) { launch_sgemm(job_f2(p, false), epi_f2(p, false), stream); launch_sgemm(job_f2(p, true), epi_f2(p, true), stream); }
            if (k == 4) for (int pass = 0; pass < 3; ++pass) launch_sgemm(job_merge(p, l, pass), epi_merge(p, pass), stream);
            if (k == 5) launch_sgemm(job_out(p, l), epi_resid(p, l, 0), stream);
            if (k == 7) launch_sgemm(job_up(p, l), epi_p(p), stream);
            if (k == 9) launch_sgemm(job_down(p, l), epi_resid(p, l, 1), stream);
        }
        if (MK_SIMPLE_ATTN && k == 3) hipLaunchKernelGGL(k_sattn, dim3(MROWS * NH), dim3(64), 0, stream, p, l);
    }
#endif
}
```

```cpp
#include <hip/hip_runtime.h>
#include <cstdio>
#include <cstdint>

#ifndef MK_ONE_LAUNCH
#define MK_ONE_LAUNCH 1
#endif
#ifndef MK_SIMPLE_GEMM
#define MK_SIMPLE_GEMM 0
#endif
#ifndef MK_FUSE_ACT
#define MK_FUSE_ACT (!MK_SIMPLE_GEMM)
#endif
#ifndef MK_FFT
#define MK_FFT (!MK_SIMPLE_GEMM)
#endif
#ifndef PROBE_STEP
#define PROBE_STEP (-1)
#endif
#ifndef PROBE_REP
#define PROBE_REP 1
#endif
#ifndef MK_SIMPLE_ATTN
#define MK_SIMPLE_ATTN 0
#endif

#define LAS __attribute__((address_space(3)))
#define GAS __attribute__((address_space(1)))
typedef unsigned short bf16;
typedef short bf16x8 __attribute__((ext_vector_type(8)));
typedef float f32x4 __attribute__((ext_vector_type(4)));
typedef float f32x16 __attribute__((ext_vector_type(16)));
typedef unsigned u32x4 __attribute__((ext_vector_type(4)));
typedef unsigned u32x2 __attribute__((ext_vector_type(2)));

constexpr int DM = 2048, NBATCH = 2, SEQ = 4096, CTXL = 256, DEPTH = 4;
constexpr int ML = NBATCH * SEQ, MC = NBATCH * CTXL, MROWS = ML + MC;
constexpr int NIN = 11264, DFF = 5632, NUP = 2 * DFF, NMOD = 6 * DM;
constexpr int CB_OFF = 512, CC_OFF = 1024, CX_OFF = 1536, Q_OFF = 2048, K_OFF = 3072, V_OFF = 4096, GF_OFF = 5120, GC_OFF = 7168, GA_OFF = 9216;
constexpr int NH = 8, HD = 64, VD = 128, QKW = 1024, LK = CTXL + SEQ;
constexpr float QSCALE = 0.125f * 1.4426950408889634f;
constexpr float EPS_RMS = 1e-6f, EPS_SUBLN = 1e-5f;

constexpr size_t MiB = 1u << 20;
constexpr size_t WS_CTL = 0, CTL_BYTES = 4 * MiB;
constexpr size_t WS_MOD = 4 * MiB;
constexpr size_t WS_LAM = 5 * MiB;
constexpr size_t WS_ROPE = WS_LAM + 256;
constexpr size_t WS_CS128 = WS_LAM + 65536;
constexpr size_t WS_DC = WS_CS128 + 131072;
constexpr size_t WS_FWA = WS_DC + 262144;
constexpr size_t WS_FWC = WS_FWA + 32768;
constexpr size_t WS_FTW = WS_FWC + 16384;
constexpr size_t WS_DL = 6 * MiB;
constexpr size_t WS_G8 = WS_DL;
constexpr int NG8 = 3 * DM;
constexpr size_t WS_H = 70 * MiB;
constexpr size_t WS_XN = 138 * MiB;
constexpr size_t WS_P = 172 * MiB;
constexpr size_t WS_QR = 359 * MiB;
constexpr size_t WS_KC = 376 * MiB;
constexpr size_t WS_VT = 393 * MiB;
constexpr size_t WS_T = 410 * MiB;
constexpr size_t WS_TC = 426 * MiB;
constexpr size_t WS_BR = 427 * MiB;
constexpr size_t WS_MACC = 461 * MiB;
constexpr size_t WS_HALO = 501 * MiB;
constexpr size_t WS_MRG = 529 * MiB;
constexpr size_t WS_ACT = 563 * MiB;
constexpr size_t WS_W = 657 * MiB;
constexpr size_t W_IN = 0, W_BM = 44 * MiB, W_OUT = 52 * MiB, W_UP = 60 * MiB, W_DOWN = 104 * MiB, W_LAYER = 126 * MiB;
constexpr size_t WS_END = WS_W + 4 * W_LAYER;

struct Params { const float* in[20]; float* out; unsigned char* ws; };
enum { I_X = 0, I_C, I_CTX, I_CCTX, I_WMOD, I_BMOD, I_G1, I_G2, I_WIN, I_CONVW, I_LAMB, I_SUBG, I_WBF, I_WBC, I_WBA, I_WOUT, I_WUP, I_FCONVW, I_WDOWN, I_GFIN };

__host__ __device__ __forceinline__ unsigned f2bf(float f) { unsigned u = __builtin_bit_cast(unsigned, f); return (u + 0x7fffu + ((u >> 16) & 1u)) >> 16; }
typedef float f32x2_t __attribute__((ext_vector_type(2))); typedef __bf16 bf16x2_t __attribute__((ext_vector_type(2)));
__device__ __forceinline__ unsigned pk2(float lo, float hi) { f32x2_t v = {lo, hi}; bf16x2_t b = __builtin_convertvector(v, bf16x2_t); return __builtin_bit_cast(unsigned, b); }
__device__ __forceinline__ float bflo(unsigned w) { return __uint_as_float(w << 16); }
__device__ __forceinline__ float bfhi(unsigned w) { return __uint_as_float(w & 0xffff0000u); }
__device__ __forceinline__ void unpack8(const u32x4 w, float* f) { f[0] = bflo(w.x); f[1] = bfhi(w.x); f[2] = bflo(w.y); f[3] = bfhi(w.y); f[4] = bflo(w.z); f[5] = bfhi(w.z); f[6] = bflo(w.w); f[7] = bfhi(w.w); }
__device__ __forceinline__ u32x4 pack8(const float* f) { u32x4 w; w.x = pk2(f[0], f[1]); w.y = pk2(f[2], f[3]); w.z = pk2(f[4], f[5]); w.w = pk2(f[6], f[7]); return w; }
#define DPP_ADD(v, ctrl) v += __builtin_bit_cast(float, __builtin_amdgcn_mov_dpp(__builtin_bit_cast(int, v), ctrl, 0xf, 0xf, true))
__device__ __forceinline__ float wave_sum(float v) {
    DPP_ADD(v, 0xB1); DPP_ADD(v, 0x4E); DPP_ADD(v, 0x141); DPP_ADD(v, 0x140);
    { auto rr = __builtin_amdgcn_permlane16_swap(__float_as_uint(v), __float_as_uint(v), false, false); v = __uint_as_float(rr[0]) + __uint_as_float(rr[1]); }
    { auto rr = __builtin_amdgcn_permlane32_swap(__float_as_uint(v), __float_as_uint(v), false, false); v = __uint_as_float(rr[0]) + __uint_as_float(rr[1]); }
    return v;
}
__device__ __forceinline__ float wave_max(float v) {
#pragma unroll
    for (int o = 1; o < 64; o <<= 1) v = fmaxf(v, __shfl_xor(v, o));
    return v;
}
__device__ __forceinline__ float sigmoidf_(float x) { return 1.0f / (1.0f + __expf(-x)); }
__device__ __forceinline__ int lane_id_opaque() { unsigned m = ~0u; asm volatile("" : "+s"(m)); return (int)__builtin_amdgcn_mbcnt_hi(m, __builtin_amdgcn_mbcnt_lo(m, 0u)); }
struct RowInfo { int b, pos, L, mrow, kv; bool ctx; };
__host__ __device__ __forceinline__ RowInfo row_info(int row) {
    RowInfo r;
    if (row < ML) { r.b = row >> 12; r.pos = row & (SEQ - 1); r.L = SEQ; r.mrow = r.b; r.kv = CTXL + r.pos; r.ctx = false; }
    else { const int rr = row - ML; r.b = rr >> 8; r.pos = rr & (CTXL - 1); r.L = CTXL; r.mrow = 2; r.kv = r.pos; r.ctx = true; }
    return r;
}

struct GemmJob { const bf16* A; const bf16* Bt; int lda, ldb, M, N, K, Z, zdiv, pad; long sA1, sA2, sB1, sB2; };
__host__ __device__ __forceinline__ long job_aoff(const GemmJob& j, int z) { return (long)(z / j.zdiv) * j.sA1 + (long)(z % j.zdiv) * j.sA2; }
__host__ __device__ __forceinline__ long job_boff(const GemmJob& j, int z) { return (long)(z / j.zdiv) * j.sB1 + (long)(z % j.zdiv) * j.sB2; }

struct EStore {
    static constexpr bool HAS_MID = false, WHOLE = false, PERM = true;
    bf16* C; int ldc, pad; long sC;
    __device__ __forceinline__ void apply8(int z, int row, int col, f32x4 v0, f32x4 v1) const {
        u32x4 w; w.x = pk2(v0[0], v0[1]); w.y = pk2(v0[2], v0[3]); w.z = pk2(v1[0], v1[1]); w.w = pk2(v1[2], v1[3]);
        *(u32x4*)(C + (size_t)z * sC + (size_t)row * ldc + col) = w;
    }
};
struct ETr {
    static constexpr bool HAS_MID = false, WHOLE = false, PERM = true;
    bf16* T; int L, pad;
    __device__ __forceinline__ void apply8(int z, int row, int col, f32x4 v0, f32x4 v1) const {
        u32x4 w; w.x = pk2(v0[0], v0[1]); w.y = pk2(v0[2], v0[3]); w.z = pk2(v1[0], v1[1]); w.w = pk2(v1[2], v1[3]);
        const int b = z >> 2, g = z & 3;
        *(u32x4*)(T + ((size_t)(b * 512 + g * 128 + (row & 127)) * (size_t)(2 * L) + (size_t)(row >> 7) * L + col)) = w;
    }
};
struct EMerge {
    static constexpr bool HAS_MID = false, WHOLE = false, PERM = true;
    const bf16* P; float* macc; bf16* mrg; int goff, pass;
    __device__ __forceinline__ void apply8(int, int row, int col, f32x4 v0, f32x4 v1) const {
        const u32x4 gw = *(const u32x4*)(P + (size_t)row * NIN + goff + col);
        float g[8]; unpack8(gw, g);
        float v[8] = {v0[0], v0[1], v0[2], v0[3], v1[0], v1[1], v1[2], v1[3]};
        float* mp = macc + (size_t)row * DM + col;
        if (pass > 0) { const f32x4 a = *(const f32x4*)mp, b = *(const f32x4*)(mp + 4);
#pragma unroll
            for (int i = 0; i < 4; ++i) { v[i] = sigmoidf_(g[i]) * v[i] + a[i]; v[4 + i] = sigmoidf_(g[4 + i]) * v[4 + i] + b[i]; } }
        else {
#pragma unroll
            for (int i = 0; i < 8; ++i) v[i] = sigmoidf_(g[i]) * v[i]; }
        if (pass < 2) { *(f32x4*)mp = (f32x4){v[0], v[1], v[2], v[3]}; *(f32x4*)(mp + 4) = (f32x4){v[4], v[5], v[6], v[7]}; }
        else *(u32x4*)(mrg + (size_t)row * DM + col) = pack8(v);
    }
};
struct EMerge1 {
    static constexpr bool HAS_MID = true, WHOLE = false, PERM = true; static constexpr int MID0 = 512 / 64, MID1 = 1024 / 64;
    const unsigned char* g8; bf16* mrg;
    __device__ __forceinline__ void mid8(int seg, int row, int col, f32x4& v0, f32x4& v1) const {
        const unsigned char* gp = g8 + (size_t)row * NG8 + col + (seg == 0 ? 0 : DM);
        const u32x2 qa = *(const u32x2*)gp, qb = *(const u32x2*)(gp + DM);
#pragma unroll
        for (int i = 0; i < 8; ++i) { const unsigned wa = i < 4 ? qa.x : qa.y, wb = i < 4 ? qb.x : qb.y;
            const float r = (float)((wa >> (8 * (i & 3))) & 255u) * __builtin_amdgcn_rcpf((float)((wb >> (8 * (i & 3))) & 255u));
            if (i < 4) v0[i] *= r; else v1[i - 4] *= r; }
    }
    __device__ __forceinline__ void apply8(int, int row, int col, f32x4 v0, f32x4 v1) const {
        const u32x2 q = *(const u32x2*)(g8 + (size_t)row * NG8 + 2 * DM + col);
        float v[8];
#pragma unroll
        for (int i = 0; i < 8; ++i) { const unsigned w = i < 4 ? q.x : q.y; v[i] = (i < 4 ? v0[i] : v1[i - 4]) * ((float)((w >> (8 * (i & 3))) & 255u) * (1.0f / 255.0f)); }
        *(u32x4*)(mrg + (size_t)row * DM + col) = pack8(v);
    }
};
struct EWin {
    static constexpr bool HAS_MID = false, WHOLE = false, PERM = true;
    bf16* P; unsigned char* g8;
    __device__ __forceinline__ void apply8(int, int row, int col, f32x4 v0, f32x4 v1) const {
        if (col < GF_OFF) { u32x4 w; w.x = pk2(v0[0], v0[1]); w.y = pk2(v0[2], v0[3]); w.z = pk2(v1[0], v1[1]); w.w = pk2(v1[2], v1[3]); *(u32x4*)(P + (size_t)row * NIN + col) = w; }
        else {
            unsigned q[8];
#pragma unroll
            for (int i = 0; i < 8; ++i) { const float g = i < 4 ? v0[i] : v1[i - 4]; q[i] = (unsigned)fminf(fmaxf(255.0f * __builtin_amdgcn_rcpf(1.0f + __expf(-g)) + 0.5f, 1.0f), 255.0f); }
            u32x2 w; w.x = q[0] | (q[1] << 8) | (q[2] << 16) | (q[3] << 24); w.y = q[4] | (q[5] << 8) | (q[6] << 16) | (q[7] << 24);
            *(u32x2*)(g8 + (size_t)row * NG8 + (col - GF_OFF)) = w; }
    }
};
struct EResid {
    static constexpr bool HAS_MID = false, WHOLE = false, PERM = true;
    bf16* h; const float* modl; const float* xin; const float* cin; int goff, pad;
    __device__ __forceinline__ void apply8(int, int row, int col, f32x4 v0, f32x4 v1) const {
        const RowInfo ri = row_info(row);
        const float* gp = modl + (size_t)ri.mrow * NMOD + goff + col;
        const f32x4 g0 = *(const f32x4*)gp, g1 = *(const f32x4*)(gp + 4);
        bf16* hp = h + (size_t)row * DM + col;
        float a[8];
        if (xin) { const float* sp = row < ML ? xin + (size_t)row * DM + col : cin + (size_t)(row - ML) * DM + col; const f32x4 s0 = *(const f32x4*)sp, s1 = *(const f32x4*)(sp + 4);
#pragma unroll
            for (int i = 0; i < 4; ++i) { a[i] = s0[i]; a[4 + i] = s1[i]; } }
        else unpack8(*(const u32x4*)hp, a);
#pragma unroll
        for (int i = 0; i < 4; ++i) { a[i] += g0[i] * v0[i]; a[4 + i] += g1[i] * v1[i]; }
        *(u32x4*)hp = pack8(a);
    }
};

__device__ __forceinline__ float dpp_shr1(float oldv, float src) { return __builtin_bit_cast(float, __builtin_amdgcn_update_dpp(__builtin_bit_cast(int, oldv), __builtin_bit_cast(int, src), 0x111, 0xf, 0xf, false)); }
__device__ __forceinline__ float dpp_shl1(float oldv, float src) { return __builtin_bit_cast(float, __builtin_amdgcn_update_dpp(__builtin_bit_cast(int, oldv), __builtin_bit_cast(int, src), 0x101, 0xf, 0xf, false)); }
__device__ __forceinline__ float dpp_ror1(float src) { return __builtin_bit_cast(float, __builtin_amdgcn_mov_dpp(__builtin_bit_cast(int, src), 0x121, 0xf, 0xf, true)); }
__device__ __forceinline__ float dpp_ror15(float src) { return __builtin_bit_cast(float, __builtin_amdgcn_mov_dpp(__builtin_bit_cast(int, src), 0x12F, 0xf, 0xf, true)); }
struct EUpAct {
    static constexpr bool HAS_MID = false, WHOLE = true, PERM = true;
    bf16* act; const float* cw; float* halo; LAS float* edge;
    __device__ __forceinline__ void whole(const f32x4 (&acc)[2][2][4][2], int pm, int pn, int wr, int wc, int, int) const {
        const int ln_ = lane_id_opaque(), fr = ln_ & 15, fq = ln_ >> 4;
        int cb = 32 * wc + 8 * fq; asm volatile("" : "+v"(cb));
#pragma unroll
        for (int ai = 0; ai < 2; ++ai) { const int g = 2 * ai + wr;
#pragma unroll
            for (int bj = 0; bj < 2; ++bj)
#pragma unroll
                for (int n = 0; n < 2; ++n) {
                    if (fr == 0) *(LAS f32x4*)(edge + (g * 2 + 0) * 256 + 128 * bj + cb + 4 * n) = acc[ai][bj][0][n];
                    if (fr == 15) *(LAS f32x4*)(edge + (g * 2 + 1) * 256 + 128 * bj + cb + 4 * n) = acc[ai][bj][3][n]; } }
        LAS float* cwl = edge + 2048;
        { const int tid_ = (wr * 4 + wc) * 64 + ln_;
#pragma unroll
          for (int q = 0; q < 2; ++q) { const int idx = tid_ + 512 * q; if (idx < 768) { const int t = idx >> 8, c = idx & 255; cwl[idx] = cw[(size_t)t * NUP + (c >> 7) * DFF + 128 * pn + (c & 127)]; } } }
        asm volatile("s_waitcnt lgkmcnt(0)\n\ts_barrier" ::: "memory");
        const bool seq_first = pm >= 32 || (pm & 15) == 0, seq_last = pm >= 32 || (pm & 15) == 15;
        const int j0 = 128 * pn + cb;
        LAS float* uh = edge + 2048 + 768;
#pragma unroll
        for (int ai = 0; ai < 2; ++ai) { const int g = 2 * ai + wr; unsigned opk[4][2];
#pragma unroll
            for (int n = 0; n < 2; ++n) {
                asm volatile("" ::: "memory");
                f32x4 w[2][3];
#pragma unroll
                for (int bj = 0; bj < 2; ++bj)
#pragma unroll
                    for (int t = 0; t < 3; ++t) w[bj][t] = *(const LAS f32x4*)(cwl + t * 256 + bj * 128 + cb + 4 * n);
                float o[4][4];
#pragma unroll
                for (int e = 0; e < 4; ++e) {
                    float u[2][4];
#pragma unroll
                    for (int bj = 0; bj < 2; ++bj) {
                        float x0 = acc[ai][bj][0][n][e], x1 = acc[ai][bj][1][n][e], x2 = acc[ai][bj][2][n][e], x3 = acc[ai][bj][3][n][e];
                        asm volatile("" : "+v"(x0), "+v"(x1), "+v"(x2), "+v"(x3));
                        const float epv = g > 0 ? edge[((g - 1) * 2 + 1) * 256 + 128 * bj + cb + 4 * n + e] : 0.f, env = g < 3 ? edge[((g + 1) * 2 + 0) * 256 + 128 * bj + cb + 4 * n + e] : 0.f;
                        const float p0 = dpp_shr1(epv, x0), p1 = dpp_shr1(dpp_ror1(x0), x1), p2 = dpp_shr1(dpp_ror1(x1), x2), p3 = dpp_shr1(dpp_ror1(x2), x3);
                        const float q0 = dpp_shl1(dpp_ror15(x1), x0), q1 = dpp_shl1(dpp_ror15(x2), x1), q2 = dpp_shl1(dpp_ror15(x3), x2), q3 = dpp_shl1(env, x3);
                        const float w0 = w[bj][0][e], w1 = w[bj][1][e], w2 = w[bj][2][e];
                        u[bj][0] = w0 * p0 + w1 * x0 + w2 * q0; u[bj][1] = w0 * p1 + w1 * x1 + w2 * q1; u[bj][2] = w0 * p2 + w1 * x2 + w2 * q2; u[bj][3] = w0 * p3 + w1 * x3 + w2 * q3;
                        { const bool tgt_ = ai == 0 ? (wr == 0 && fr == 0) : (wr == 1 && fr == 15);
                          uh[tgt_ ? (ai == 0 ? 0 : 256) + 128 * bj + cb + 4 * n + e : 512 + ln_] = ai == 0 ? u[bj][0] : u[bj][3]; }
                        asm volatile("" : "+v"(u[bj][0]), "+v"(u[bj][1]), "+v"(u[bj][2]), "+v"(u[bj][3]));
                    }
#pragma unroll
                    for (int m = 0; m < 4; ++m) { const float a = u[0][m]; o[m][e] = a * __builtin_amdgcn_rcpf(1.0f + __expf(-a)) * u[1][m]; }
                    asm volatile("" : "+v"(o[0][e]), "+v"(o[1][e]), "+v"(o[2][e]), "+v"(o[3][e]));
                }
                if (n == 0) {
#pragma unroll
                    for (int m = 0; m < 4; ++m) { opk[m][0] = pk2(o[m][0], o[m][1]); opk[m][1] = pk2(o[m][2], o[m][3]); }
                } else {
#pragma unroll
                    for (int m = 0; m < 4; ++m) { u32x4 pw; pw.x = opk[m][0]; pw.y = opk[m][1]; pw.z = pk2(o[m][0], o[m][1]); pw.w = pk2(o[m][2], o[m][3]); *(u32x4*)(act + (size_t)(pm * 256 + ai * 128 + wr * 64 + m * 16 + fr) * DFF + j0) = pw; }
                }
            }
        }
        asm volatile("s_waitcnt lgkmcnt(0)\n\ts_barrier" ::: "memory");
        { const int tid_ = (wr * 4 + wc) * 64 + ln_, k = tid_ >> 7, c = tid_ & 127;
          if ((k & 1) ? !seq_last : !seq_first) {
              const LAS float* src = k == 0 ? edge : (k == 1 ? edge + 7 * 256 : (k == 2 ? uh : uh + 256));
              float* hg = halo + (size_t)pm * 8 * DFF + (size_t)(k * 2) * DFF + 128 * pn + c;
              hg[0] = src[c]; hg[DFF] = src[128 + c]; } }
    }
};
__host__ __device__ __forceinline__ const bf16* wl(const Params& p, int layer, size_t off) { return (const bf16*)(p.ws + WS_W + (size_t)layer * W_LAYER + off); }
__host__ __device__ __forceinline__ GemmJob job_win(const Params& p, int l) { return GemmJob{(const bf16*)(p.ws + WS_XN), wl(p, l, W_IN), DM, DM, MROWS, NIN, DM, 1, 1, 0, 0, 0, 0, 0}; }
__host__ __device__ __forceinline__ GemmJob job_up(const Params& p, int l) { return GemmJob{(const bf16*)(p.ws + WS_XN), wl(p, l, W_UP), DM, DM, (l + 1 < DEPTH || MK_SIMPLE_GEMM) ? MROWS : ML, NUP, DM, 1, 1, 0, 0, 0, 0, 0}; }
__host__ __device__ __forceinline__ GemmJob job_out(const Params& p, int l, int M = MROWS) { return GemmJob{(const bf16*)(p.ws + WS_MRG), wl(p, l, W_OUT), DM, DM, M, DM, DM, 1, 1, 0, 0, 0, 0, 0}; }
__host__ __device__ __forceinline__ GemmJob job_down(const Params& p, int l, int M = MROWS) { return GemmJob{(const bf16*)(p.ws + WS_ACT), wl(p, l, W_DOWN), DFF, DFF, M, DM, DFF, 1, 1, 0, 0, 0, 0, 0}; }
__host__ __device__ __forceinline__ GemmJob job_merge1(const Params& p, int l) { return GemmJob{(const bf16*)(p.ws + WS_BR), wl(p, l, W_BM), DM, DM, ML, DM, DM, 1, 1, 0, 0, 0, 0, 0}; }
__host__ __device__ __forceinline__ GemmJob job_merge(const Params& p, int l, int pass) {
    const int koff = pass == 0 ? 0 : (pass == 1 ? 512 : 1024), K = pass == 2 ? 1024 : 512;
    return GemmJob{(const bf16*)(p.ws + WS_BR) + koff, wl(p, l, W_BM) + koff, DM, DM, MROWS, DM, K, 1, 1, 0, 0, 0, 0, 0};
}
__host__ __device__ __forceinline__ GemmJob job_f1(const Params& p, bool ctx) {
    const bf16* P = (const bf16*)(p.ws + WS_P);
    if (!ctx) return GemmJob{(const bf16*)(p.ws + WS_CS128), P, 256, NIN, 256, SEQ, 256, 8, 4, 0, 0, 0, (long)SEQ * NIN, 128};
    return GemmJob{(const bf16*)(p.ws + WS_CS128), P + (size_t)ML * NIN, 256, NIN, 256, CTXL, 256, 8, 4, 0, 0, 0, (long)CTXL * NIN, 128};
}
__host__ __device__ __forceinline__ GemmJob job_f2(const Params& p, bool ctx) {
    if (!ctx) return GemmJob{(const bf16*)(p.ws + WS_DL), (const bf16*)(p.ws + WS_T), 2 * SEQ, 2 * SEQ, SEQ, 512, 2 * SEQ, 2, 1, 0, 0, 0, (long)512 * 2 * SEQ, 0};
    return GemmJob{(const bf16*)(p.ws + WS_DC), (const bf16*)(p.ws + WS_TC), 2 * CTXL, 2 * CTXL, CTXL, 512, 2 * CTXL, 2, 1, 0, 0, 0, (long)512 * 2 * CTXL, 0};
}
__host__ __device__ __forceinline__ EStore epi_p(const Params& p) { return EStore{(bf16*)(p.ws + WS_P), NIN, 0, 0}; }
__host__ __device__ __forceinline__ EStore epi_f2(const Params& p, bool ctx) {
    if (!ctx) return EStore{(bf16*)(p.ws + WS_BR), DM, 0, (long)SEQ * DM};
    return EStore{(bf16*)(p.ws + WS_BR) + (size_t)ML * DM, DM, 0, (long)CTXL * DM};
}
__host__ __device__ __forceinline__ ETr epi_f1(const Params& p, bool ctx) { return ctx ? ETr{(bf16*)(p.ws + WS_TC), CTXL, 0} : ETr{(bf16*)(p.ws + WS_T), SEQ, 0}; }
__host__ __device__ __forceinline__ EMerge epi_merge(const Params& p, int pass) {
    return EMerge{(const bf16*)(p.ws + WS_P), (float*)(p.ws + WS_MACC), (bf16*)(p.ws + WS_MRG), pass == 0 ? GF_OFF : (pass == 1 ? GC_OFF : GA_OFF), pass};
}
__host__ __device__ __forceinline__ EResid epi_resid(const Params& p, int l, int which) {
    const bool first = (l == 0 && which == 0);
    return EResid{(bf16*)(p.ws + WS_H), (const float*)(p.ws + WS_MOD) + (size_t)l * 3 * NMOD, first ? p.in[I_X] : nullptr, first ? p.in[I_CTX] : nullptr, which == 0 ? 2 * DM : 5 * DM, 0};
}

template <class E> __global__ void __launch_bounds__(256) k_sgemm(GemmJob j, E e) {
    __shared__ float As[32][65], Bs[32][65];
    const int z = blockIdx.z, m0 = blockIdx.y * 64, n0 = blockIdx.x * 64, tid = threadIdx.x;
    const bf16* A = j.A + job_aoff(j, z); const bf16* Bt = j.Bt + job_boff(j, z);
    const int lr = tid >> 2, lc = (tid & 3) * 8, ty = tid >> 3, tx = tid & 7;
    float acc[2][8];
#pragma unroll
    for (int a = 0; a < 2; ++a)
#pragma unroll
        for (int b = 0; b < 8; ++b) acc[a][b] = 0.f;
    for (int k0 = 0; k0 < j.K; k0 += 32) {
        const u32x4 aw = *(const u32x4*)(A + (size_t)(m0 + lr) * j.lda + k0 + lc);
        const u32x4 bw = *(const u32x4*)(Bt + (size_t)(n0 + lr) * j.ldb + k0 + lc);
        float af[8], bf[8]; unpack8(aw, af); unpack8(bw, bf);
        __syncthreads();
#pragma unroll
        for (int i = 0; i < 8; ++i) { As[lc + i][lr] = af[i]; Bs[lc + i][lr] = bf[i]; }
        __syncthreads();
#pragma unroll 8
        for (int kk = 0; kk < 32; ++kk) {
            const float a0 = As[kk][2 * ty], a1 = As[kk][2 * ty + 1];
#pragma unroll
            for (int b = 0; b < 8; ++b) { const float bv = Bs[kk][8 * tx + b]; acc[0][b] += a0 * bv; acc[1][b] += a1 * bv; }
        }
    }
#pragma unroll
    for (int a = 0; a < 2; ++a)
        e.apply8(z, m0 + 2 * ty + a, n0 + 8 * tx, (f32x4){acc[a][0], acc[a][1], acc[a][2], acc[a][3]}, (f32x4){acc[a][4], acc[a][5], acc[a][6], acc[a][7]});
}
template <class E> static void launch_sgemm(const GemmJob& j, const E& e, hipStream_t st) {
    hipLaunchKernelGGL((k_sgemm<E>), dim3(j.N / 64, j.M / 64, j.Z), dim3(256), 0, st, j, e);
}

__global__ void __launch_bounds__(64) k_sattn(Params p, int layer) {
    __shared__ float S0[LK], S1[LK], q[128];
    const int row = blockIdx.x >> 3, h = blockIdx.x & 7, lane = threadIdx.x;
    const RowInfo ri = row_info(row);
    const int nk = ri.ctx ? CTXL : LK;
    const bf16* Qr = (const bf16*)(p.ws + WS_QR); const bf16* Kc = (const bf16*)(p.ws + WS_KC); const bf16* Vt = (const bf16*)(p.ws + WS_VT);
    bf16* br = (bf16*)(p.ws + WS_BR);
    const float lam = ((const float*)(p.ws + WS_LAM))[layer];
    const float lam_init = 0.8f - 0.6f * expf(-0.3f * (float)layer);
    q[lane] = __uint_as_float(((unsigned)Qr[(size_t)row * QKW + h * 128 + lane]) << 16);
    q[64 + lane] = __uint_as_float(((unsigned)Qr[(size_t)row * QKW + h * 128 + 64 + lane]) << 16);
    __syncthreads();
    float m0 = -1e30f, m1 = -1e30f;
    for (int j = lane; j < nk; j += 64) {
        const bf16* kp = Kc + ((size_t)(ri.b * LK + j) * QKW + h * 128);
        float s0 = 0.f, s1 = 0.f;
#pragma unroll
        for (int c = 0; c < 8; ++c) { float f[8]; unpack8(*(const u32x4*)(kp + c * 8), f);
#pragma unroll
            for (int i = 0; i < 8; ++i) s0 += q[c * 8 + i] * f[i]; }
#pragma unroll
        for (int c = 0; c < 8; ++c) { float f[8]; unpack8(*(const u32x4*)(kp + 64 + c * 8), f);
#pragma unroll
            for (int i = 0; i < 8; ++i) s1 += q[64 + c * 8 + i] * f[i]; }
        S0[j] = s0; S1[j] = s1; m0 = fmaxf(m0, s0); m1 = fmaxf(m1, s1);
    }
    m0 = wave_max(m0); m1 = wave_max(m1);
    float l0 = 0.f, l1 = 0.f;
    for (int j = lane; j < nk; j += 64) { const float e0 = exp2f(S0[j] - m0), e1 = exp2f(S1[j] - m1); S0[j] = e0; S1[j] = e1; l0 += e0; l1 += e1; }
    l0 = wave_sum(l0); l1 = wave_sum(l1);
    const float i0 = 1.0f / l0, i1 = lam / l1;
    for (int j = lane; j < nk; j += 64) S0[j] = S0[j] * i0 - S1[j] * i1;
    __syncthreads();
    float o[2];
#pragma unroll
    for (int t = 0; t < 2; ++t) {
        const int dv = lane + 64 * t;
        const bf16* vp = Vt + ((size_t)(ri.b * QKW + h * 128 + dv) * LK);
        float s = 0.f;
        for (int j = 0; j < nk; j += 8) { float f[8]; unpack8(*(const u32x4*)(vp + j), f);
#pragma unroll
            for (int i = 0; i < 8; ++i) s += S0[j + i] * f[i]; }
        o[t] = s;
    }
    const float ss = wave_sum(o[0] * o[0] + o[1] * o[1]);
    const float rs = rsqrtf(ss * (1.0f / 128.0f) + EPS_SUBLN) * (1.0f - lam_init);
    const float* sg = p.in[I_SUBG] + layer * VD;
#pragma unroll
    for (int t = 0; t < 2; ++t) { const int dv = lane + 64 * t; br[(size_t)row * DM + 1024 + h * 128 + dv] = (bf16)f2bf(o[t] * rs * sg[dv]); }
}

namespace pg8 {
constexpr int BM = 256, BK = 64, HALF = 128, HTB = HALF * BK * 2, STAGE_BYTES = 8 * HTB, NXCD = 8, WGM = 8;
__host__ __device__ __forceinline__ int lds_byte(int r, int c) { const int st = (r >> 4) * 2 + (c >> 5), rr = r & 15, cc = c & 31, ob = rr * 64 + cc * 2; return st * 1024 + (ob ^ (((ob >> 9) & 1) << 5)); }
__host__ __device__ __forceinline__ void stage_rc(int b, int& R, int& C) { const int st = b / 1024, sb = b % 1024, swz = sb ^ (((sb >> 9) & 1) << 5); R = (st >> 1) * 16 + swz / 64; C = (st & 1) * 32 + (swz % 64) / 2; }
__host__ __device__ __forceinline__ int perm32(int rho) { const int n = rho >> 4, i = rho & 15; return 8 * (i >> 2) + 4 * n + (i & 3); }
struct Unit { int pm, pn, z; size_t aoff, boff; };
struct Sched {
    int nM, nN, tiles, total, G, c, lda, ldb, zdiv; long sA1, sA2, sB1, sB2;
    __device__ __forceinline__ void init(const GemmJob& j, int G_, int c_) { nM = j.M / BM; nN = j.N / BM; tiles = nM * nN; total = tiles * j.Z; G = G_; c = c_; lda = j.lda; ldb = j.ldb; zdiv = j.zdiv; sA1 = j.sA1; sA2 = j.sA2; sB1 = j.sB1; sB2 = j.sB2; }
    __device__ __forceinline__ bool next(int i, Unit& u) const {
        const long L = (long)i * G + c; if (L >= total) return false;
        const int z = (int)(L / tiles); int wgid = (int)(L % tiles);
        { const int q = tiles / NXCD, r = tiles % NXCD, xcd = wgid % NXCD, off = wgid / NXCD; wgid = (xcd < r ? xcd * (q + 1) : r * (q + 1) + (xcd - r) * q) + off; }
        const int nig = WGM * nN, gid = wgid / nig, fm = gid * WGM, gsz = (nM - fm) < WGM ? (nM - fm) : WGM;
        u.pm = fm + ((wgid % nig) % gsz); u.pn = (wgid % nig) / gsz; u.z = z;
        const long z1 = z / zdiv, z2 = z % zdiv;
        u.aoff = (size_t)(z1 * sA1 + z2 * sA2 + (long)u.pm * BM * lda) * 2; u.boff = (size_t)(z1 * sB1 + z2 * sB2 + (long)u.pn * BM * ldb) * 2;
        return true;
    }
};
template <class E> __device__ __forceinline__ void run_epi(const E& e, const f32x4 (&acc)[2][2][4][2], const Unit& u, int wr, int wc, int, int) {
    const int ln_ = lane_id_opaque(), fr = ln_ & 15, fq = ln_ >> 4;
    int row0 = u.pm * BM + wr * 64 + fr, col0 = u.pn * BM + wc * 64 + 8 * fq;
    asm volatile("" : "+v"(row0), "+v"(col0));
    const int colq = col0 - 4 * fq; (void)colq;
#pragma unroll
    for (int ai = 0; ai < 2; ++ai)
#pragma unroll
        for (int m = 0; m < 4; ++m)
#pragma unroll
            for (int bj = 0; bj < 2; ++bj) {
                if constexpr (E::PERM) e.apply8(u.z, row0 + ai * HALF + m * 16, col0 + bj * 32, acc[ai][bj][m][0], acc[ai][bj][m][1]);
                else { e.apply4(u.z, row0 + ai * HALF + m * 16, colq + bj * 32, acc[ai][bj][m][0]); e.apply4(u.z, row0 + ai * HALF + m * 16, colq + bj * 32 + 16, acc[ai][bj][m][1]); } }
}
template <class E> __device__ __forceinline__ void run_mid(const E& e, f32x4 (&acc)[2][2][4][2], const Unit& u, int seg, int wr, int wc, int, int) {
    const int ln_ = lane_id_opaque(), fr = ln_ & 15, fq = ln_ >> 4;
    int row0 = u.pm * BM + wr * 64 + fr, col0 = u.pn * BM + wc * 64 + 8 * fq;
    asm volatile("" : "+v"(row0), "+v"(col0));
#pragma unroll
    for (int ai = 0; ai < 2; ++ai)
#pragma unroll
        for (int m = 0; m < 4; ++m)
#pragma unroll
            for (int bj = 0; bj < 2; ++bj) e.mid8(seg, row0 + ai * HALF + m * 16, col0 + bj * 32, acc[ai][bj][m][0], acc[ai][bj][m][1]);
}
template <class E>
__device__ __forceinline__ void gemm_phase(LAS unsigned char* lds, const GemmJob g, const Sched& S, const E& e, int wave_) {
    int tid = wave_ * 64 + lane_id_opaque(); asm volatile("" : "+v"(tid));
    const int wid = wave_, lane = tid & 63, wr = wid >> 2, wc = wid & 3, fr = lane & 15, fq = lane >> 4;
    const int K = g.K, nt = K / BK;
    unsigned voffA[2], voffB[2];
#pragma unroll
    for (int i = 0; i < 2; ++i) { int R, C; stage_rc(tid * 16 + i * 8192, R, C); const int Rb = (R >> 5) * 64 + (E::PERM ? perm32(R & 31) : (R & 31));
        voffA[i] = (unsigned)(R * g.lda + C) * 2u; voffB[i] = (unsigned)(Rb * g.ldb + C) * 2u; }
    const size_t kstep = (size_t)(BK * 2);
    const size_t hstepA = (size_t)HALF * g.lda * 2, hstepB = (size_t)32 * g.ldb * 2;
    const unsigned ldsw = (unsigned)wid * 1024u;
    const int aoff = lds_byte(wr * 64 + fr, fq * 8), boff = lds_byte(wc * 32 + fr, fq * 8);
#define PG8_SA(b, h) (((b) * 2 + (h)) * HTB)
#define PG8_SB(b, h) ((4 + (b) * 2 + (h)) * HTB)
#define PG8_STAGE(bufoff, gbase, voff) do { _Pragma("unroll") for (int _i = 0; _i < 2; ++_i) \
        __builtin_amdgcn_global_load_lds((const unsigned*)((const char*)(gbase) + (voff)[_i]), (LAS unsigned*)(lds + (bufoff) + ldsw + _i * 8192), 16, 0, 0); } while (0)
#define PG8_LDA(dst, b, h) do { _Pragma("unroll") for (int m = 0; m < 4; ++m) _Pragma("unroll") for (int k = 0; k < 2; ++k) dst[m][k] = *(const LAS bf16x8*)(lds + PG8_SA(b, h) + aoff + m * 2048 + k * 1024); } while (0)
#define PG8_LDB(dst, b, h) do { _Pragma("unroll") for (int n = 0; n < 2; ++n) _Pragma("unroll") for (int k = 0; k < 2; ++k) dst[n][k] = *(const LAS bf16x8*)(lds + PG8_SB(b, h) + boff + n * 2048 + k * 1024); } while (0)
#define PG8_MMA(ai, bj, At, Bt) do { __builtin_amdgcn_s_setprio(1); _Pragma("unroll") for (int m = 0; m < 4; ++m) _Pragma("unroll") for (int n = 0; n < 2; ++n) _Pragma("unroll") for (int k = 0; k < 2; ++k) \
        acc[ai][bj][m][n] = __builtin_amdgcn_mfma_f32_16x16x32_bf16(Bt[n][k], At[m][k], acc[ai][bj][m][n], 0, 0, 0); __builtin_amdgcn_s_setprio(0); } while (0)
#define PG8_WAIT_V(n) asm volatile("s_waitcnt vmcnt(" #n ")" ::: "memory")
#define PG8_WAIT_L(n) asm volatile("s_waitcnt lgkmcnt(" #n ")" ::: "memory")
#define PG8_BAR __builtin_amdgcn_s_barrier()
#define PG8_SCHED __builtin_amdgcn_sched_barrier(0)
    Unit cur, nxt; int ui = 0;
    if (!S.next(0, cur)) return;
    f32x4 acc[2][2][4][2];
#pragma unroll
    for (int a = 0; a < 2; ++a)
#pragma unroll
        for (int b = 0; b < 2; ++b)
#pragma unroll
            for (int m = 0; m < 4; ++m)
#pragma unroll
                for (int n = 0; n < 2; ++n) acc[a][b][m][n] = (f32x4){0.f, 0.f, 0.f, 0.f};
    bf16x8 At[4][2], B0[2][2], B1[2][2];
    const char* cA = (const char*)g.A + cur.aoff; const char* cB = (const char*)g.Bt + cur.boff;
    PG8_STAGE(PG8_SB(0, 0), cB, voffB); PG8_STAGE(PG8_SB(0, 1), cB + hstepB, voffB); PG8_STAGE(PG8_SA(0, 0), cA, voffA); PG8_STAGE(PG8_SA(0, 1), cA + hstepA, voffA);
    if (wr == 1) PG8_BAR;
    PG8_WAIT_V(2); PG8_BAR;
    PG8_STAGE(PG8_SB(1, 0), cB + kstep, voffB); PG8_STAGE(PG8_SA(1, 0), cA + kstep, voffA); PG8_STAGE(PG8_SB(1, 1), cB + hstepB + kstep, voffB);
    PG8_WAIT_V(6); PG8_BAR;
    for (;;) {
        const bool has_next = S.next(ui + 1, nxt);
        const char* nA = has_next ? (const char*)g.A + nxt.aoff : cA; const char* nB = has_next ? (const char*)g.Bt + nxt.boff : cB;
        for (int t = 0; t < nt; t += 2) {
            const bool last = (t == nt - 2);
            const char* a1 = cA + (size_t)(t + 1) * kstep;
            const char* a2 = last ? nA : cA + (size_t)(t + 2) * kstep; const char* b2 = last ? nB : cB + (size_t)(t + 2) * kstep;
            const char* a3 = a2 + kstep; const char* b3 = b2 + kstep;
            PG8_LDB(B0, 0, 0); PG8_LDB(B1, 0, 1); PG8_SCHED; PG8_LDA(At, 0, 0); PG8_STAGE(PG8_SA(1, 1), a1 + hstepA, voffA);
            PG8_WAIT_V(8); PG8_WAIT_L(0); PG8_BAR; PG8_MMA(0, 0, At, B0); PG8_MMA(0, 1, At, B1); PG8_BAR; PG8_SCHED;
            PG8_LDA(At, 0, 1); PG8_STAGE(PG8_SB(0, 0), b2, voffB); PG8_STAGE(PG8_SB(0, 1), b2 + hstepB, voffB); PG8_STAGE(PG8_SA(0, 0), a2, voffA);
            PG8_WAIT_V(8); PG8_WAIT_L(0); PG8_BAR; PG8_MMA(1, 0, At, B0); PG8_MMA(1, 1, At, B1); PG8_BAR; PG8_SCHED;
            PG8_LDB(B0, 1, 0); PG8_LDB(B1, 1, 1); PG8_SCHED; PG8_LDA(At, 1, 0); PG8_STAGE(PG8_SA(0, 1), a2 + hstepA, voffA);
            PG8_WAIT_V(8); PG8_WAIT_L(0); PG8_BAR; PG8_MMA(0, 0, At, B0); PG8_MMA(0, 1, At, B1); PG8_BAR; PG8_SCHED;
            PG8_LDA(At, 1, 1); PG8_STAGE(PG8_SB(1, 0), b3, voffB); PG8_STAGE(PG8_SB(1, 1), b3 + hstepB, voffB); PG8_STAGE(PG8_SA(1, 0), a3, voffA);
            PG8_WAIT_V(8); PG8_WAIT_L(0); PG8_BAR; PG8_MMA(1, 0, At, B0); PG8_MMA(1, 1, At, B1); PG8_BAR; PG8_SCHED;
            if constexpr (E::HAS_MID) { if (t + 2 == E::MID0 || t + 2 == E::MID1) run_mid(e, acc, cur, (t + 2 == E::MID0) ? 0 : 1, wr, wc, fr, fq); }
        }
        if (wr == 0) PG8_BAR;
        if constexpr (E::WHOLE) e.whole(acc, cur.pm, cur.pn, wr, wc, fr, fq); else run_epi(e, acc, cur, wr, wc, fr, fq);
        if (!has_next) break;
#pragma unroll
        for (int a = 0; a < 2; ++a)
#pragma unroll
            for (int b = 0; b < 2; ++b)
#pragma unroll
                for (int m = 0; m < 4; ++m)
#pragma unroll
                    for (int n = 0; n < 2; ++n) acc[a][b][m][n] = (f32x4){0.f, 0.f, 0.f, 0.f};
        cur = nxt; cA = nA; cB = nB; ++ui;
        if (wr == 1) PG8_BAR;
    }
    PG8_WAIT_V(0);
    PG8_BAR;
#undef PG8_SA
#undef PG8_SB
#undef PG8_STAGE
#undef PG8_LDA
#undef PG8_LDB
#undef PG8_MMA
#undef PG8_WAIT_V
#undef PG8_WAIT_L
#undef PG8_BAR
#undef PG8_SCHED
}
}

#define XB_TMO      128
#define XB_XCNT(j)  (256  + 64 * (j))
#define XB_XSUB(j)  (1280 + 64 * (j))
#define XB_XGEN(j)  (2304 + 64 * (j))
#define XB_TOP      3328
#define XB_TOPGEN   3392
#define XCD_BAR_WORDS 3456
#define XB_SPIN_CAP (1u << 18)
__device__ __forceinline__ unsigned xb_ld(unsigned* p)              { return __hip_atomic_load(p, __ATOMIC_RELAXED, __HIP_MEMORY_SCOPE_AGENT); }
__device__ __forceinline__ unsigned xb_add(unsigned* p, unsigned v) { return __hip_atomic_fetch_add(p, v, __ATOMIC_RELAXED, __HIP_MEMORY_SCOPE_AGENT); }
__device__ __forceinline__ unsigned xb_xcc_id() { return (unsigned)__builtin_amdgcn_s_getreg((3 << 11) | 20) & 0xFu; }
#define XB_SPIN(cond, bar) do { unsigned _sp = 0; while (cond) { __builtin_amdgcn_s_sleep(1); \
    if ((++_sp & 255u) == 0u) { if (xb_ld(&(bar)[XB_TMO])) break; if (_sp > XB_SPIN_CAP) { atomicAdd(&(bar)[XB_TMO], 1u); break; } } } } while (0)
struct XcdBarrier { unsigned* bar; unsigned x; volatile LAS unsigned* st; };
__device__ __forceinline__ XcdBarrier xcd_barrier_post(unsigned* bar, volatile LAS unsigned* st) {
    XcdBarrier b; b.bar = bar; b.x = xb_xcc_id(); b.st = st;
    if (threadIdx.x == 0) (void)xb_add(&bar[XB_XCNT(b.x)], 1u);
    return b;
}
__device__ __forceinline__ void xcd_barrier_complete(unsigned* bar, unsigned x, unsigned& nloc, unsigned& nx) {
    const unsigned G = gridDim.x * gridDim.y * gridDim.z;
    unsigned sum, cnt, mine, sp = 0u;
    for (;;) {
        sum = 0u; cnt = 0u; mine = 0u;
#pragma unroll
        for (unsigned j = 0; j < 16; ++j) { const unsigned c = xb_ld(&bar[XB_XCNT(j)]); sum += c; cnt += (c > 0u) ? 1u : 0u; mine = (j == x) ? c : mine; }
        if (sum == G) break;
        __builtin_amdgcn_s_sleep(1);
        if ((++sp & 255u) == 0u) { if (xb_ld(&bar[XB_TMO])) break; if (sp > XB_SPIN_CAP) { atomicAdd(&bar[XB_TMO], 1u); break; } }
    }
    nloc = mine > 0u ? mine : 1u; nx = cnt > 0u ? cnt : 1u;
}
__device__ __forceinline__ void xcd_barrier(const XcdBarrier& b) {
    asm volatile("s_waitcnt vmcnt(0)" ::: "memory");
    __syncthreads();
    if (threadIdx.x == 0) {
        unsigned* bar = b.bar;
        __builtin_amdgcn_s_waitcnt(0);
        unsigned nloc = b.st[0], nx = b.st[1];
        if (nloc == 0u) { xcd_barrier_complete(bar, b.x, nloc, nx); b.st[0] = nloc; b.st[1] = nx; }
        const unsigned old = xb_add(&bar[XB_XSUB(b.x)], 1u);
        const unsigned gen = old / nloc;
        if (old + 1u == (gen + 1u) * nloc) {
            __builtin_amdgcn_fence(__ATOMIC_RELEASE, "agent");
            asm volatile("s_waitcnt vmcnt(0)" ::: "memory");
            const unsigned og = xb_add(&bar[XB_TOP], 1u);
            const unsigned tg = og / nx;
            if (og + 1u == (tg + 1u) * nx) xb_add(&bar[XB_TOPGEN], 1u);
            else XB_SPIN(xb_ld(&bar[XB_TOPGEN]) == tg, bar);
            __builtin_amdgcn_fence(__ATOMIC_ACQUIRE, "agent");
            xb_add(&bar[XB_XGEN(b.x)], 1u);
            asm volatile("s_waitcnt vmcnt(0)" ::: "memory");
        } else {
            XB_SPIN(xb_ld(&bar[XB_XGEN(b.x)]) == gen, bar);
            __builtin_amdgcn_fence(__ATOMIC_ACQUIRE, "agent");
            asm volatile("s_waitcnt vmcnt(0)" ::: "memory");
        }
    }
    __syncthreads();
}

constexpr int NWAVES = 8, NTHR = 512;
constexpr int RING_BYTES = 131072, MISC_OFF = RING_BYTES, LDS_BYTES = 147456;
constexpr int CW_BAR = 4096;
#define LDS_WAIT() asm volatile("s_waitcnt lgkmcnt(0)" ::: "memory")

struct Ctx { LAS unsigned char* lds; int tid, lane, wave, vcu, G; };
__device__ __forceinline__ Ctx fresh(const Ctx& F0) { Ctx F = F0; int v = F0.vcu, w = F0.wave; asm volatile("" : "+s"(v), "+s"(w)); int t = w * 64 + lane_id_opaque(); asm volatile("" : "+v"(t)); F.tid = t; F.lane = t & 63; F.vcu = v; F.wave = w; return F; }

template <bool UPPERM = false> __device__ __forceinline__ void transpose_item(const float* W, int N, bf16* WT, int ldt, int col_off, LAS float* scr, int item, int lane) {
    const int nblk = N / 32, kb = item / nblk, nb = item % nblk, k0 = 64 * kb, n0 = 32 * nb;
    { const int kr = lane >> 3, c4 = lane & 7;
      f32x4 v[8];
#pragma unroll
      for (int i = 0; i < 8; ++i) v[i] = *(const f32x4*)(W + (size_t)(k0 + 8 * i + kr) * N + n0 + 4 * c4);
#pragma unroll
      for (int i = 0; i < 8; ++i)
#pragma unroll
          for (int j = 0; j < 4; ++j) scr[(8 * i + kr) * 33 + 4 * c4 + j] = v[i][j]; }
    LDS_WAIT(); asm volatile("" ::: "memory");
    const int c = lane & 7;
#pragma unroll
    for (int j = 0; j < 4; ++j) { const int n = (lane >> 3) + 8 * j; const LAS float* s = scr + (8 * c) * 33 + n;
        u32x4 o; o.x = pk2(s[0 * 33], s[1 * 33]); o.y = pk2(s[2 * 33], s[3 * 33]); o.z = pk2(s[4 * 33], s[5 * 33]); o.w = pk2(s[6 * 33], s[7 * 33]);
        int nr = n0 + n; if (UPPERM) { const int av = nr >= DFF, j = nr - av * DFF; nr = (j >> 7) * 256 + ((j >> 5) & 3) * 64 + av * 32 + (j & 31); }
        *(u32x4*)(WT + (size_t)nr * ldt + col_off + k0 + 8 * c) = o; }
    LDS_WAIT(); asm volatile("" ::: "memory");
}
__device__ __forceinline__ void prologue(const Params& p, const Ctx& F0) {
    const Ctx F = fresh(F0);
    const int gw = F.vcu * NWAVES + F.wave, NGW = F.G * NWAVES;
    const int gt = F.vcu * NTHR + F.tid, NGT = F.G * NTHR;
    {
        LAS float* sv = (LAS float*)F.lds;
        LAS float* red = (LAS float*)(F.lds + 24576);
        for (int i = F.tid; i < 3 * DM; i += NTHR) { const int r = i / DM, k = i % DM; const float x = r < 2 ? p.in[I_C][r * DM + k] : p.in[I_CCTX][k]; sv[i] = x / (1.0f + __expf(-x)); }
        __syncthreads();
        const int ng = F.tid & 15, ks = F.tid >> 4;
        float* mod = (float*)(p.ws + WS_MOD);
        for (int it = F.vcu; it < DEPTH * (NMOD / 64); it += F.G) {
            const int l = it / (NMOD / 64), n0 = (it % (NMOD / 64)) * 64;
            const float* W = p.in[I_WMOD] + ((size_t)l * DM + ks * 64) * NMOD + n0 + 4 * ng;
            f32x4 a0 = {0, 0, 0, 0}, a1 = {0, 0, 0, 0}, a2 = {0, 0, 0, 0};
#pragma unroll 8
            for (int kk = 0; kk < 64; ++kk) { const f32x4 w = *(const f32x4*)(W + (size_t)kk * NMOD); const int k = ks * 64 + kk; a0 += sv[k] * w; a1 += sv[DM + k] * w; a2 += sv[2 * DM + k] * w; }
            *(LAS f32x4*)(red + (ks * 3 + 0) * 64 + 4 * ng) = a0; *(LAS f32x4*)(red + (ks * 3 + 1) * 64 + 4 * ng) = a1; *(LAS f32x4*)(red + (ks * 3 + 2) * 64 + 4 * ng) = a2;
            __syncthreads();
            if (F.tid < 192) { const int r = F.tid >> 6, n = F.tid & 63; float s = p.in[I_BMOD][(size_t)l * NMOD + n0 + n];
                for (int q = 0; q < 32; ++q) s += red[(q * 3 + r) * 64 + n];
                mod[((size_t)l * 3 + r) * NMOD + n0 + n] = s; }
            __syncthreads();
        }
    }
    {
        LAS float* scr = (LAS float*)(F.lds + F.wave * 16384);
        constexpr int I_IN = (DM / 64) * (NIN / 32), I_BF = (512 / 64) * (DM / 32), I_BA = (1024 / 64) * (DM / 32), I_OUT = (DM / 64) * (DM / 32), I_DN = (DFF / 64) * (DM / 32);
        constexpr int PER_LAYER = 2 * I_IN + 2 * I_BF + I_BA + I_OUT + I_DN;
        for (int it = gw; it < DEPTH * PER_LAYER; it += NGW) {
            const int l = it / PER_LAYER; int r = it % PER_LAYER;
            unsigned char* wb = p.ws + WS_W + (size_t)l * W_LAYER;
            if (r < I_IN) { transpose_item(p.in[I_WIN] + (size_t)l * DM * NIN, NIN, (bf16*)(wb + W_IN), DM, 0, scr, r, F.lane); continue; } r -= I_IN;
            if (r < I_IN) { transpose_item<MK_FUSE_ACT != 0>(p.in[I_WUP] + (size_t)l * DM * NUP, NUP, (bf16*)(wb + W_UP), DM, 0, scr, r, F.lane); continue; } r -= I_IN;
            if (r < I_BF) { transpose_item(p.in[I_WBF] + (size_t)l * 512 * DM, DM, (bf16*)(wb + W_BM), DM, 0, scr, r, F.lane); continue; } r -= I_BF;
            if (r < I_BF) { transpose_item(p.in[I_WBC] + (size_t)l * 512 * DM, DM, (bf16*)(wb + W_BM), DM, 512, scr, r, F.lane); continue; } r -= I_BF;
            if (r < I_BA) { transpose_item(p.in[I_WBA] + (size_t)l * 1024 * DM, DM, (bf16*)(wb + W_BM), DM, 1024, scr, r, F.lane); continue; } r -= I_BA;
            if (r < I_OUT) { transpose_item(p.in[I_WOUT] + (size_t)l * DM * DM, DM, (bf16*)(wb + W_OUT), DM, 0, scr, r, F.lane); continue; } r -= I_OUT;
            transpose_item(p.in[I_WDOWN] + (size_t)l * DFF * DM, DM, (bf16*)(wb + W_DOWN), DFF, 0, scr, r, F.lane);
        }
    }
    {
#if MK_FFT
        { bf16* WA = (bf16*)(p.ws + WS_FWA); bf16* WC = (bf16*)(p.ws + WS_FWC); float2* tw = (float2*)(p.ws + WS_FTW);
          for (int it = gt; it < 128 * 128; it += NGT) { const int r = it >> 7, k = it & 127, pr = r >> 6, ap = r & 63, pk = k >> 6, a = k & 63; float sn, cs; sincospif((float)((ap * a) & 63) * (1.0f / 32.0f), &sn, &cs);
              const float v = (pr == 0 ? (pk == 0 ? cs : -sn) : (pk == 0 ? -sn : -cs)) * 0.125f; WA[it] = (bf16)f2bf(v); }
          for (int it = gt; it < 64 * 128; it += NGT) { const int bp = it >> 7, k = it & 127, pk = k >> 6, b = k & 63; float sn, cs; sincospif((float)((bp * b) & 63) * (1.0f / 32.0f), &sn, &cs); WC[it] = (bf16)f2bf((pk == 0 ? cs : sn) * 0.125f); }
          for (int it = gt; it < 4096; it += NGT) { float sn, cs; sincospif((float)it * (1.0f / 2048.0f), &sn, &cs); tw[it] = make_float2(cs, sn); } }
#else
        bf16* DL = (bf16*)(p.ws + WS_DL);
        for (int it = gt; it < SEQ * 1024; it += NGT) {
            const int lp = it >> 10, j0 = (it & 1023) * 8; float v[8];
#pragma unroll
            for (int e = 0; e < 8; ++e) { const int j = j0 + e, l = j & (SEQ - 1); const int m = (lp * l) & (SEQ - 1); float s, c; sincospif((float)m * (1.0f / 2048.0f), &s, &c); v[e] = (j < SEQ ? c : -s) * (1.0f / 64.0f); }
            *(u32x4*)(DL + (size_t)lp * (2 * SEQ) + j0) = pack8(v);
        }
#endif
        bf16* DC = (bf16*)(p.ws + WS_DC);
        for (int it = gt; it < CTXL * 64; it += NGT) {
            const int lp = it >> 6, j0 = (it & 63) * 8; float v[8];
#pragma unroll
            for (int e = 0; e < 8; ++e) { const int j = j0 + e, l = j & (CTXL - 1); const int m = (lp * l) & (CTXL - 1); float s, c; sincospif((float)m * (1.0f / 128.0f), &s, &c); v[e] = (j < CTXL ? c : -s) * (1.0f / 16.0f); }
            *(u32x4*)(DC + (size_t)lp * (2 * CTXL) + j0) = pack8(v);
        }
        bf16* CS = (bf16*)(p.ws + WS_CS128);
        for (int it = gt; it < 256 * 32; it += NGT) {
            const int row = it >> 5, k0 = (it & 31) * 8, cs = row >> 7, cp = row & 127; float v[8];
#pragma unroll
            for (int e = 0; e < 8; ++e) { const int k = k0 + e; const int m = (cp * k) & 127; float s, c; sincospif((float)m * (1.0f / 64.0f), &s, &c); v[e] = k < 128 ? (cs == 0 ? c : s) * 0.08838834764831845f : 0.f; }
            *(u32x4*)(CS + (size_t)row * 256 + k0) = pack8(v);
        }
        float2* rope = (float2*)(p.ws + WS_ROPE);
        for (int it = gt; it < 64 * 16; it += NGT) { const int pos = it >> 4, j = it & 15; const float inv = powf(10000.0f, -(float)j * (1.0f / 16.0f)); const float a = (float)pos * inv; rope[it] = make_float2(cosf(a), sinf(a)); }
        if (gt < DEPTH) { const float* lm = p.in[I_LAMB] + gt * 4 * HD; float s0 = 0.f, s1 = 0.f; for (int d = 0; d < HD; ++d) { s0 += lm[d] * lm[HD + d]; s1 += lm[2 * HD + d] * lm[3 * HD + d]; }
            ((float*)(p.ws + WS_LAM))[gt] = expf(s0) - expf(s1) + (0.8f - 0.6f * expf(-0.3f * (float)gt)); }
    }
}

__device__ __forceinline__ void norm_row_finish(const LAS float* tab, bf16* xrow, const float (&f)[4][8], int lane) {
    float ss = 0.f;
#pragma unroll
    for (int j = 0; j < 4; ++j)
#pragma unroll
        for (int i = 0; i < 8; i += 2) ss += f[j][i] * f[j][i] + f[j][i + 1] * f[j][i + 1];
    const float rstd = rsqrtf(wave_sum(ss) * (1.0f / DM) + EPS_RMS);
#pragma unroll
    for (int j = 0; j < 4; ++j) { const int ci = 4 * (lane + 64 * j); float o[8];
        const f32x4 ae = *(const LAS f32x4*)(tab + ci), ao = *(const LAS f32x4*)(tab + 1024 + ci), be = *(const LAS f32x4*)(tab + 2048 + ci), bo = *(const LAS f32x4*)(tab + 3072 + ci);
#pragma unroll
        for (int i = 0; i < 4; ++i) { o[i] = (f[j][i] * rstd) * ae[i] + be[i]; o[4 + i] = (f[j][4 + i] * rstd) * ao[i] + bo[i]; }
        *(u32x4*)(xrow + 8 * (lane + 64 * j)) = pack8(o); }
}
template <int NR> __device__ __forceinline__ void norm_rows_bf16(const bf16* h, bf16* xn, const LAS float* tab, int row0, int lane) {
    u32x4 raw[NR][4];
#pragma unroll
    for (int r = 0; r < NR; ++r) { const u32x4* xr = (const u32x4*)(h + (size_t)(row0 + r) * DM) + lane;
#pragma unroll
        for (int j = 0; j < 4; ++j) raw[r][j] = xr[64 * j]; }
#pragma unroll
    for (int r = 0; r < NR; ++r) { float f[4][8];
#pragma unroll
        for (int j = 0; j < 4; ++j) unpack8(raw[r][j], f[j]);
        norm_row_finish(tab, xn + (size_t)(row0 + r) * DM, f, lane); }
}
__device__ __forceinline__ void norm_row_f32(const float* src, bf16* xrow, const LAS float* tab, int lane) {
    const f32x4* xr = (const f32x4*)src + 2 * lane; float f[4][8];
#pragma unroll
    for (int j = 0; j < 4; ++j) { const f32x4 a = xr[128 * j], b = xr[128 * j + 1]; f[j][0] = a[0]; f[j][1] = a[1]; f[j][2] = a[2]; f[j][3] = a[3]; f[j][4] = b[0]; f[j][5] = b[1]; f[j][6] = b[2]; f[j][7] = b[3]; }
    norm_row_finish(tab, xrow, f, lane);
}
__device__ __forceinline__ void norm_mod_phase(const Params& p, const Ctx& F0, int layer, int which) {
    const Ctx F = fresh(F0);
    const bf16* h = (const bf16*)(p.ws + WS_H); bf16* xn = (bf16*)(p.ws + WS_XN);
    const float* g = p.in[which == 0 ? I_G1 : I_G2] + (size_t)layer * DM;
    const float* modl = (const float*)(p.ws + WS_MOD) + (size_t)layer * 3 * NMOD;
    const int shoff = which == 0 ? 0 : 3 * DM, scoff = shoff + DM;
    LAS float* tab = (LAS float*)F.lds;
    for (int u = F.vcu; u < 256; u += F.G) {
        __syncthreads();
        { const int c4 = 4 * F.tid, li = (F.tid & 1) * 1024 + 4 * (F.tid >> 1);
          const f32x4 gg = *(const f32x4*)(g + c4);
#pragma unroll
          for (int s2 = 0; s2 < 2; ++s2) { const float* md = modl + (size_t)(s2 == 0 ? (u >> 7) : 2) * NMOD;
              const f32x4 sc = *(const f32x4*)(md + scoff + c4), sh = *(const f32x4*)(md + shoff + c4);
              *(LAS f32x4*)(tab + s2 * 4096 + li) = gg * (1.0f + sc); *(LAS f32x4*)(tab + s2 * 4096 + 2048 + li) = sh; } }
        __syncthreads();
        const int row0 = 32 * u + 4 * F.wave;
        if (layer == 0 && which == 0) {
            for (int r = 0; r < 4; ++r) norm_row_f32(p.in[I_X] + (size_t)(row0 + r) * DM, xn + (size_t)(row0 + r) * DM, tab, F.lane);
            if (F.wave < 2) norm_row_f32(p.in[I_CTX] + (size_t)(2 * u + F.wave) * DM, xn + (size_t)(ML + 2 * u + F.wave) * DM, tab + 4096, F.lane);
        } else {
            norm_rows_bf16<4>(h, xn, tab, row0, F.lane);
            if (F.wave < 2 && !(which == 1 && layer + 1 == DEPTH)) norm_rows_bf16<1>(h, xn, tab + 4096, ML + 2 * u + F.wave, F.lane);
        }
    }
}
__device__ __forceinline__ void mixer_prep_phase(const Params& p, const Ctx& F0, int layer) {
    const Ctx F = fresh(F0);
    const int gw = F.vcu * NWAVES + F.wave, NGW = F.G * NWAVES;
    const int gt = F.vcu * NTHR + F.tid, NGT = F.G * NTHR;
    const bf16* P = (const bf16*)(p.ws + WS_P);
    bf16* Qr = (bf16*)(p.ws + WS_QR); bf16* Kc = (bf16*)(p.ws + WS_KC); bf16* Vt = (bf16*)(p.ws + WS_VT); bf16* br = (bf16*)(p.ws + WS_BR);
    const float2* rope = (const float2*)(p.ws + WS_ROPE);
    for (int it = gt; it < MROWS * 128; it += NGT) {
        const int row = it >> 7, w = it & 127, tens = w >> 6, sub = w & 63, hh = sub >> 3, cc = (sub >> 2) & 1, ax = (sub >> 1) & 1, jh = sub & 1;
        const int base = hh * 128 + cc * 64 + ax * 32 + jh * 8;
        const RowInfo ri = row_info(row);
        const bf16* src = P + (size_t)row * NIN + (tens == 0 ? Q_OFF : K_OFF) + base;
        float x1[8], x2[8]; unpack8(*(const u32x4*)src, x1); unpack8(*(const u32x4*)(src + 16), x2);
        float o1[8], o2[8];
        if (!ri.ctx) { const int pa = ax == 0 ? (ri.pos >> 6) : (ri.pos & 63);
#pragma unroll
            for (int e = 0; e < 8; ++e) { const float2 cs = rope[pa * 16 + jh * 8 + e]; o1[e] = x1[e] * cs.x - x2[e] * cs.y; o2[e] = x2[e] * cs.x + x1[e] * cs.y; } }
        else {
#pragma unroll
            for (int e = 0; e < 8; ++e) { o1[e] = x1[e]; o2[e] = x2[e]; } }
        bf16* dst;
        if (tens == 0) {
#pragma unroll
            for (int e = 0; e < 8; ++e) { o1[e] *= QSCALE; o2[e] *= QSCALE; }
            dst = Qr + (size_t)row * QKW + base; }
        else dst = Kc + ((size_t)(ri.b * LK + ri.kv) * QKW + base);
        *(u32x4*)dst = pack8(o1); *(u32x4*)(dst + 16) = pack8(o2);
    }
    const float* cw = p.in[I_CONVW] + (size_t)layer * 3 * 512;
    for (int it = gt; it < MROWS * 64; it += NGT) {
        const int row = it >> 6, j0 = (it & 63) * 8; const RowInfo ri = row_info(row);
        const bf16* pr = P + (size_t)row * NIN + j0;
        float cb[8], a[8], b[8], acc[8];
        unpack8(*(const u32x4*)(pr + CB_OFF), cb);
        unpack8(*(const u32x4*)(pr + CC_OFF), a); unpack8(*(const u32x4*)(pr + CX_OFF), b);
#pragma unroll
        for (int e = 0; e < 8; ++e) acc[e] = a[e] * b[e] * cw[512 + j0 + e];
        if (ri.pos > 0) { unpack8(*(const u32x4*)(pr - NIN + CC_OFF), a); unpack8(*(const u32x4*)(pr - NIN + CX_OFF), b);
#pragma unroll
            for (int e = 0; e < 8; ++e) acc[e] += a[e] * b[e] * cw[j0 + e]; }
        if (ri.pos + 1 < ri.L) { unpack8(*(const u32x4*)(pr + NIN + CC_OFF), a); unpack8(*(const u32x4*)(pr + NIN + CX_OFF), b);
#pragma unroll
            for (int e = 0; e < 8; ++e) acc[e] += a[e] * b[e] * cw[1024 + j0 + e]; }
#pragma unroll
        for (int e = 0; e < 8; ++e) acc[e] *= cb[e];
        *(u32x4*)(br + (size_t)row * DM + 512 + j0) = pack8(acc);
    }
    LAS bf16* scr = (LAS bf16*)(F.lds + F.wave * 16384);
    for (int it = gw; it < (MROWS / 64) * 16; it += NGW) {
        const int tt = it >> 4, ct = it & 15, row0 = tt * 64; const RowInfo ri = row_info(row0);
#pragma unroll
        for (int i = 0; i < 8; ++i) { const int t = i * 8 + (F.lane >> 3), ch = F.lane & 7;
            const u32x4 w = *(const u32x4*)(P + (size_t)(row0 + t) * NIN + V_OFF + ct * 64 + ch * 8);
            const unsigned ww[4] = {w.x, w.y, w.z, w.w};
#pragma unroll
            for (int e = 0; e < 8; ++e) scr[(ch * 8 + e) * 72 + t] = (bf16)((ww[e >> 1] >> ((e & 1) * 16)) & 0xffffu); }
        LDS_WAIT(); asm volatile("" ::: "memory");
#pragma unroll
        for (int i = 0; i < 8; ++i) { const int col = i * 8 + (F.lane >> 3), ch = F.lane & 7;
            const u32x4 w = *(const LAS u32x4*)(scr + col * 72 + ch * 8);
            *(u32x4*)(Vt + ((size_t)(ri.b * QKW + ct * 64 + col) * LK + ri.kv + ch * 8)) = w; }
        LDS_WAIT(); asm volatile("" ::: "memory");
    }
}
__device__ __forceinline__ void ffn_act_phase(const Params& p, const Ctx& F0, int layer) {
    const Ctx F = fresh(F0);
    const int gt = F.vcu * NTHR + F.tid, NGT = F.G * NTHR;
    const bf16* Y = (const bf16*)(p.ws + WS_P); bf16* act = (bf16*)(p.ws + WS_ACT);
    const float* cw = p.in[I_FCONVW] + (size_t)layer * 3 * NUP;
    for (int it = gt; it < MROWS * (DFF / 8); it += NGT) {
        const int row = it / (DFF / 8), j0 = (it % (DFF / 8)) * 8; const RowInfo ri = row_info(row);
        const bf16* pr = Y + (size_t)row * NUP + j0;
        float a[8], v[8], ua[8], uv[8];
        unpack8(*(const u32x4*)pr, a); unpack8(*(const u32x4*)(pr + DFF), v);
#pragma unroll
        for (int e = 0; e < 8; ++e) { ua[e] = a[e] * cw[NUP + j0 + e]; uv[e] = v[e] * cw[NUP + DFF + j0 + e]; }
        if (ri.pos > 0) { unpack8(*(const u32x4*)(pr - NUP), a); unpack8(*(const u32x4*)(pr - NUP + DFF), v);
#pragma unroll
            for (int e = 0; e < 8; ++e) { ua[e] += a[e] * cw[j0 + e]; uv[e] += v[e] * cw[DFF + j0 + e]; } }
        if (ri.pos + 1 < ri.L) { unpack8(*(const u32x4*)(pr + NUP), a); unpack8(*(const u32x4*)(pr + NUP + DFF), v);
#pragma unroll
            for (int e = 0; e < 8; ++e) { ua[e] += a[e] * cw[2 * NUP + j0 + e]; uv[e] += v[e] * cw[2 * NUP + DFF + j0 + e]; } }
        float o[8];
#pragma unroll
        for (int e = 0; e < 8; ++e) o[e] = ua[e] * sigmoidf_(ua[e]) * uv[e];
        *(u32x4*)(act + (size_t)row * DFF + j0) = pack8(o);
    }
}
__device__ __forceinline__ void act_fix_phase(const Params& p, const Ctx& F0, int layer) {
    const Ctx F = fresh(F0);
    const int gt = F.vcu * NTHR + F.tid, NGT = F.G * NTHR;
    const float* halo = (const float*)(p.ws + WS_HALO); bf16* act = (bf16*)(p.ws + WS_ACT);
    const float* cw = p.in[I_FCONVW] + (size_t)layer * 3 * NUP;
    for (int it = gt; it < 30 * 2 * DFF; it += NGT) {
        const int j = it % DFF, rb = it / DFF, side = rb & 1, bi = rb >> 1, pm = bi + bi / 15;
        float ua, uv; int row;
        if (side == 0) {
            const float* hp = halo + (size_t)pm * 8 * DFF, *hn = halo + (size_t)(pm + 1) * 8 * DFF;
            ua = hp[(3 * 2 + 0) * DFF + j] + cw[2 * NUP + j] * hn[(0 * 2 + 0) * DFF + j]; uv = hp[(3 * 2 + 1) * DFF + j] + cw[2 * NUP + DFF + j] * hn[(0 * 2 + 1) * DFF + j]; row = pm * 256 + 255;
        } else {
            const float* hp = halo + (size_t)pm * 8 * DFF, *hn = halo + (size_t)(pm + 1) * 8 * DFF;
            ua = hn[(2 * 2 + 0) * DFF + j] + cw[j] * hp[(1 * 2 + 0) * DFF + j]; uv = hn[(2 * 2 + 1) * DFF + j] + cw[DFF + j] * hp[(1 * 2 + 1) * DFF + j]; row = (pm + 1) * 256;
        }
        act[(size_t)row * DFF + j] = (bf16)pk2(ua * sigmoidf_(ua) * uv, 0.f);
    }
}
__device__ __forceinline__ void final_norm_phase(const Params& p, const Ctx& F0) {
    const Ctx F = fresh(F0);
    const int gw = F.vcu * NWAVES + F.wave, NGW = F.G * NWAVES;
    const bf16* h = (const bf16*)(p.ws + WS_H); const float* g = p.in[I_GFIN];
    for (int row = gw; row < ML; row += NGW) {
        const u32x4* xr = (const u32x4*)(h + (size_t)row * DM) + F.lane;
        float v[4][8]; float ss = 0.f;
#pragma unroll
        for (int j = 0; j < 4; ++j) { unpack8(xr[64 * j], v[j]);
#pragma unroll
            for (int e = 0; e < 8; ++e) ss += v[j][e] * v[j][e]; }
        const float rstd = rsqrtf(wave_sum(ss) * (1.0f / DM) + EPS_RMS);
#pragma unroll
        for (int j = 0; j < 4; ++j) { const int col = 8 * (F.lane + 64 * j); const f32x4 g0 = *(const f32x4*)(g + col), g1 = *(const f32x4*)(g + col + 4);
            f32x4* orow = (f32x4*)(p.out + (size_t)row * DM + col);
            orow[0] = (f32x4){v[j][0], v[j][1], v[j][2], v[j][3]} * rstd * g0; orow[1] = (f32x4){v[j][4], v[j][5], v[j][6], v[j][7]} * rstd * g1; }
    }
}

constexpr float AT_TRIG = 65536.0f;
constexpr int AT_KP = 144;
constexpr int AT_K0 = 0, AT_K1 = 64 * AT_KP, AT_V = 2 * 64 * AT_KP, AT_STG = AT_V + 128 * AT_KP;
__device__ __forceinline__ float swap32_max(float v) { auto rr = __builtin_amdgcn_permlane32_swap(__float_as_uint(v), __float_as_uint(v), false, false); return fmaxf(__uint_as_float(rr[0]), __uint_as_float(rr[1])); }
__device__ __forceinline__ float swap32_sum(float v) { auto rr = __builtin_amdgcn_permlane32_swap(__float_as_uint(v), __float_as_uint(v), false, false); return __uint_as_float(rr[0]) + __uint_as_float(rr[1]); }
__device__ __forceinline__ void attn_unit(const Params& p, const Ctx& F0, int layer, int b, int h, int qrow0, int nk) {
    const Ctx F = fresh(F0);
    const bf16* Qr = (const bf16*)(p.ws + WS_QR); const bf16* Kc = (const bf16*)(p.ws + WS_KC) + (size_t)b * LK * QKW + h * 128; const bf16* Vt = (const bf16*)(p.ws + WS_VT) + (size_t)(b * QKW + h * 128) * LK;
    bf16* br = (bf16*)(p.ws + WS_BR);
    const int tid = F.tid, lane = F.lane, wid = F.wave, comp = wid >> 2, qw = wid & 3, r32 = lane & 31, hi = lane >> 5;
    LAS unsigned char* lds = F.lds;
    const int srow = tid >> 3, sch = tid & 7;
    const bf16* gk = Kc + (size_t)srow * QKW + sch * 8;
    const bf16* gv = Vt + (size_t)srow * LK + sch * 8;
    const int sk = srow * AT_KP + sch * 16;
    u32x4 st0, st1, st2, st3;
#define AT_LOAD(t) do { const bf16* k_ = gk + (size_t)(t) * 64 * QKW; const bf16* v_ = gv + (t) * 64; st0 = *(const u32x4*)k_; st1 = *(const u32x4*)(k_ + 64); st2 = *(const u32x4*)v_; st3 = *(const u32x4*)(v_ + (size_t)64 * LK); } while (0)
#define AT_STORE(s) do { LAS unsigned char* d_ = lds + (s) * AT_STG; *(LAS u32x4*)(d_ + AT_K0 + sk) = st0; *(LAS u32x4*)(d_ + AT_K1 + sk) = st1; *(LAS u32x4*)(d_ + AT_V + sk) = st2; *(LAS u32x4*)(d_ + AT_V + 64 * AT_KP + sk) = st3; } while (0)
    const int nt = nk / 64;
    AT_LOAD(0);
    bf16x8 qf[4];
    { const bf16* qp = Qr + (size_t)(qrow0 + qw * 32 + r32) * QKW + h * 128 + comp * 64 + hi * 8;
#pragma unroll
      for (int d0 = 0; d0 < 4; ++d0) qf[d0] = *(const bf16x8*)(qp + d0 * 16); }
    AT_STORE(0);
    f32x16 ot[4];
#pragma unroll
    for (int i = 0; i < 4; ++i)
#pragma unroll
        for (int r = 0; r < 16; ++r) ot[i][r] = 0.f;
    float mrun = 0.f, lrun = 0.f;
    const int krow = (r32 & 19) | ((r32 & 4) << 1) | ((r32 & 8) >> 1);
    const int kfo = (comp ? AT_K1 : AT_K0) + krow * AT_KP + hi * 16;
    const int vfo = AT_V + r32 * AT_KP + hi * 16;
    bf16x8 pprev[4];
#pragma unroll
    for (int i = 0; i < 4; ++i) pprev[i] = (bf16x8){0, 0, 0, 0, 0, 0, 0, 0};
    bf16x8 va0, va1, va2, va3, vb0, vb1, vb2, vb3;
    va0 = va1 = va2 = va3 = (bf16x8){0, 0, 0, 0, 0, 0, 0, 0};
#define AT_VRD(vb_, f_) (*(const LAS bf16x8*)((vb_) + ((f_) & 3) * 32 * AT_KP + ((f_) >> 2) * 32))
#define AT_SB() __builtin_amdgcn_sched_barrier(0)
#define AT_PVPRE(stage_) do { const LAS unsigned char* vb_ = lds + (stage_) * AT_STG + vfo; va0 = AT_VRD(vb_, 0); va1 = AT_VRD(vb_, 1); va2 = AT_VRD(vb_, 2); va3 = AT_VRD(vb_, 3); } while (0)
#define AT_MF(i_, v_, g_, pf_) ot[i_] = __builtin_amdgcn_mfma_f32_32x32x16_bf16(v_, pf_[g_], ot[i_], 0, 0, 0)
#define AT_PV(stage_, pf_) do { const LAS unsigned char* vb_ = lds + (stage_) * AT_STG + vfo; AT_SB(); \
        vb0 = AT_VRD(vb_, 4);  AT_MF(0, va0, 0, pf_); AT_SB(); vb1 = AT_VRD(vb_, 5);  AT_MF(1, va1, 0, pf_); AT_SB(); vb2 = AT_VRD(vb_, 6);  AT_MF(2, va2, 0, pf_); AT_SB(); vb3 = AT_VRD(vb_, 7);  AT_MF(3, va3, 0, pf_); AT_SB(); \
        va0 = AT_VRD(vb_, 8);  AT_MF(0, vb0, 1, pf_); AT_SB(); va1 = AT_VRD(vb_, 9);  AT_MF(1, vb1, 1, pf_); AT_SB(); va2 = AT_VRD(vb_, 10); AT_MF(2, vb2, 1, pf_); AT_SB(); va3 = AT_VRD(vb_, 11); AT_MF(3, vb3, 1, pf_); AT_SB(); \
        vb0 = AT_VRD(vb_, 12); AT_MF(0, va0, 2, pf_); AT_SB(); vb1 = AT_VRD(vb_, 13); AT_MF(1, va1, 2, pf_); AT_SB(); vb2 = AT_VRD(vb_, 14); AT_MF(2, va2, 2, pf_); AT_SB(); vb3 = AT_VRD(vb_, 15); AT_MF(3, va3, 2, pf_); AT_SB(); \
        AT_MF(0, vb0, 3, pf_); AT_MF(1, vb1, 3, pf_); AT_MF(2, vb2, 3, pf_); AT_MF(3, vb3, 3, pf_); AT_SB(); } while (0)
    __syncthreads();
    int s_prev = 2, s_cur = 0, s_next = 1;
    for (int t = 0; t < nt; ++t) {
        if (t + 1 < nt) AT_LOAD(t + 1);
        bf16x8 kf[8];
        { const LAS unsigned char* kb_ = lds + s_cur * AT_STG + kfo;
#pragma unroll
          for (int f = 0; f < 8; ++f) kf[f] = *(const LAS bf16x8*)(kb_ + (f >> 2) * 32 * AT_KP + (f & 3) * 32); }
        if (comp && t > 0) AT_PV(s_prev, pprev);
        const LAS unsigned char* sb = lds + s_cur * AT_STG;
        f32x16 sc[2];
        const bool ref0 = !__any(mrun != 0.f);
#define AT_QK() do { AT_SB(); _Pragma("unroll") for (int d0 = 0; d0 < 4; ++d0) { sc[0] = __builtin_amdgcn_mfma_f32_32x32x16_bf16(kf[d0], qf[d0], sc[0], 0, 0, 0); sc[1] = __builtin_amdgcn_mfma_f32_32x32x16_bf16(kf[4 + d0], qf[d0], sc[1], 0, 0, 0); } AT_SB(); } while (0)
        if (ref0) {
#pragma unroll
            for (int r = 0; r < 16; ++r) { sc[0][r] = 0.f; sc[1][r] = 0.f; }
            AT_QK();
        } else {
#pragma unroll
            for (int r = 0; r < 16; ++r) { sc[0][r] = -mrun; sc[1][r] = -mrun; }
            AT_QK();
        }
#undef AT_QK
        if (!comp) AT_PVPRE(s_cur);
        f32x16 ex[2];
#pragma unroll
        for (int kh = 0; kh < 2; ++kh)
#pragma unroll
            for (int r = 0; r < 16; ++r) ex[kh][r] = __builtin_amdgcn_exp2f(sc[kh][r]);
        float ps;
        { float a0 = ex[0][0], a1 = ex[1][0];
#pragma unroll
          for (int r = 1; r < 16; ++r) { a0 += ex[0][r]; if ((r & 3) == 3) asm volatile("" : "+v"(a0)); }
#pragma unroll
          for (int r = 1; r < 16; ++r) { a1 += ex[1][r]; if ((r & 3) == 1) asm volatile("" : "+v"(a1)); }
          ps = a0 + a1; }
        const float pst = swap32_sum(ps);
        if (t == 0 || __any(!(pst < AT_TRIG))) {
            float mx = fmaxf(sc[0][0], sc[1][0]);
#pragma unroll
            for (int r = 1; r < 16; ++r) mx = fmaxf(mx, fmaxf(sc[0][r], sc[1][r]));
            mx = swap32_max(mx);
            const float dl = (!(pst < AT_TRIG) || (t == 0 && fabsf(mx) > 16.f)) ? mx : 0.f;
            mrun += dl;
            const float alpha = __builtin_amdgcn_exp2f(-dl);
            lrun *= alpha;
            ps = 0.f;
#pragma unroll
            for (int kh = 0; kh < 2; ++kh)
#pragma unroll
                for (int r = 0; r < 16; ++r) { const float e = __builtin_amdgcn_exp2f(sc[kh][r] - dl); ex[kh][r] = e; ps += e; }
            if (t > 0) {
#pragma unroll
                for (int i = 0; i < 4; ++i)
#pragma unroll
                    for (int r = 0; r < 16; ++r) ot[i][r] *= alpha;
            }
        }
        lrun += ps;
#pragma unroll
        for (int kh = 0; kh < 2; ++kh)
#pragma unroll
            for (int s2 = 0; s2 < 2; ++s2) {
                u32x4 pw; pw.x = pk2(ex[kh][8 * s2 + 0], ex[kh][8 * s2 + 1]); pw.y = pk2(ex[kh][8 * s2 + 2], ex[kh][8 * s2 + 3]); pw.z = pk2(ex[kh][8 * s2 + 4], ex[kh][8 * s2 + 5]); pw.w = pk2(ex[kh][8 * s2 + 6], ex[kh][8 * s2 + 7]);
                pprev[kh * 2 + s2] = __builtin_bit_cast(bf16x8, pw);
            }
        if (!comp) AT_PV(s_cur, pprev);
        if (t + 1 < nt) AT_STORE(s_next);
        if (comp) AT_PVPRE(s_cur);
        __syncthreads();
        { const int tmp = s_prev; s_prev = s_cur; s_cur = s_next; s_next = tmp; }
    }
    if (comp) AT_PV(s_prev, pprev);
    __syncthreads();
#undef AT_PV
#undef AT_PVPRE
#undef AT_MF
#undef AT_VRD
    const float ltot = swap32_sum(lrun);
    const float lam = ((const float*)(p.ws + WS_LAM))[layer];
    const float inv = comp ? lam / ltot : 1.0f / ltot;
    LAS float* xb = (LAS float*)lds;
    if (comp) {
#pragma unroll
        for (int i = 0; i < 4; ++i)
#pragma unroll
            for (int r = 0; r < 16; ++r) xb[(qw * 64 + i * 16 + r) * 64 + lane] = ot[i][r] * inv;
    }
    __syncthreads();
    if (!comp) {
        float ss = 0.f;
#pragma unroll
        for (int i = 0; i < 4; ++i)
#pragma unroll
            for (int r = 0; r < 16; ++r) { const float o = ot[i][r] * inv - xb[(qw * 64 + i * 16 + r) * 64 + lane]; ot[i][r] = o; ss += o * o; }
        ss = swap32_sum(ss);
        const float lam_init = 0.8f - 0.6f * __expf(-0.3f * (float)layer);
        const float rs = rsqrtf(ss * (1.0f / 128.0f) + EPS_SUBLN) * (1.0f - lam_init);
        const float* sg = p.in[I_SUBG] + layer * VD;
        bf16* op = br + (size_t)(qrow0 + qw * 32 + r32) * DM + 1024 + h * 128;
#pragma unroll
        for (int i = 0; i < 4; ++i)
#pragma unroll
            for (int g4 = 0; g4 < 4; ++g4) { const int dv = 32 * i + 8 * g4 + 4 * hi; const f32x4 gg = *(const f32x4*)(sg + dv);
                u32x2 w; w.x = pk2(ot[i][4 * g4 + 0] * rs * gg[0], ot[i][4 * g4 + 1] * rs * gg[1]); w.y = pk2(ot[i][4 * g4 + 2] * rs * gg[2], ot[i][4 * g4 + 3] * rs * gg[3]);
                *(u32x2*)(op + dv) = w; }
    }
    __syncthreads();
#undef AT_LOAD
#undef AT_STORE
}
__device__ __forceinline__ void attn_phase(const Params& p, const Ctx& F, int layer) {
    const int nunit = layer + 1 < DEPTH ? 512 + 32 : 512;
    for (int u = F.vcu; u < nunit; u += F.G) {
        if (u < 512) { const int bh = u >> 5, qb = u & 31, b = bh >> 3, h = bh & 7; attn_unit(p, F, layer, b, h, b * SEQ + qb * 128, LK); }
        else { const int v = u - 512, bh = v >> 1, qb = v & 1, b = bh >> 3, h = bh & 7; attn_unit(p, F, layer, b, h, ML + b * CTXL + qb * 128, CTXL); }
    }
}

constexpr int FM_PITCH = 288, FM_WA = 0, FM_WC = 128 * FM_PITCH, FM_IMG = FM_WC + 64 * FM_PITCH, FM_IMGB = 64 * FM_PITCH;
__device__ __forceinline__ void fmix_phase(const Params& p, const Ctx& F0) {
    const Ctx F = fresh(F0);
    LAS unsigned char* lds = F.lds;
    const bf16* T = (const bf16*)(p.ws + WS_T); bf16* br = (bf16*)(p.ws + WS_BR); const float2* tw = (const float2*)(p.ws + WS_FTW);
    for (int idx = F.tid; idx < 128 * 16; idx += NTHR) { const int r = idx >> 4, ch = idx & 15; *(LAS u32x4*)(lds + FM_WA + r * FM_PITCH + ch * 16) = *(const u32x4*)((const bf16*)(p.ws + WS_FWA) + r * 128 + ch * 8); }
    for (int idx = F.tid; idx < 64 * 16; idx += NTHR) { const int r = idx >> 4, ch = idx & 15; *(LAS u32x4*)(lds + FM_WC + r * FM_PITCH + ch * 16) = *(const u32x4*)((const bf16*)(p.ws + WS_FWC) + r * 128 + ch * 8); }
    const int c = F.wave >> 1, h = F.wave & 1, l15 = F.lane & 15, kq = F.lane >> 4;
    LAS unsigned char* img = lds + FM_IMG + c * FM_IMGB;
    for (int u = F.vcu; u < 256; u += F.G) {
        const int batch = u >> 7, n0 = (u & 127) * 4;
        __syncthreads();
#pragma unroll
        for (int it = 0; it < 8; ++it) { const int cc = it >> 1, part = it & 1, a = F.lane, bg = F.wave;
            const u32x4 w = *(const u32x4*)(T + ((size_t)(batch * 512 + n0 + cc) * (2 * SEQ) + part * SEQ + 64 * a + 8 * bg));
            LAS bf16* d = (LAS bf16*)(lds + FM_IMG + cc * FM_IMGB + (8 * bg) * FM_PITCH + (part * 64 + a) * 2);
            const unsigned ww[4] = {w.x, w.y, w.z, w.w};
#pragma unroll
            for (int e = 0; e < 8; ++e) d[e * (FM_PITCH / 2)] = (bf16)((ww[e >> 1] >> ((e & 1) * 16)) & 0xffffu); }
        __syncthreads();
        f32x4 ya[4][4];
#pragma unroll
        for (int mi = 0; mi < 4; ++mi)
#pragma unroll
            for (int nt = 0; nt < 4; ++nt) ya[mi][nt] = (f32x4){0.f, 0.f, 0.f, 0.f};
#pragma unroll
        for (int ks = 0; ks < 4; ++ks) {
            bf16x8 af[4], bfr[4];
#pragma unroll
            for (int mi = 0; mi < 4; ++mi) { const int mt = (mi >> 1) * 4 + 2 * h + (mi & 1); af[mi] = *(const LAS bf16x8*)(lds + FM_WA + (16 * mt + l15) * FM_PITCH + (32 * ks + 8 * kq) * 2); }
#pragma unroll
            for (int nt = 0; nt < 4; ++nt) bfr[nt] = *(const LAS bf16x8*)(img + (16 * nt + l15) * FM_PITCH + (32 * ks + 8 * kq) * 2);
#pragma unroll
            for (int mi = 0; mi < 4; ++mi)
#pragma unroll
                for (int nt = 0; nt < 4; ++nt) ya[mi][nt] = __builtin_amdgcn_mfma_f32_16x16x32_bf16(af[mi], bfr[nt], ya[mi][nt], 0, 0, 0);
        }
        __syncthreads();
#pragma unroll
        for (int mi = 0; mi < 2; ++mi)
#pragma unroll
            for (int nt = 0; nt < 4; ++nt)
#pragma unroll
                for (int r = 0; r < 4; ++r) { const int ap = 16 * (2 * h + mi) + 4 * kq + r, b = 16 * nt + l15; const float2 cs = tw[ap * b];
                    const float yre = ya[mi][nt][r], yim = ya[2 + mi][nt][r];
                    LAS bf16* d = (LAS bf16*)(img + ap * FM_PITCH + b * 2);
                    d[0] = (bf16)f2bf(yre * cs.x + yim * cs.y); d[64] = (bf16)f2bf(yim * cs.x - yre * cs.y); }
        __syncthreads();
        f32x4 xa[2][4];
#pragma unroll
        for (int mi = 0; mi < 2; ++mi)
#pragma unroll
            for (int nt = 0; nt < 4; ++nt) xa[mi][nt] = (f32x4){0.f, 0.f, 0.f, 0.f};
#pragma unroll
        for (int ks = 0; ks < 4; ++ks) {
            bf16x8 af[2], bfr[4];
#pragma unroll
            for (int mi = 0; mi < 2; ++mi) af[mi] = *(const LAS bf16x8*)(img + (16 * (2 * h + mi) + l15) * FM_PITCH + (32 * ks + 8 * kq) * 2);
#pragma unroll
            for (int nt = 0; nt < 4; ++nt) bfr[nt] = *(const LAS bf16x8*)(lds + FM_WC + (16 * nt + l15) * FM_PITCH + (32 * ks + 8 * kq) * 2);
#pragma unroll
            for (int mi = 0; mi < 2; ++mi)
#pragma unroll
                for (int nt = 0; nt < 4; ++nt) xa[mi][nt] = __builtin_amdgcn_mfma_f32_16x16x32_bf16(af[mi], bfr[nt], xa[mi][nt], 0, 0, 0);
        }
        __syncthreads();
        LAS bf16* xs = (LAS bf16*)(lds + FM_IMG);
#pragma unroll
        for (int mi = 0; mi < 2; ++mi)
#pragma unroll
            for (int nt = 0; nt < 4; ++nt)
#pragma unroll
                for (int r = 0; r < 4; ++r) { const int ap = 16 * (2 * h + mi) + 4 * kq + r, bp = 16 * nt + l15; xs[(ap + 64 * bp) * 4 + c] = (bf16)f2bf(xa[mi][nt][r]); }
        __syncthreads();
#pragma unroll
        for (int it = 0; it < 8; ++it) { const int lp = F.tid + NTHR * it; *(u32x2*)(br + (size_t)(batch * SEQ + lp) * DM + n0) = *(const LAS u32x2*)(xs + lp * 4); }
    }
    __syncthreads();
}

constexpr int CG_STG = 32768, CG_B = 16384;
template <int MODE> __device__ __forceinline__ void ctx_gemm(const Params& p, const Ctx& F0, int layer) {
    const Ctx F = fresh(F0);
    const bf16* A; const bf16* Bt; int lda, K;
    if (MODE == 0) { A = (const bf16*)(p.ws + WS_BR); Bt = wl(p, layer, W_BM); lda = DM; K = DM; }
    else if (MODE == 1) { A = (const bf16*)(p.ws + WS_MRG); Bt = wl(p, layer, W_OUT); lda = DM; K = DM; }
    else if (MODE == 2) { A = (const bf16*)(p.ws + WS_ACT); Bt = wl(p, layer, W_DOWN); lda = DFF; K = DFF; }
    else { A = (const bf16*)(p.ws + WS_DC); Bt = (const bf16*)(p.ws + WS_TC); lda = 2 * CTXL; K = 2 * CTXL; }
    const int NU = MODE == 3 ? 64 : 256;
    const int ldb = lda, fr = F.lane & 15, fq = F.lane >> 4, nch = K / 128;
    LAS unsigned char* lds = F.lds;
    const int rb = F.wave >> 1, cb0 = 2 * (F.wave & 1);
    const int dr = 8 * F.wave + (F.lane >> 4), dp = F.lane & 15;
    for (int u = F.vcu; u < NU; u += F.G) {
        int row0 = ML + (u & 7) * 64, col0 = ((u >> 5) * 4 + ((u >> 3) & 3)) * 64;
        size_t arow = (size_t)row0, brow = (size_t)col0;
        if (MODE == 3) { const int b3 = u >> 5, rk = (u >> 3) & 3, ck = u & 7; row0 = ML + b3 * CTXL + rk * 64; col0 = ck * 64; arow = (size_t)rk * 64; brow = (size_t)b3 * 512 + ck * 64; }
        const bf16* ga0 = A + (size_t)(arow + dr) * lda + ((dp ^ (dr & 15)) << 3); const bf16* ga1 = A + (size_t)(arow + dr + 4) * lda + ((dp ^ ((dr + 4) & 15)) << 3);
        const bf16* gb0 = Bt + (size_t)(brow + dr) * ldb + ((dp ^ (dr & 15)) << 3); const bf16* gb1 = Bt + (size_t)(brow + dr + 4) * ldb + ((dp ^ ((dr + 4) & 15)) << 3);
#define CG_DMA(t) do { LAS unsigned char* d_ = lds + ((t) & 3) * CG_STG + F.wave * 2048; const int ko_ = (t) * 128; \
        __builtin_amdgcn_global_load_lds((const unsigned*)(ga0 + ko_), (LAS unsigned*)(d_), 16, 0, 0); __builtin_amdgcn_global_load_lds((const unsigned*)(ga1 + ko_), (LAS unsigned*)(d_ + 1024), 16, 0, 0); \
        __builtin_amdgcn_global_load_lds((const unsigned*)(gb0 + ko_), (LAS unsigned*)(d_ + CG_B), 16, 0, 0); __builtin_amdgcn_global_load_lds((const unsigned*)(gb1 + ko_), (LAS unsigned*)(d_ + CG_B + 1024), 16, 0, 0); } while (0)
        asm volatile("s_waitcnt vmcnt(0) lgkmcnt(0)\n\ts_barrier" ::: "memory");
        const int nsc = nch / 2;
        CG_DMA(0); CG_DMA(1);
        f32x4 acc[2] = {{0.f, 0.f, 0.f, 0.f}, {0.f, 0.f, 0.f, 0.f}}, tot[2] = {{0.f, 0.f, 0.f, 0.f}, {0.f, 0.f, 0.f, 0.f}};
        asm volatile("s_waitcnt vmcnt(0)\n\ts_barrier" ::: "memory");
        const int ao = (16 * rb + fr) * 256, bo = CG_B + (16 * cb0 + fr) * 256;
        for (int sc = 0; sc < nsc; ++sc) {
            if (sc + 1 < nsc) { CG_DMA(2 * sc + 2); CG_DMA(2 * sc + 3); }
#pragma unroll
            for (int hh = 0; hh < 2; ++hh) {
                const LAS unsigned char* sb = lds + ((2 * sc + hh) & 3) * CG_STG;
#pragma unroll
                for (int ks = 0; ks < 4; ++ks) { const int po = ((4 * ks + fq) ^ fr) << 4;
                    const bf16x8 af = *(const LAS bf16x8*)(sb + ao + po), b0 = *(const LAS bf16x8*)(sb + bo + po), b1 = *(const LAS bf16x8*)(sb + bo + 16 * 256 + po);
                    acc[0] = __builtin_amdgcn_mfma_f32_16x16x32_bf16(b0, af, acc[0], 0, 0, 0); acc[1] = __builtin_amdgcn_mfma_f32_16x16x32_bf16(b1, af, acc[1], 0, 0, 0); }
            }
            if (MODE == 0 && (sc == 1 || sc == 3 || sc == 7)) {
                const int goff = sc == 1 ? 0 : (sc == 3 ? DM : 2 * DM);
#pragma unroll
                for (int j = 0; j < 2; ++j) { const unsigned gw = *(const unsigned*)((const unsigned char*)(p.ws + WS_G8) + (size_t)(row0 + 16 * rb + fr) * NG8 + goff + col0 + 16 * (cb0 + j) + 4 * fq);
#pragma unroll
                    for (int i = 0; i < 4; ++i) { tot[j][i] += ((float)((gw >> (8 * i)) & 255u) * (1.0f / 255.0f)) * acc[j][i]; acc[j][i] = 0.f; } }
            }
            asm volatile("s_waitcnt vmcnt(0) lgkmcnt(0)\n\ts_barrier" ::: "memory");
        }
#undef CG_DMA
#pragma unroll
        for (int j = 0; j < 2; ++j) { const int row = row0 + 16 * rb + fr, col = col0 + 16 * (cb0 + j) + 4 * fq;
            if (MODE == 0) { u32x2 w; w.x = pk2(tot[j][0], tot[j][1]); w.y = pk2(tot[j][2], tot[j][3]); *(u32x2*)((bf16*)(p.ws + WS_MRG) + (size_t)row * DM + col) = w; }
            else if (MODE == 3) { u32x2 w; w.x = pk2(acc[j][0], acc[j][1]); w.y = pk2(acc[j][2], acc[j][3]); *(u32x2*)((bf16*)(p.ws + WS_BR) + (size_t)row * DM + col) = w; }
            else { const f32x4 gt = *(const f32x4*)((const float*)(p.ws + WS_MOD) + ((size_t)layer * 3 + 2) * NMOD + (MODE == 1 ? 2 * DM : 5 * DM) + col);
                bf16* hp = (bf16*)(p.ws + WS_H) + (size_t)row * DM + col;
                f32x4 sv;
                if (MODE == 1 && layer == 0) sv = *(const f32x4*)(p.in[I_CTX] + (size_t)(row - ML) * DM + col);
                else { const u32x2 hw = *(const u32x2*)hp; sv = (f32x4){bflo(hw.x), bfhi(hw.x), bflo(hw.y), bfhi(hw.y)}; }
                const f32x4 r = sv + gt * acc[j];
                u32x2 w; w.x = pk2(r[0], r[1]); w.y = pk2(r[2], r[3]); *(u32x2*)hp = w; } }
    }
    asm volatile("s_waitcnt vmcnt(0) lgkmcnt(0)" ::: "memory");
    __syncthreads();
}

constexpr int STEPS_PER_LAYER = 10, N_STEPS = 1 + DEPTH * STEPS_PER_LAYER + 1;
enum { SK_GEMM = 1, SK_ATTN = 2 };
struct Args { Params p; int lo, hi, li, skip; };
template <class E> __device__ __forceinline__ void run_gemm(const Ctx& F, const GemmJob& j, const E& e, int rot) {
    int c = (int)((blockIdx.x + (unsigned)rot) % (unsigned)F.G); asm volatile("" : "+s"(c));
    pg8::Sched S; S.init(j, F.G, c);
    int wv = F.wave; asm volatile("" : "+s"(wv));
    pg8::gemm_phase<E>(F.lds, j, S, e, wv);
}
__global__ void __launch_bounds__(NTHR, 2) mega(Args a) {
    extern __shared__ __attribute__((aligned(16))) unsigned char lds_raw[];
    Ctx F; F.lds = (LAS unsigned char*)lds_raw; F.tid = threadIdx.x; F.lane = F.tid & 63; F.wave = __builtin_amdgcn_readfirstlane(F.tid >> 6);
    F.G = gridDim.x; { const int bx = blockIdx.x; F.vcu = (F.G % 8 == 0) ? (bx % 8) * (F.G / 8) + bx / 8 : bx; }
    const Params& p = a.p;
    volatile LAS unsigned* MISC = (volatile LAS unsigned*)(F.lds + MISC_OFF);
    if (F.tid < 64) MISC[F.tid] = 0u;
    __syncthreads();
    XcdBarrier bar; bar.bar = (unsigned*)(p.ws + WS_CTL) + CW_BAR + a.li * 4096; bar.x = 0; bar.st = MISC + 8;
    if (a.hi - a.lo > 1) bar = xcd_barrier_post(bar.bar, MISC + 8);
    const int lo = a.lo, hi = a.hi;
    const bool do_gemm = !(a.skip & SK_GEMM), do_attn = !(a.skip & SK_ATTN);
#define IN(k) (lo <= (k) && (k) < hi)
#define SEAM(k) do { if (IN(k) && IN((k) + 1)) xcd_barrier(bar); } while (0)
#define REPEAT(k, body) do { _Pragma("nounroll") for (int r_ = 0; r_ < ((PROBE_STEP == (k)) ? 1 + PROBE_REP : 1); ++r_) { const bool first_ = (r_ == 0); (void)first_; body; if (r_ + 1 < ((PROBE_STEP == (k)) ? 1 + PROBE_REP : 1)) xcd_barrier(bar); } } while (0)
    if (IN(0)) REPEAT(10, { prologue(p, F); __syncthreads(); });
    SEAM(0);
    for (int l = 0; l < DEPTH; ++l) {
        const int s0 = 1 + l * STEPS_PER_LAYER;
        if (IN(s0 + 0)) REPEAT(0, norm_mod_phase(p, F, l, 0));
        SEAM(s0 + 0);
        if (IN(s0 + 1) && do_gemm) REPEAT(1, run_gemm(F, job_win(p, l), EWin{(bf16*)(p.ws + WS_P), (unsigned char*)(p.ws + WS_G8)}, 0));
        SEAM(s0 + 1);
        if (IN(s0 + 2)) REPEAT(2, {
            mixer_prep_phase(p, F, l); __syncthreads();
            if (do_gemm) { run_gemm(F, job_f1(p, false), epi_f1(p, false), 0); run_gemm(F, job_f1(p, true), epi_f1(p, true), F.G - 128); }
        });
        SEAM(s0 + 2);
        if (IN(s0 + 3)) {
#if MK_FFT
            REPEAT(30, { if (do_gemm) { fmix_phase(p, F); if (l + 1 < DEPTH) ctx_gemm<3>(p, F, l); } });
#else
            REPEAT(30, { if (do_gemm) { run_gemm(F, job_f2(p, false), epi_f2(p, false), 0); run_gemm(F, job_f2(p, true), epi_f2(p, true), F.G - 64); } });
#endif
            REPEAT(31, { if (do_attn) attn_phase(p, F, l); });
        }
        SEAM(s0 + 3);
        if (IN(s0 + 4) && do_gemm) REPEAT(4, { run_gemm(F, job_merge1(p, l), EMerge1{(const unsigned char*)(p.ws + WS_G8), (bf16*)(p.ws + WS_MRG)}, 0); if (l + 1 < DEPTH) ctx_gemm<0>(p, F, l); });
        SEAM(s0 + 4);
        if (IN(s0 + 5) && do_gemm) REPEAT(5, { if (first_) { run_gemm(F, job_out(p, l, ML), epi_resid(p, l, 0), 0); if (l + 1 < DEPTH) ctx_gemm<1>(p, F, l); } else run_gemm(F, job_out(p, l, ML), EStore{(bf16*)(p.ws + WS_MACC), DM, 0, 0}, 0); });
        SEAM(s0 + 5);
        if (IN(s0 + 6)) REPEAT(6, norm_mod_phase(p, F, l, 1));
        SEAM(s0 + 6);
#if MK_FUSE_ACT
        if (IN(s0 + 7) && do_gemm) REPEAT(7, run_gemm(F, job_up(p, l), EUpAct{(bf16*)(p.ws + WS_ACT), p.in[I_FCONVW] + (size_t)l * 3 * NUP, (float*)(p.ws + WS_HALO), (LAS float*)(F.lds + MISC_OFF + 1024)}, 0));
#else
        if (IN(s0 + 7) && do_gemm) REPEAT(7, run_gemm(F, job_up(p, l), epi_p(p), 0));
#endif
        SEAM(s0 + 7);
#if MK_FUSE_ACT
        if (IN(s0 + 8)) REPEAT(8, act_fix_phase(p, F, l));
#else
        if (IN(s0 + 8)) REPEAT(8, ffn_act_phase(p, F, l));
#endif
        SEAM(s0 + 8);
        if (IN(s0 + 9) && do_gemm) REPEAT(9, { if (first_) { run_gemm(F, job_down(p, l, ML), epi_resid(p, l, 1), 0); if (l + 1 < DEPTH) ctx_gemm<2>(p, F, l); } else run_gemm(F, job_down(p, l, ML), EStore{(bf16*)(p.ws + WS_MACC), DM, 0, 0}, 0); });
        SEAM(s0 + 9);
    }
    if (IN(N_STEPS - 1)) final_norm_phase(p, F);
#undef REPEAT
#undef IN
#undef SEAM
}

extern "C" void kernel_launch(void* const* d_in, const int* in_sizes, int n_in, void* d_out, int out_size, void* d_ws, size_t ws_size, hipStream_t stream) {
    static int grid = 0;
    if (grid == 0) {
        if (n_in != 20 || out_size != ML * DM || ws_size < WS_END) { fprintf(stderr, "kernel_launch: unexpected shapes (n_in %d out %d ws %zu)\n", n_in, out_size, ws_size); grid = -1; return; }
        int dev = 0, cus = 0, per_cu = 0;
        if (hipGetDevice(&dev) != hipSuccess || hipDeviceGetAttribute(&cus, hipDeviceAttributeMultiprocessorCount, dev) != hipSuccess) { grid = -1; return; }
        if (hipFuncSetAttribute((const void*)mega, hipFuncAttributeMaxDynamicSharedMemorySize, LDS_BYTES) != hipSuccess) { fprintf(stderr, "kernel_launch: hipFuncSetAttribute failed\n"); grid = -1; return; }
        if (hipOccupancyMaxActiveBlocksPerMultiprocessor(&per_cu, (const void*)mega, NTHR, LDS_BYTES) != hipSuccess || per_cu < 1) fprintf(stderr, "kernel_launch: occupancy query says %d\n", per_cu);
        (void)hipGetLastError();
        grid = cus;
    }
    if (grid < 0) return;
    (void)hipMemsetAsync((char*)d_ws + WS_CTL, 0, CTL_BYTES, stream);
    Args a{};
    for (int i = 0; i < 20; ++i) a.p.in[i] = (const float*)d_in[i];
    a.p.out = (float*)d_out; a.p.ws = (unsigned char*)d_ws;
    const Params& p = a.p;
#if MK_ONE_LAUNCH
    a.lo = 0; a.hi = N_STEPS; a.li = 0; a.skip = 0;
    hipLaunchKernelGGL(mega, dim3(grid), dim3(NTHR), LDS_BYTES, stream, a);
#else
    a.skip = (MK_SIMPLE_GEMM ? SK_GEMM : 0) | (MK_SIMPLE_ATTN ? SK_ATTN : 0);
    int li = 0;
    for (int s = 0; s < N_STEPS; ++s) {
        a.lo = s; a.hi = s + 1; a.li = li++;
        const int l = (s - 1) / STEPS_PER_LAYER, k = (s - 1) % STEPS_PER_LAYER;
        const bool layer_step = s >= 1 && s < N_STEPS - 1;
        const bool pure_gemm = layer_step && (k == 1 || k == 4 || k == 5 || k == 7 || k == 9);
        if (!(pure_gemm && MK_SIMPLE_GEMM)) hipLaunchKernelGGL(mega, dim3(grid), dim3(NTHR), LDS_BYTES, stream, a);
        if (!layer_step) continue;
        if (MK_SIMPLE_GEMM) {
            if (k == 1) launch_sgemm(job_win(p, l), epi_p(p), stream);
            if (k == 2) { launch_sgemm(job_f1(p, false), epi_f1(p, false), stream); launch_sgemm(job_f1(p, true), epi_f1(p, true), stream); }
            if (k == 3) { launch_sgemm(job_f2(p, false), epi_f2(p, false), stream); launch_sgemm(job_f2(p, true), epi_f2(p, true), stream); }
            if (k == 4) for (int pass = 0; pass < 3; ++pass) launch_sgemm(job_merge(p, l, pass), epi_merge(p, pass), stream);
            if (k == 5) launch_sgemm(job_out(p, l), epi_resid(p, l, 0), stream);
            if (k == 7) launch_sgemm(job_up(p, l), epi_p(p), stream);
            if (k == 9) launch_sgemm(job_down(p, l), epi_resid(p, l, 1), stream);
        }
        if (MK_SIMPLE_ATTN && k == 3) hipLaunchKernelGGL(k_sattn, dim3(MROWS * NH), dim3(64), 0, stream, p, l);
    }
#endif
}
```

```cpp
#include <hip/hip_runtime.h>
#include <cstdio>
#include <cstdint>

#ifndef MK_ONE_LAUNCH
#define MK_ONE_LAUNCH 1
#endif
#ifndef MK_SIMPLE_GEMM
#define MK_SIMPLE_GEMM 0
#endif
#ifndef MK_FUSE_ACT
#define MK_FUSE_ACT (!MK_SIMPLE_GEMM)
#endif
#ifndef MK_FFT
#define MK_FFT (!MK_SIMPLE_GEMM)
#endif
#ifndef PROBE_STEP
#define PROBE_STEP (-1)
#endif
#ifndef PROBE_REP
#define PROBE_REP 1
#endif
#ifndef MK_SIMPLE_ATTN
#define MK_SIMPLE_ATTN 0
#endif

#define LAS __attribute__((address_space(3)))
#define GAS __attribute__((address_space(1)))
typedef unsigned short bf16;
typedef short bf16x8 __attribute__((ext_vector_type(8)));
typedef float f32x4 __attribute__((ext_vector_type(4)));
typedef float f32x16 __attribute__((ext_vector_type(16)));
typedef unsigned u32x4 __attribute__((ext_vector_type(4)));
typedef unsigned u32x2 __attribute__((ext_vector_type(2)));

constexpr int DM = 2048, NBATCH = 2, SEQ = 4096, CTXL = 256, DEPTH = 4;
constexpr int ML = NBATCH * SEQ, MC = NBATCH * CTXL, MROWS = ML + MC;
constexpr int NIN = 11264, DFF = 5632, NUP = 2 * DFF, NMOD = 6 * DM;
constexpr int CB_OFF = 512, CC_OFF = 1024, CX_OFF = 1536, Q_OFF = 2048, K_OFF = 3072, V_OFF = 4096, GF_OFF = 5120, GC_OFF = 7168, GA_OFF = 9216;
constexpr int NH = 8, HD = 64, VD = 128, QKW = 1024, LK = CTXL + SEQ;
constexpr float QSCALE = 0.125f * 1.4426950408889634f;
constexpr float EPS_RMS = 1e-6f, EPS_SUBLN = 1e-5f;

constexpr size_t MiB = 1u << 20;
constexpr size_t WS_CTL = 0, CTL_BYTES = 4 * MiB;
constexpr size_t WS_MOD = 4 * MiB;
constexpr size_t WS_LAM = 5 * MiB;
constexpr size_t WS_ROPE = WS_LAM + 256;
constexpr size_t WS_CS128 = WS_LAM + 65536;
constexpr size_t WS_DC = WS_CS128 + 131072;
constexpr size_t WS_FWA = WS_DC + 262144;
constexpr size_t WS_FWC = WS_FWA + 32768;
constexpr size_t WS_FTW = WS_FWC + 16384;
constexpr size_t WS_DL = 6 * MiB;
constexpr size_t WS_G8 = WS_DL;
constexpr int NG8 = 3 * DM;
constexpr size_t WS_H = 70 * MiB;
constexpr size_t WS_XN = 138 * MiB;
constexpr size_t WS_P = 172 * MiB;
constexpr size_t WS_QR = 359 * MiB;
constexpr size_t WS_KC = 376 * MiB;
constexpr size_t WS_VT = 393 * MiB;
constexpr size_t WS_T = 410 * MiB;
constexpr size_t WS_TC = 426 * MiB;
constexpr size_t WS_BR = 427 * MiB;
constexpr size_t WS_MACC = 461 * MiB;
constexpr size_t WS_HALO = 501 * MiB;
constexpr size_t WS_MRG = 529 * MiB;
constexpr size_t WS_ACT = 563 * MiB;
constexpr size_t WS_W = 657 * MiB;
constexpr size_t W_IN = 0, W_BM = 44 * MiB, W_OUT = 52 * MiB, W_UP = 60 * MiB, W_DOWN = 104 * MiB, W_LAYER = 126 * MiB;
constexpr size_t WS_END = WS_W + 4 * W_LAYER;

struct Params { const float* in[20]; float* out; unsigned char* ws; };
enum { I_X = 0, I_C, I_CTX, I_CCTX, I_WMOD, I_BMOD, I_G1, I_G2, I_WIN, I_CONVW, I_LAMB, I_SUBG, I_WBF, I_WBC, I_WBA, I_WOUT, I_WUP, I_FCONVW, I_WDOWN, I_GFIN };

__host__ __device__ __forceinline__ unsigned f2bf(float f) { unsigned u = __builtin_bit_cast(unsigned, f); return (u + 0x7fffu + ((u >> 16) & 1u)) >> 16; }
typedef float f32x2_t __attribute__((ext_vector_type(2))); typedef __bf16 bf16x2_t __attribute__((ext_vector_type(2)));
__device__ __forceinline__ unsigned pk2(float lo, float hi) { f32x2_t v = {lo, hi}; bf16x2_t b = __builtin_convertvector(v, bf16x2_t); return __builtin_bit_cast(unsigned, b); }
__device__ __forceinline__ float bflo(unsigned w) { return __uint_as_float(w << 16); }
__device__ __forceinline__ float bfhi(unsigned w) { return __uint_as_float(w & 0xffff0000u); }
__device__ __forceinline__ void unpack8(const u32x4 w, float* f) { f[0] = bflo(w.x); f[1] = bfhi(w.x); f[2] = bflo(w.y); f[3] = bfhi(w.y); f[4] = bflo(w.z); f[5] = bfhi(w.z); f[6] = bflo(w.w); f[7] = bfhi(w.w); }
__device__ __forceinline__ u32x4 pack8(const float* f) { u32x4 w; w.x = pk2(f[0], f[1]); w.y = pk2(f[2], f[3]); w.z = pk2(f[4], f[5]); w.w = pk2(f[6], f[7]); return w; }
#define DPP_ADD(v, ctrl) v += __builtin_bit_cast(float, __builtin_amdgcn_mov_dpp(__builtin_bit_cast(int, v), ctrl, 0xf, 0xf, true))
__device__ __forceinline__ float wave_sum(float v) {
    DPP_ADD(v, 0xB1); DPP_ADD(v, 0x4E); DPP_ADD(v, 0x141); DPP_ADD(v, 0x140);
    { auto rr = __builtin_amdgcn_permlane16_swap(__float_as_uint(v), __float_as_uint(v), false, false); v = __uint_as_float(rr[0]) + __uint_as_float(rr[1]); }
    { auto rr = __builtin_amdgcn_permlane32_swap(__float_as_uint(v), __float_as_uint(v), false, false); v = __uint_as_float(rr[0]) + __uint_as_float(rr[1]); }
    return v;
}
__device__ __forceinline__ float wave_max(float v) {
#pragma unroll
    for (int o = 1; o < 64; o <<= 1) v = fmaxf(v, __shfl_xor(v, o));
    return v;
}
__device__ __forceinline__ float sigmoidf_(float x) { return 1.0f / (1.0f + __expf(-x)); }
__device__ __forceinline__ int lane_id_opaque() { unsigned m = ~0u; asm volatile("" : "+s"(m)); return (int)__builtin_amdgcn_mbcnt_hi(m, __builtin_amdgcn_mbcnt_lo(m, 0u)); }
struct RowInfo { int b, pos, L, mrow, kv; bool ctx; };
__host__ __device__ __forceinline__ RowInfo row_info(int row) {
    RowInfo r;
    if (row < ML) { r.b = row >> 12; r.pos = row & (SEQ - 1); r.L = SEQ; r.mrow = r.b; r.kv = CTXL + r.pos; r.ctx = false; }
    else { const int rr = row - ML; r.b = rr >> 8; r.pos = rr & (CTXL - 1); r.L = CTXL; r.mrow = 2; r.kv = r.pos; r.ctx = true; }
    return r;
}

struct GemmJob { const bf16* A; const bf16* Bt; int lda, ldb, M, N, K, Z, zdiv, pad; long sA1, sA2, sB1, sB2; };
__host__ __device__ __forceinline__ long job_aoff(const GemmJob& j, int z) { return (long)(z / j.zdiv) * j.sA1 + (long)(z % j.zdiv) * j.sA2; }
__host__ __device__ __forceinline__ long job_boff(const GemmJob& j, int z) { return (long)(z / j.zdiv) * j.sB1 + (long)(z % j.zdiv) * j.sB2; }

struct EStore {
    static constexpr bool HAS_MID = false, WHOLE = false, PERM = true;
    bf16* C; int ldc, pad; long sC;
    __device__ __forceinline__ void apply8(int z, int row, int col, f32x4 v0, f32x4 v1) const {
        u32x4 w; w.x = pk2(v0[0], v0[1]); w.y = pk2(v0[2], v0[3]); w.z = pk2(v1[0], v1[1]); w.w = pk2(v1[2], v1[3]);
        *(u32x4*)(C + (size_t)z * sC + (size_t)row * ldc + col) = w;
    }
};
struct ETr {
    static constexpr bool HAS_MID = false, WHOLE = false, PERM = true;
    bf16* T; int L, pad;
    __device__ __forceinline__ void apply8(int z, int row, int col, f32x4 v0, f32x4 v1) const {
        u32x4 w; w.x = pk2(v0[0], v0[1]); w.y = pk2(v0[2], v0[3]); w.z = pk2(v1[0], v1[1]); w.w = pk2(v1[2], v1[3]);
        const int b = z >> 2, g = z & 3;
        *(u32x4*)(T + ((size_t)(b * 512 + g * 128 + (row & 127)) * (size_t)(2 * L) + (size_t)(row >> 7) * L + col)) = w;
    }
};
struct EMerge {
    static constexpr bool HAS_MID = false, WHOLE = false, PERM = true;
    const bf16* P; float* macc; bf16* mrg; int goff, pass;
    __device__ __forceinline__ void apply8(int, int row, int col, f32x4 v0, f32x4 v1) const {
        const u32x4 gw = *(const u32x4*)(P + (size_t)row * NIN + goff + col);
        float g[8]; unpack8(gw, g);
        float v[8] = {v0[0], v0[1], v0[2], v0[3], v1[0], v1[1], v1[2], v1[3]};
        float* mp = macc + (size_t)row * DM + col;
        if (pass > 0) { const f32x4 a = *(const f32x4*)mp, b = *(const f32x4*)(mp + 4);
#pragma unroll
            for (int i = 0; i < 4; ++i) { v[i] = sigmoidf_(g[i]) * v[i] + a[i]; v[4 + i] = sigmoidf_(g[4 + i]) * v[4 + i] + b[i]; } }
        else {
#pragma unroll
            for (int i = 0; i < 8; ++i) v[i] = sigmoidf_(g[i]) * v[i]; }
        if (pass < 2) { *(f32x4*)mp = (f32x4){v[0], v[1], v[2], v[3]}; *(f32x4*)(mp + 4) = (f32x4){v[4], v[5], v[6], v[7]}; }
        else *(u32x4*)(mrg + (size_t)row * DM + col) = pack8(v);
    }
};
struct EMerge1 {
    static constexpr bool HAS_MID = true, WHOLE = false, PERM = true; static constexpr int MID0 = 512 / 64, MID1 = 1024 / 64;
    const unsigned char* g8; bf16* mrg;
    __device__ __forceinline__ void mid8(int seg, int row, int col, f32x4& v0, f32x4& v1) const {
        const unsigned char* gp = g8 + (size_t)row * NG8 + col + (seg == 0 ? 0 : DM);
        const u32x2 qa = *(const u32x2*)gp, qb = *(const u32x2*)(gp + DM);
#pragma unroll
        for (int i = 0; i < 8; ++i) { const unsigned wa = i < 4 ? qa.x : qa.y, wb = i < 4 ? qb.x : qb.y;
            const float r = (float)((wa >> (8 * (i & 3))) & 255u) * __builtin_amdgcn_rcpf((float)((wb >> (8 * (i & 3))) & 255u));
            if (i < 4) v0[i] *= r; else v1[i - 4] *= r; }
    }
    __device__ __forceinline__ void apply8(int, int row, int col, f32x4 v0, f32x4 v1) const {
        const u32x2 q = *(const u32x2*)(g8 + (size_t)row * NG8 + 2 * DM + col);
        float v[8];
#pragma unroll
        for (int i = 0; i < 8; ++i) { const unsigned w = i < 4 ? q.x : q.y; v[i] = (i < 4 ? v0[i] : v1[i - 4]) * ((float)((w >> (8 * (i & 3))) & 255u) * (1.0f / 255.0f)); }
        *(u32x4*)(mrg + (size_t)row * DM + col) = pack8(v);
    }
};
struct EWin {
    static constexpr bool HAS_MID = false, WHOLE = false, PERM = true;
    bf16* P; unsigned char* g8;
    __device__ __forceinline__ void apply8(int, int row, int col, f32x4 v0, f32x4 v1) const {
        if (col < GF_OFF) { u32x4 w; w.x = pk2(v0[0], v0[1]); w.y = pk2(v0[2], v0[3]); w.z = pk2(v1[0], v1[1]); w.w = pk2(v1[2], v1[3]); *(u32x4*)(P + (size_t)row * NIN + col) = w; }
        else {
            unsigned q[8];
#pragma unroll
            for (int i = 0; i < 8; ++i) { const float g = i < 4 ? v0[i] : v1[i - 4]; q[i] = (unsigned)fminf(fmaxf(255.0f * __builtin_amdgcn_rcpf(1.0f + __expf(-g)) + 0.5f, 1.0f), 255.0f); }
            u32x2 w; w.x = q[0] | (q[1] << 8) | (q[2] << 16) | (q[3] << 24); w.y = q[4] | (q[5] << 8) | (q[6] << 16) | (q[7] << 24);
            *(u32x2*)(g8 + (size_t)row * NG8 + (col - GF_OFF)) = w; }
    }
};
struct EResid {
    static constexpr bool HAS_MID = false, WHOLE = false, PERM = true;
    bf16* h; const float* modl; const float* xin; const float* cin; int goff, pad;
    __device__ __forceinline__ void apply8(int, int row, int col, f32x4 v0, f32x4 v1) const {
        const RowInfo ri = row_info(row);
        const float* gp = modl + (size_t)ri.mrow * NMOD + goff + col;
        const f32x4 g0 = *(const f32x4*)gp, g1 = *(const f32x4*)(gp + 4);
        bf16* hp = h + (size_t)row * DM + col;
        float a[8];
        if (xin) { const float* sp = row < ML ? xin + (size_t)row * DM + col : cin + (size_t)(row - ML) * DM + col; const f32x4 s0 = *(const f32x4*)sp, s1 = *(const f32x4*)(sp + 4);
#pragma unroll
            for (int i = 0; i < 4; ++i) { a[i] = s0[i]; a[4 + i] = s1[i]; } }
        else unpack8(*(const u32x4*)hp, a);
#pragma unroll
        for (int i = 0; i < 4; ++i) { a[i] += g0[i] * v0[i]; a[4 + i] += g1[i] * v1[i]; }
        *(u32x4*)hp = pack8(a);
    }
};

__device__ __forceinline__ float dpp_shr1(float oldv, float src) { return __builtin_bit_cast(float, __builtin_amdgcn_update_dpp(__builtin_bit_cast(int, oldv), __builtin_bit_cast(int, src), 0x111, 0xf, 0xf, false)); }
__device__ __forceinline__ float dpp_shl1(float oldv, float src) { return __builtin_bit_cast(float, __builtin_amdgcn_update_dpp(__builtin_bit_cast(int, oldv), __builtin_bit_cast(int, src), 0x101, 0xf, 0xf, false)); }
__device__ __forceinline__ float dpp_ror1(float src) { return __builtin_bit_cast(float, __builtin_amdgcn_mov_dpp(__builtin_bit_cast(int, src), 0x121, 0xf, 0xf, true)); }
__device__ __forceinline__ float dpp_ror15(float src) { return __builtin_bit_cast(float, __builtin_amdgcn_mov_dpp(__builtin_bit_cast(int, src), 0x12F, 0xf, 0xf, true)); }
struct EUpAct {
    static constexpr bool HAS_MID = false, WHOLE = true, PERM = true;
    bf16* act; const float* cw; float* halo; LAS float* edge;
    __device__ __forceinline__ void whole(const f32x4 (&acc)[2][2][4][2], int pm, int pn, int wr, int wc, int, int) const {
        const int ln_ = lane_id_opaque(), fr = ln_ & 15, fq = ln_ >> 4;
        int cb = 32 * wc + 8 * fq; asm volatile("" : "+v"(cb));
#pragma unroll
        for (int ai = 0; ai < 2; ++ai) { const int g = 2 * ai + wr;
#pragma unroll
            for (int bj = 0; bj < 2; ++bj)
#pragma unroll
                for (int n = 0; n < 2; ++n) {
                    if (fr == 0) *(LAS f32x4*)(edge + (g * 2 + 0) * 256 + 128 * bj + cb + 4 * n) = acc[ai][bj][0][n];
                    if (fr == 15) *(LAS f32x4*)(edge + (g * 2 + 1) * 256 + 128 * bj + cb + 4 * n) = acc[ai][bj][3][n]; } }
        LAS float* cwl = edge + 2048;
        { const int tid_ = (wr * 4 + wc) * 64 + ln_;
#pragma unroll
          for (int q = 0; q < 2; ++q) { const int idx = tid_ + 512 * q; if (idx < 768) { const int t = idx >> 8, c = idx & 255; cwl[idx] = cw[(size_t)t * NUP + (c >> 7) * DFF + 128 * pn + (c & 127)]; } } }
        asm volatile("s_waitcnt lgkmcnt(0)\n\ts_barrier" ::: "memory");
        const bool seq_first = pm >= 32 || (pm & 15) == 0, seq_last = pm >= 32 || (pm & 15) == 15;
        const int j0 = 128 * pn + cb;
        float* hb = halo + (size_t)pm * 4 * 2 * DFF + j0;
#pragma unroll
        for (int ai = 0; ai < 2; ++ai) { const int g = 2 * ai + wr; unsigned opk[4][2];
#pragma unroll
            for (int n = 0; n < 2; ++n) {
                asm volatile("" ::: "memory");
                f32x4 w[2][3];
#pragma unroll
                for (int bj = 0; bj < 2; ++bj)
#pragma unroll
                    for (int t = 0; t < 3; ++t) w[bj][t] = *(const LAS f32x4*)(cwl + t * 256 + bj * 128 + cb + 4 * n);
                float o[4][4];
#pragma unroll
                for (int e = 0; e < 4; ++e) {
                    float u[2][4];
#pragma unroll
                    for (int bj = 0; bj < 2; ++bj) {
                        float x0 = acc[ai][bj][0][n][e], x1 = acc[ai][bj][1][n][e], x2 = acc[ai][bj][2][n][e], x3 = acc[ai][bj][3][n][e];
                        asm volatile("" : "+v"(x0), "+v"(x1), "+v"(x2), "+v"(x3));
                        const float epv = g > 0 ? edge[((g - 1) * 2 + 1) * 256 + 128 * bj + cb + 4 * n + e] : 0.f, env = g < 3 ? edge[((g + 1) * 2 + 0) * 256 + 128 * bj + cb + 4 * n + e] : 0.f;
                        const float p0 = dpp_shr1(epv, x0), p1 = dpp_shr1(dpp_ror1(x0), x1), p2 = dpp_shr1(dpp_ror1(x1), x2), p3 = dpp_shr1(dpp_ror1(x2), x3);
                        const float q0 = dpp_shl1(dpp_ror15(x1), x0), q1 = dpp_shl1(dpp_ror15(x2), x1), q2 = dpp_shl1(dpp_ror15(x3), x2), q3 = dpp_shl1(env, x3);
                        const float w0 = w[bj][0][e], w1 = w[bj][1][e], w2 = w[bj][2][e];
                        u[bj][0] = w0 * p0 + w1 * x0 + w2 * q0; u[bj][1] = w0 * p1 + w1 * x1 + w2 * q1; u[bj][2] = w0 * p2 + w1 * x2 + w2 * q2; u[bj][3] = w0 * p3 + w1 * x3 + w2 * q3;
                        if (g == 0 && fr == 0 && !seq_first) { hb[(0 * 2 + bj) * DFF + 4 * n + e] = x0; hb[(2 * 2 + bj) * DFF + 4 * n + e] = u[bj][0]; }
                        if (g == 3 && fr == 15 && !seq_last) { hb[(1 * 2 + bj) * DFF + 4 * n + e] = x3; hb[(3 * 2 + bj) * DFF + 4 * n + e] = u[bj][3]; }
                        asm volatile("" : "+v"(u[bj][0]), "+v"(u[bj][1]), "+v"(u[bj][2]), "+v"(u[bj][3]));
                    }
#pragma unroll
                    for (int m = 0; m < 4; ++m) { const float a = u[0][m]; o[m][e] = a * __builtin_amdgcn_rcpf(1.0f + __expf(-a)) * u[1][m]; }
                    asm volatile("" : "+v"(o[0][e]), "+v"(o[1][e]), "+v"(o[2][e]), "+v"(o[3][e]));
                }
                if (n == 0) {
#pragma unroll
                    for (int m = 0; m < 4; ++m) { opk[m][0] = pk2(o[m][0], o[m][1]); opk[m][1] = pk2(o[m][2], o[m][3]); }
                } else {
#pragma unroll
                    for (int m = 0; m < 4; ++m) { u32x4 pw; pw.x = opk[m][0]; pw.y = opk[m][1]; pw.z = pk2(o[m][0], o[m][1]); pw.w = pk2(o[m][2], o[m][3]); *(u32x4*)(act + (size_t)(pm * 256 + ai * 128 + wr * 64 + m * 16 + fr) * DFF + j0) = pw; }
                }
            }
        }
    }
};
__host__ __device__ __forceinline__ const bf16* wl(const Params& p, int layer, size_t off) { return (const bf16*)(p.ws + WS_W + (size_t)layer * W_LAYER + off); }
__host__ __device__ __forceinline__ GemmJob job_win(const Params& p, int l) { return GemmJob{(const bf16*)(p.ws + WS_XN), wl(p, l, W_IN), DM, DM, MROWS, NIN, DM, 1, 1, 0, 0, 0, 0, 0}; }
__host__ __device__ __forceinline__ GemmJob job_up(const Params& p, int l) { return GemmJob{(const bf16*)(p.ws + WS_XN), wl(p, l, W_UP), DM, DM, MROWS, NUP, DM, 1, 1, 0, 0, 0, 0, 0}; }
__host__ __device__ __forceinline__ GemmJob job_out(const Params& p, int l, int M = MROWS) { return GemmJob{(const bf16*)(p.ws + WS_MRG), wl(p, l, W_OUT), DM, DM, M, DM, DM, 1, 1, 0, 0, 0, 0, 0}; }
__host__ __device__ __forceinline__ GemmJob job_down(const Params& p, int l, int M = MROWS) { return GemmJob{(const bf16*)(p.ws + WS_ACT), wl(p, l, W_DOWN), DFF, DFF, M, DM, DFF, 1, 1, 0, 0, 0, 0, 0}; }
__host__ __device__ __forceinline__ GemmJob job_merge1(const Params& p, int l) { return GemmJob{(const bf16*)(p.ws + WS_BR), wl(p, l, W_BM), DM, DM, ML, DM, DM, 1, 1, 0, 0, 0, 0, 0}; }
__host__ __device__ __forceinline__ GemmJob job_merge(const Params& p, int l, int pass) {
    const int koff = pass == 0 ? 0 : (pass == 1 ? 512 : 1024), K = pass == 2 ? 1024 : 512;
    return GemmJob{(const bf16*)(p.ws + WS_BR) + koff, wl(p, l, W_BM) + koff, DM, DM, MROWS, DM, K, 1, 1, 0, 0, 0, 0, 0};
}
__host__ __device__ __forceinline__ GemmJob job_f1(const Params& p, bool ctx) {
    const bf16* P = (const bf16*)(p.ws + WS_P);
    if (!ctx) return GemmJob{(const bf16*)(p.ws + WS_CS128), P, 256, NIN, 256, SEQ, 256, 8, 4, 0, 0, 0, (long)SEQ * NIN, 128};
    return GemmJob{(const bf16*)(p.ws + WS_CS128), P + (size_t)ML * NIN, 256, NIN, 256, CTXL, 256, 8, 4, 0, 0, 0, (long)CTXL * NIN, 128};
}
__host__ __device__ __forceinline__ GemmJob job_f2(const Params& p, bool ctx) {
    if (!ctx) return GemmJob{(const bf16*)(p.ws + WS_DL), (const bf16*)(p.ws + WS_T), 2 * SEQ, 2 * SEQ, SEQ, 512, 2 * SEQ, 2, 1, 0, 0, 0, (long)512 * 2 * SEQ, 0};
    return GemmJob{(const bf16*)(p.ws + WS_DC), (const bf16*)(p.ws + WS_TC), 2 * CTXL, 2 * CTXL, CTXL, 512, 2 * CTXL, 2, 1, 0, 0, 0, (long)512 * 2 * CTXL, 0};
}
__host__ __device__ __forceinline__ EStore epi_p(const Params& p) { return EStore{(bf16*)(p.ws + WS_P), NIN, 0, 0}; }
__host__ __device__ __forceinline__ EStore epi_f2(const Params& p, bool ctx) {
    if (!ctx) return EStore{(bf16*)(p.ws + WS_BR), DM, 0, (long)SEQ * DM};
    return EStore{(bf16*)(p.ws + WS_BR) + (size_t)ML * DM, DM, 0, (long)CTXL * DM};
}
__host__ __device__ __forceinline__ ETr epi_f1(const Params& p, bool ctx) { return ctx ? ETr{(bf16*)(p.ws + WS_TC), CTXL, 0} : ETr{(bf16*)(p.ws + WS_T), SEQ, 0}; }
__host__ __device__ __forceinline__ EMerge epi_merge(const Params& p, int pass) {
    return EMerge{(const bf16*)(p.ws + WS_P), (float*)(p.ws + WS_MACC), (bf16*)(p.ws + WS_MRG), pass == 0 ? GF_OFF : (pass == 1 ? GC_OFF : GA_OFF), pass};
}
__host__ __device__ __forceinline__ EResid epi_resid(const Params& p, int l, int which) {
    const bool first = (l == 0 && which == 0);
    return EResid{(bf16*)(p.ws + WS_H), (const float*)(p.ws + WS_MOD) + (size_t)l * 3 * NMOD, first ? p.in[I_X] : nullptr, first ? p.in[I_CTX] : nullptr, which == 0 ? 2 * DM : 5 * DM, 0};
}

template <class E> __global__ void __launch_bounds__(256) k_sgemm(GemmJob j, E e) {
    __shared__ float As[32][65], Bs[32][65];
    const int z = blockIdx.z, m0 = blockIdx.y * 64, n0 = blockIdx.x * 64, tid = threadIdx.x;
    const bf16* A = j.A + job_aoff(j, z); const bf16* Bt = j.Bt + job_boff(j, z);
    const int lr = tid >> 2, lc = (tid & 3) * 8, ty = tid >> 3, tx = tid & 7;
    float acc[2][8];
#pragma unroll
    for (int a = 0; a < 2; ++a)
#pragma unroll
        for (int b = 0; b < 8; ++b) acc[a][b] = 0.f;
    for (int k0 = 0; k0 < j.K; k0 += 32) {
        const u32x4 aw = *(const u32x4*)(A + (size_t)(m0 + lr) * j.lda + k0 + lc);
        const u32x4 bw = *(const u32x4*)(Bt + (size_t)(n0 + lr) * j.ldb + k0 + lc);
        float af[8], bf[8]; unpack8(aw, af); unpack8(bw, bf);
        __syncthreads();
#pragma unroll
        for (int i = 0; i < 8; ++i) { As[lc + i][lr] = af[i]; Bs[lc + i][lr] = bf[i]; }
        __syncthreads();
#pragma unroll 8
        for (int kk = 0; kk < 32; ++kk) {
            const float a0 = As[kk][2 * ty], a1 = As[kk][2 * ty + 1];
#pragma unroll
            for (int b = 0; b < 8; ++b) { const float bv = Bs[kk][8 * tx + b]; acc[0][b] += a0 * bv; acc[1][b] += a1 * bv; }
        }
    }
#pragma unroll
    for (int a = 0; a < 2; ++a)
        e.apply8(z, m0 + 2 * ty + a, n0 + 8 * tx, (f32x4){acc[a][0], acc[a][1], acc[a][2], acc[a][3]}, (f32x4){acc[a][4], acc[a][5], acc[a][6], acc[a][7]});
}
template <class E> static void launch_sgemm(const GemmJob& j, const E& e, hipStream_t st) {
    hipLaunchKernelGGL((k_sgemm<E>), dim3(j.N / 64, j.M / 64, j.Z), dim3(256), 0, st, j, e);
}

__global__ void __launch_bounds__(64) k_sattn(Params p, int layer) {
    __shared__ float S0[LK], S1[LK], q[128];
    const int row = blockIdx.x >> 3, h = blockIdx.x & 7, lane = threadIdx.x;
    const RowInfo ri = row_info(row);
    const int nk = ri.ctx ? CTXL : LK;
    const bf16* Qr = (const bf16*)(p.ws + WS_QR); const bf16* Kc = (const bf16*)(p.ws + WS_KC); const bf16* Vt = (const bf16*)(p.ws + WS_VT);
    bf16* br = (bf16*)(p.ws + WS_BR);
    const float lam = ((const float*)(p.ws + WS_LAM))[layer];
    const float lam_init = 0.8f - 0.6f * expf(-0.3f * (float)layer);
    q[lane] = __uint_as_float(((unsigned)Qr[(size_t)row * QKW + h * 128 + lane]) << 16);
    q[64 + lane] = __uint_as_float(((unsigned)Qr[(size_t)row * QKW + h * 128 + 64 + lane]) << 16);
    __syncthreads();
    float m0 = -1e30f, m1 = -1e30f;
    for (int j = lane; j < nk; j += 64) {
        const bf16* kp = Kc + ((size_t)(ri.b * LK + j) * QKW + h * 128);
        float s0 = 0.f, s1 = 0.f;
#pragma unroll
        for (int c = 0; c < 8; ++c) { float f[8]; unpack8(*(const u32x4*)(kp + c * 8), f);
#pragma unroll
            for (int i = 0; i < 8; ++i) s0 += q[c * 8 + i] * f[i]; }
#pragma unroll
        for (int c = 0; c < 8; ++c) { float f[8]; unpack8(*(const u32x4*)(kp + 64 + c * 8), f);
#pragma unroll
            for (int i = 0; i < 8; ++i) s1 += q[64 + c * 8 + i] * f[i]; }
        S0[j] = s0; S1[j] = s1; m0 = fmaxf(m0, s0); m1 = fmaxf(m1, s1);
    }
    m0 = wave_max(m0); m1 = wave_max(m1);
    float l0 = 0.f, l1 = 0.f;
    for (int j = lane; j < nk; j += 64) { const float e0 = exp2f(S0[j] - m0), e1 = exp2f(S1[j] - m1); S0[j] = e0; S1[j] = e1; l0 += e0; l1 += e1; }
    l0 = wave_sum(l0); l1 = wave_sum(l1);
    const float i0 = 1.0f / l0, i1 = lam / l1;
    for (int j = lane; j < nk; j += 64) S0[j] = S0[j] * i0 - S1[j] * i1;
    __syncthreads();
    float o[2];
#pragma unroll
    for (int t = 0; t < 2; ++t) {
        const int dv = lane + 64 * t;
        const bf16* vp = Vt + ((size_t)(ri.b * QKW + h * 128 + dv) * LK);
        float s = 0.f;
        for (int j = 0; j < nk; j += 8) { float f[8]; unpack8(*(const u32x4*)(vp + j), f);
#pragma unroll
            for (int i = 0; i < 8; ++i) s += S0[j + i] * f[i]; }
        o[t] = s;
    }
    const float ss = wave_sum(o[0] * o[0] + o[1] * o[1]);
    const float rs = rsqrtf(ss * (1.0f / 128.0f) + EPS_SUBLN) * (1.0f - lam_init);
    const float* sg = p.in[I_SUBG] + layer * VD;
#pragma unroll
    for (int t = 0; t < 2; ++t) { const int dv = lane + 64 * t; br[(size_t)row * DM + 1024 + h * 128 + dv] = (bf16)f2bf(o[t] * rs * sg[dv]); }
}

namespace pg8 {
constexpr int BM = 256, BK = 64, HALF = 128, HTB = HALF * BK * 2, STAGE_BYTES = 8 * HTB, NXCD = 8, WGM = 8;
__host__ __device__ __forceinline__ int lds_byte(int r, int c) { const int st = (r >> 4) * 2 + (c >> 5), rr = r & 15, cc = c & 31, ob = rr * 64 + cc * 2; return st * 1024 + (ob ^ (((ob >> 9) & 1) << 5)); }
__host__ __device__ __forceinline__ void stage_rc(int b, int& R, int& C) { const int st = b / 1024, sb = b % 1024, swz = sb ^ (((sb >> 9) & 1) << 5); R = (st >> 1) * 16 + swz / 64; C = (st & 1) * 32 + (swz % 64) / 2; }
__host__ __device__ __forceinline__ int perm32(int rho) { const int n = rho >> 4, i = rho & 15; return 8 * (i >> 2) + 4 * n + (i & 3); }
struct Unit { int pm, pn, z; size_t aoff, boff; };
struct Sched {
    int nM, nN, tiles, total, G, c, lda, ldb, zdiv; long sA1, sA2, sB1, sB2;
    __device__ __forceinline__ void init(const GemmJob& j, int G_, int c_) { nM = j.M / BM; nN = j.N / BM; tiles = nM * nN; total = tiles * j.Z; G = G_; c = c_; lda = j.lda; ldb = j.ldb; zdiv = j.zdiv; sA1 = j.sA1; sA2 = j.sA2; sB1 = j.sB1; sB2 = j.sB2; }
    __device__ __forceinline__ bool next(int i, Unit& u) const {
        const long L = (long)i * G + c; if (L >= total) return false;
        const int z = (int)(L / tiles); int wgid = (int)(L % tiles);
        { const int q = tiles / NXCD, r = tiles % NXCD, xcd = wgid % NXCD, off = wgid / NXCD; wgid = (xcd < r ? xcd * (q + 1) : r * (q + 1) + (xcd - r) * q) + off; }
        const int nig = WGM * nN, gid = wgid / nig, fm = gid * WGM, gsz = (nM - fm) < WGM ? (nM - fm) : WGM;
        u.pm = fm + ((wgid % nig) % gsz); u.pn = (wgid % nig) / gsz; u.z = z;
        const long z1 = z / zdiv, z2 = z % zdiv;
        u.aoff = (size_t)(z1 * sA1 + z2 * sA2 + (long)u.pm * BM * lda) * 2; u.boff = (size_t)(z1 * sB1 + z2 * sB2 + (long)u.pn * BM * ldb) * 2;
        return true;
    }
};
template <class E> __device__ __forceinline__ void run_epi(const E& e, const f32x4 (&acc)[2][2][4][2], const Unit& u, int wr, int wc, int, int) {
    const int ln_ = lane_id_opaque(), fr = ln_ & 15, fq = ln_ >> 4;
    int row0 = u.pm * BM + wr * 64 + fr, col0 = u.pn * BM + wc * 64 + 8 * fq;
    asm volatile("" : "+v"(row0), "+v"(col0));
    const int colq = col0 - 4 * fq; (void)colq;
#pragma unroll
    for (int ai = 0; ai < 2; ++ai)
#pragma unroll
        for (int m = 0; m < 4; ++m)
#pragma unroll
            for (int bj = 0; bj < 2; ++bj) {
                if constexpr (E::PERM) e.apply8(u.z, row0 + ai * HALF + m * 16, col0 + bj * 32, acc[ai][bj][m][0], acc[ai][bj][m][1]);
                else { e.apply4(u.z, row0 + ai * HALF + m * 16, colq + bj * 32, acc[ai][bj][m][0]); e.apply4(u.z, row0 + ai * HALF + m * 16, colq + bj * 32 + 16, acc[ai][bj][m][1]); } }
}
template <class E> __device__ __forceinline__ void run_mid(const E& e, f32x4 (&acc)[2][2][4][2], const Unit& u, int seg, int wr, int wc, int, int) {
    const int ln_ = lane_id_opaque(), fr = ln_ & 15, fq = ln_ >> 4;
    int row0 = u.pm * BM + wr * 64 + fr, col0 = u.pn * BM + wc * 64 + 8 * fq;
    asm volatile("" : "+v"(row0), "+v"(col0));
#pragma unroll
    for (int ai = 0; ai < 2; ++ai)
#pragma unroll
        for (int m = 0; m < 4; ++m)
#pragma unroll
            for (int bj = 0; bj < 2; ++bj) e.mid8(seg, row0 + ai * HALF + m * 16, col0 + bj * 32, acc[ai][bj][m][0], acc[ai][bj][m][1]);
}
template <class E>
__device__ __forceinline__ void gemm_phase(LAS unsigned char* lds, const GemmJob g, const Sched& S, const E& e, int wave_) {
    int tid = wave_ * 64 + lane_id_opaque(); asm volatile("" : "+v"(tid));
    const int wid = wave_, lane = tid & 63, wr = wid >> 2, wc = wid & 3, fr = lane & 15, fq = lane >> 4;
    const int K = g.K, nt = K / BK;
    unsigned voffA[2], voffB[2];
#pragma unroll
    for (int i = 0; i < 2; ++i) { int R, C; stage_rc(tid * 16 + i * 8192, R, C); const int Rb = (R >> 5) * 64 + (E::PERM ? perm32(R & 31) : (R & 31));
        voffA[i] = (unsigned)(R * g.lda + C) * 2u; voffB[i] = (unsigned)(Rb * g.ldb + C) * 2u; }
    const size_t kstep = (size_t)(BK * 2);
    const size_t hstepA = (size_t)HALF * g.lda * 2, hstepB = (size_t)32 * g.ldb * 2;
    const unsigned ldsw = (unsigned)wid * 1024u;
    const int aoff = lds_byte(wr * 64 + fr, fq * 8), boff = lds_byte(wc * 32 + fr, fq * 8);
#define PG8_SA(b, h) (((b) * 2 + (h)) * HTB)
#define PG8_SB(b, h) ((4 + (b) * 2 + (h)) * HTB)
#define PG8_STAGE(bufoff, gbase, voff) do { _Pragma("unroll") for (int _i = 0; _i < 2; ++_i) \
        __builtin_amdgcn_global_load_lds((const unsigned*)((const char*)(gbase) + (voff)[_i]), (LAS unsigned*)(lds + (bufoff) + ldsw + _i * 8192), 16, 0, 0); } while (0)
#define PG8_LDA(dst, b, h) do { _Pragma("unroll") for (int m = 0; m < 4; ++m) _Pragma("unroll") for (int k = 0; k < 2; ++k) dst[m][k] = *(const LAS bf16x8*)(lds + PG8_SA(b, h) + aoff + m * 2048 + k * 1024); } while (0)
#define PG8_LDB(dst, b, h) do { _Pragma("unroll") for (int n = 0; n < 2; ++n) _Pragma("unroll") for (int k = 0; k < 2; ++k) dst[n][k] = *(const LAS bf16x8*)(lds + PG8_SB(b, h) + boff + n * 2048 + k * 1024); } while (0)
#define PG8_MMA(ai, bj, At, Bt) do { __builtin_amdgcn_s_setprio(1); _Pragma("unroll") for (int m = 0; m < 4; ++m) _Pragma("unroll") for (int n = 0; n < 2; ++n) _Pragma("unroll") for (int k = 0; k < 2; ++k) \
        acc[ai][bj][m][n] = __builtin_amdgcn_mfma_f32_16x16x32_bf16(Bt[n][k], At[m][k], acc[ai][bj][m][n], 0, 0, 0); __builtin_amdgcn_s_setprio(0); } while (0)
#define PG8_WAIT_V(n) asm volatile("s_waitcnt vmcnt(" #n ")" ::: "memory")
#define PG8_WAIT_L(n) asm volatile("s_waitcnt lgkmcnt(" #n ")" ::: "memory")
#define PG8_BAR __builtin_amdgcn_s_barrier()
#define PG8_SCHED __builtin_amdgcn_sched_barrier(0)
    Unit cur, nxt; int ui = 0;
    if (!S.next(0, cur)) return;
    f32x4 acc[2][2][4][2];
#pragma unroll
    for (int a = 0; a < 2; ++a)
#pragma unroll
        for (int b = 0; b < 2; ++b)
#pragma unroll
            for (int m = 0; m < 4; ++m)
#pragma unroll
                for (int n = 0; n < 2; ++n) acc[a][b][m][n] = (f32x4){0.f, 0.f, 0.f, 0.f};
    bf16x8 At[4][2], B0[2][2], B1[2][2];
    const char* cA = (const char*)g.A + cur.aoff; const char* cB = (const char*)g.Bt + cur.boff;
    PG8_STAGE(PG8_SB(0, 0), cB, voffB); PG8_STAGE(PG8_SB(0, 1), cB + hstepB, voffB); PG8_STAGE(PG8_SA(0, 0), cA, voffA); PG8_STAGE(PG8_SA(0, 1), cA + hstepA, voffA);
    if (wr == 1) PG8_BAR;
    PG8_WAIT_V(2); PG8_BAR;
    PG8_STAGE(PG8_SB(1, 0), cB + kstep, voffB); PG8_STAGE(PG8_SA(1, 0), cA + kstep, voffA); PG8_STAGE(PG8_SB(1, 1), cB + hstepB + kstep, voffB);
    PG8_WAIT_V(6); PG8_BAR;
    for (;;) {
        const bool has_next = S.next(ui + 1, nxt);
        const char* nA = has_next ? (const char*)g.A + nxt.aoff : cA; const char* nB = has_next ? (const char*)g.Bt + nxt.boff : cB;
        for (int t = 0; t < nt; t += 2) {
            const bool last = (t == nt - 2);
            const char* a1 = cA + (size_t)(t + 1) * kstep;
            const char* a2 = last ? nA : cA + (size_t)(t + 2) * kstep; const char* b2 = last ? nB : cB + (size_t)(t + 2) * kstep;
            const char* a3 = a2 + kstep; const char* b3 = b2 + kstep;
            PG8_LDB(B0, 0, 0); PG8_LDB(B1, 0, 1); PG8_SCHED; PG8_LDA(At, 0, 0); PG8_STAGE(PG8_SA(1, 1), a1 + hstepA, voffA);
            PG8_WAIT_V(8); PG8_WAIT_L(0); PG8_BAR; PG8_MMA(0, 0, At, B0); PG8_MMA(0, 1, At, B1); PG8_BAR; PG8_SCHED;
            PG8_LDA(At, 0, 1); PG8_STAGE(PG8_SB(0, 0), b2, voffB); PG8_STAGE(PG8_SB(0, 1), b2 + hstepB, voffB); PG8_STAGE(PG8_SA(0, 0), a2, voffA);
            PG8_WAIT_V(8); PG8_WAIT_L(0); PG8_BAR; PG8_MMA(1, 0, At, B0); PG8_MMA(1, 1, At, B1); PG8_BAR; PG8_SCHED;
            PG8_LDB(B0, 1, 0); PG8_LDB(B1, 1, 1); PG8_SCHED; PG8_LDA(At, 1, 0); PG8_STAGE(PG8_SA(0, 1), a2 + hstepA, voffA);
            PG8_WAIT_V(8); PG8_WAIT_L(0); PG8_BAR; PG8_MMA(0, 0, At, B0); PG8_MMA(0, 1, At, B1); PG8_BAR; PG8_SCHED;
            PG8_LDA(At, 1, 1); PG8_STAGE(PG8_SB(1, 0), b3, voffB); PG8_STAGE(PG8_SB(1, 1), b3 + hstepB, voffB); PG8_STAGE(PG8_SA(1, 0), a3, voffA);
            PG8_WAIT_V(8); PG8_WAIT_L(0); PG8_BAR; PG8_MMA(1, 0, At, B0); PG8_MMA(1, 1, At, B1); PG8_BAR; PG8_SCHED;
            if constexpr (E::HAS_MID) { if (t + 2 == E::MID0 || t + 2 == E::MID1) run_mid(e, acc, cur, (t + 2 == E::MID0) ? 0 : 1, wr, wc, fr, fq); }
        }
        if (wr == 0) PG8_BAR;
        if constexpr (E::WHOLE) e.whole(acc, cur.pm, cur.pn, wr, wc, fr, fq); else run_epi(e, acc, cur, wr, wc, fr, fq);
        if (!has_next) break;
#pragma unroll
        for (int a = 0; a < 2; ++a)
#pragma unroll
            for (int b = 0; b < 2; ++b)
#pragma unroll
                for (int m = 0; m < 4; ++m)
#pragma unroll
                    for (int n = 0; n < 2; ++n) acc[a][b][m][n] = (f32x4){0.f, 0.f, 0.f, 0.f};
        cur = nxt; cA = nA; cB = nB; ++ui;
        if (wr == 1) PG8_BAR;
    }
    PG8_WAIT_V(0);
    PG8_BAR;
#undef PG8_SA
#undef PG8_SB
#undef PG8_STAGE
#undef PG8_LDA
#undef PG8_LDB
#undef PG8_MMA
#undef PG8_WAIT_V
#undef PG8_WAIT_L
#undef PG8_BAR
#undef PG8_SCHED
}
}

#define XB_TMO      128
#define XB_XCNT(j)  (256  + 64 * (j))
#define XB_XSUB(j)  (1280 + 64 * (j))
#define XB_XGEN(j)  (2304 + 64 * (j))
#define XB_TOP      3328
#define XB_TOPGEN   3392
#define XCD_BAR_WORDS 3456
#define XB_SPIN_CAP (1u << 18)
__device__ __forceinline__ unsigned xb_ld(unsigned* p)              { return __hip_atomic_load(p, __ATOMIC_RELAXED, __HIP_MEMORY_SCOPE_AGENT); }
__device__ __forceinline__ unsigned xb_add(unsigned* p, unsigned v) { return __hip_atomic_fetch_add(p, v, __ATOMIC_RELAXED, __HIP_MEMORY_SCOPE_AGENT); }
__device__ __forceinline__ unsigned xb_xcc_id() { return (unsigned)__builtin_amdgcn_s_getreg((3 << 11) | 20) & 0xFu; }
#define XB_SPIN(cond, bar) do { unsigned _sp = 0; while (cond) { __builtin_amdgcn_s_sleep(1); \
    if ((++_sp & 255u) == 0u) { if (xb_ld(&(bar)[XB_TMO])) break; if (_sp > XB_SPIN_CAP) { atomicAdd(&(bar)[XB_TMO], 1u); break; } } } } while (0)
struct XcdBarrier { unsigned* bar; unsigned x; volatile LAS unsigned* st; };
__device__ __forceinline__ XcdBarrier xcd_barrier_post(unsigned* bar, volatile LAS unsigned* st) {
    XcdBarrier b; b.bar = bar; b.x = xb_xcc_id(); b.st = st;
    if (threadIdx.x == 0) (void)xb_add(&bar[XB_XCNT(b.x)], 1u);
    return b;
}
__device__ __forceinline__ void xcd_barrier_complete(unsigned* bar, unsigned x, unsigned& nloc, unsigned& nx) {
    const unsigned G = gridDim.x * gridDim.y * gridDim.z;
    unsigned sum, cnt, mine, sp = 0u;
    for (;;) {
        sum = 0u; cnt = 0u; mine = 0u;
#pragma unroll
        for (unsigned j = 0; j < 16; ++j) { const unsigned c = xb_ld(&bar[XB_XCNT(j)]); sum += c; cnt += (c > 0u) ? 1u : 0u; mine = (j == x) ? c : mine; }
        if (sum == G) break;
        __builtin_amdgcn_s_sleep(1);
        if ((++sp & 255u) == 0u) { if (xb_ld(&bar[XB_TMO])) break; if (sp > XB_SPIN_CAP) { atomicAdd(&bar[XB_TMO], 1u); break; } }
    }
    nloc = mine > 0u ? mine : 1u; nx = cnt > 0u ? cnt : 1u;
}
__device__ __forceinline__ void xcd_barrier(const XcdBarrier& b) {
    asm volatile("s_waitcnt vmcnt(0)" ::: "memory");
    __syncthreads();
    if (threadIdx.x == 0) {
        unsigned* bar = b.bar;
        __builtin_amdgcn_s_waitcnt(0);
        unsigned nloc = b.st[0], nx = b.st[1];
        if (nloc == 0u) { xcd_barrier_complete(bar, b.x, nloc, nx); b.st[0] = nloc; b.st[1] = nx; }
        const unsigned old = xb_add(&bar[XB_XSUB(b.x)], 1u);
        const unsigned gen = old / nloc;
        if (old + 1u == (gen + 1u) * nloc) {
            __builtin_amdgcn_fence(__ATOMIC_RELEASE, "agent");
            asm volatile("s_waitcnt vmcnt(0)" ::: "memory");
            const unsigned og = xb_add(&bar[XB_TOP], 1u);
            const unsigned tg = og / nx;
            if (og + 1u == (tg + 1u) * nx) xb_add(&bar[XB_TOPGEN], 1u);
            else XB_SPIN(xb_ld(&bar[XB_TOPGEN]) == tg, bar);
            __builtin_amdgcn_fence(__ATOMIC_ACQUIRE, "agent");
            xb_add(&bar[XB_XGEN(b.x)], 1u);
            asm volatile("s_waitcnt vmcnt(0)" ::: "memory");
        } else {
            XB_SPIN(xb_ld(&bar[XB_XGEN(b.x)]) == gen, bar);
            __builtin_amdgcn_fence(__ATOMIC_ACQUIRE, "agent");
            asm volatile("s_waitcnt vmcnt(0)" ::: "memory");
        }
    }
    __syncthreads();
}

constexpr int NWAVES = 8, NTHR = 512;
constexpr int RING_BYTES = 131072, MISC_OFF = RING_BYTES, LDS_BYTES = 147456;
constexpr int CW_BAR = 4096;
#define LDS_WAIT() asm volatile("s_waitcnt lgkmcnt(0)" ::: "memory")

struct Ctx { LAS unsigned char* lds; int tid, lane, wave, vcu, G; };
__device__ __forceinline__ Ctx fresh(const Ctx& F0) { Ctx F = F0; int v = F0.vcu, w = F0.wave; asm volatile("" : "+s"(v), "+s"(w)); int t = w * 64 + lane_id_opaque(); asm volatile("" : "+v"(t)); F.tid = t; F.lane = t & 63; F.vcu = v; F.wave = w; return F; }

template <bool UPPERM = false> __device__ __forceinline__ void transpose_item(const float* W, int N, bf16* WT, int ldt, int col_off, LAS float* scr, int item, int lane) {
    const int nblk = N / 32, kb = item / nblk, nb = item % nblk, k0 = 64 * kb, n0 = 32 * nb;
    { const int kr = lane >> 3, c4 = lane & 7;
      f32x4 v[8];
#pragma unroll
      for (int i = 0; i < 8; ++i) v[i] = *(const f32x4*)(W + (size_t)(k0 + 8 * i + kr) * N + n0 + 4 * c4);
#pragma unroll
      for (int i = 0; i < 8; ++i)
#pragma unroll
          for (int j = 0; j < 4; ++j) scr[(8 * i + kr) * 33 + 4 * c4 + j] = v[i][j]; }
    LDS_WAIT(); asm volatile("" ::: "memory");
    const int c = lane & 7;
#pragma unroll
    for (int j = 0; j < 4; ++j) { const int n = (lane >> 3) + 8 * j; const LAS float* s = scr + (8 * c) * 33 + n;
        u32x4 o; o.x = pk2(s[0 * 33], s[1 * 33]); o.y = pk2(s[2 * 33], s[3 * 33]); o.z = pk2(s[4 * 33], s[5 * 33]); o.w = pk2(s[6 * 33], s[7 * 33]);
        int nr = n0 + n; if (UPPERM) { const int av = nr >= DFF, j = nr - av * DFF; nr = (j >> 7) * 256 + ((j >> 5) & 3) * 64 + av * 32 + (j & 31); }
        *(u32x4*)(WT + (size_t)nr * ldt + col_off + k0 + 8 * c) = o; }
    LDS_WAIT(); asm volatile("" ::: "memory");
}
__device__ __forceinline__ void prologue(const Params& p, const Ctx& F0) {
    const Ctx F = fresh(F0);
    const int gw = F.vcu * NWAVES + F.wave, NGW = F.G * NWAVES;
    const int gt = F.vcu * NTHR + F.tid, NGT = F.G * NTHR;
    {
        LAS float* sv = (LAS float*)F.lds;
        LAS float* red = (LAS float*)(F.lds + 24576);
        for (int i = F.tid; i < 3 * DM; i += NTHR) { const int r = i / DM, k = i % DM; const float x = r < 2 ? p.in[I_C][r * DM + k] : p.in[I_CCTX][k]; sv[i] = x / (1.0f + __expf(-x)); }
        __syncthreads();
        const int ng = F.tid & 15, ks = F.tid >> 4;
        float* mod = (float*)(p.ws + WS_MOD);
        for (int it = F.vcu; it < DEPTH * (NMOD / 64); it += F.G) {
            const int l = it / (NMOD / 64), n0 = (it % (NMOD / 64)) * 64;
            const float* W = p.in[I_WMOD] + ((size_t)l * DM + ks * 64) * NMOD + n0 + 4 * ng;
            f32x4 a0 = {0, 0, 0, 0}, a1 = {0, 0, 0, 0}, a2 = {0, 0, 0, 0};
#pragma unroll 8
            for (int kk = 0; kk < 64; ++kk) { const f32x4 w = *(const f32x4*)(W + (size_t)kk * NMOD); const int k = ks * 64 + kk; a0 += sv[k] * w; a1 += sv[DM + k] * w; a2 += sv[2 * DM + k] * w; }
            *(LAS f32x4*)(red + (ks * 3 + 0) * 64 + 4 * ng) = a0; *(LAS f32x4*)(red + (ks * 3 + 1) * 64 + 4 * ng) = a1; *(LAS f32x4*)(red + (ks * 3 + 2) * 64 + 4 * ng) = a2;
            __syncthreads();
            if (F.tid < 192) { const int r = F.tid >> 6, n = F.tid & 63; float s = p.in[I_BMOD][(size_t)l * NMOD + n0 + n];
                for (int q = 0; q < 32; ++q) s += red[(q * 3 + r) * 64 + n];
                mod[((size_t)l * 3 + r) * NMOD + n0 + n] = s; }
            __syncthreads();
        }
    }
    {
        LAS float* scr = (LAS float*)(F.lds + F.wave * 16384);
        constexpr int I_IN = (DM / 64) * (NIN / 32), I_BF = (512 / 64) * (DM / 32), I_BA = (1024 / 64) * (DM / 32), I_OUT = (DM / 64) * (DM / 32), I_DN = (DFF / 64) * (DM / 32);
        constexpr int PER_LAYER = 2 * I_IN + 2 * I_BF + I_BA + I_OUT + I_DN;
        for (int it = gw; it < DEPTH * PER_LAYER; it += NGW) {
            const int l = it / PER_LAYER; int r = it % PER_LAYER;
            unsigned char* wb = p.ws + WS_W + (size_t)l * W_LAYER;
            if (r < I_IN) { transpose_item(p.in[I_WIN] + (size_t)l * DM * NIN, NIN, (bf16*)(wb + W_IN), DM, 0, scr, r, F.lane); continue; } r -= I_IN;
            if (r < I_IN) { transpose_item<MK_FUSE_ACT != 0>(p.in[I_WUP] + (size_t)l * DM * NUP, NUP, (bf16*)(wb + W_UP), DM, 0, scr, r, F.lane); continue; } r -= I_IN;
            if (r < I_BF) { transpose_item(p.in[I_WBF] + (size_t)l * 512 * DM, DM, (bf16*)(wb + W_BM), DM, 0, scr, r, F.lane); continue; } r -= I_BF;
            if (r < I_BF) { transpose_item(p.in[I_WBC] + (size_t)l * 512 * DM, DM, (bf16*)(wb + W_BM), DM, 512, scr, r, F.lane); continue; } r -= I_BF;
            if (r < I_BA) { transpose_item(p.in[I_WBA] + (size_t)l * 1024 * DM, DM, (bf16*)(wb + W_BM), DM, 1024, scr, r, F.lane); continue; } r -= I_BA;
            if (r < I_OUT) { transpose_item(p.in[I_WOUT] + (size_t)l * DM * DM, DM, (bf16*)(wb + W_OUT), DM, 0, scr, r, F.lane); continue; } r -= I_OUT;
            transpose_item(p.in[I_WDOWN] + (size_t)l * DFF * DM, DM, (bf16*)(wb + W_DOWN), DFF, 0, scr, r, F.lane);
        }
    }
    {
#if MK_FFT
        { bf16* WA = (bf16*)(p.ws + WS_FWA); bf16* WC = (bf16*)(p.ws + WS_FWC); float2* tw = (float2*)(p.ws + WS_FTW);
          for (int it = gt; it < 128 * 128; it += NGT) { const int r = it >> 7, k = it & 127, pr = r >> 6, ap = r & 63, pk = k >> 6, a = k & 63; float sn, cs; sincospif((float)((ap * a) & 63) * (1.0f / 32.0f), &sn, &cs);
              const float v = (pr == 0 ? (pk == 0 ? cs : -sn) : (pk == 0 ? -sn : -cs)) * 0.125f; WA[it] = (bf16)f2bf(v); }
          for (int it = gt; it < 64 * 128; it += NGT) { const int bp = it >> 7, k = it & 127, pk = k >> 6, b = k & 63; float sn, cs; sincospif((float)((bp * b) & 63) * (1.0f / 32.0f), &sn, &cs); WC[it] = (bf16)f2bf((pk == 0 ? cs : sn) * 0.125f); }
          for (int it = gt; it < 4096; it += NGT) { float sn, cs; sincospif((float)it * (1.0f / 2048.0f), &sn, &cs); tw[it] = make_float2(cs, sn); } }
#else
        bf16* DL = (bf16*)(p.ws + WS_DL);
        for (int it = gt; it < SEQ * 1024; it += NGT) {
            const int lp = it >> 10, j0 = (it & 1023) * 8; float v[8];
#pragma unroll
            for (int e = 0; e < 8; ++e) { const int j = j0 + e, l = j & (SEQ - 1); const int m = (lp * l) & (SEQ - 1); float s, c; sincospif((float)m * (1.0f / 2048.0f), &s, &c); v[e] = (j < SEQ ? c : -s) * (1.0f / 64.0f); }
            *(u32x4*)(DL + (size_t)lp * (2 * SEQ) + j0) = pack8(v);
        }
#endif
        bf16* DC = (bf16*)(p.ws + WS_DC);
        for (int it = gt; it < CTXL * 64; it += NGT) {
            const int lp = it >> 6, j0 = (it & 63) * 8; float v[8];
#pragma unroll
            for (int e = 0; e < 8; ++e) { const int j = j0 + e, l = j & (CTXL - 1); const int m = (lp * l) & (CTXL - 1); float s, c; sincospif((float)m * (1.0f / 128.0f), &s, &c); v[e] = (j < CTXL ? c : -s) * (1.0f / 16.0f); }
            *(u32x4*)(DC + (size_t)lp * (2 * CTXL) + j0) = pack8(v);
        }
        bf16* CS = (bf16*)(p.ws + WS_CS128);
        for (int it = gt; it < 256 * 32; it += NGT) {
            const int row = it >> 5, k0 = (it & 31) * 8, cs = row >> 7, cp = row & 127; float v[8];
#pragma unroll
            for (int e = 0; e < 8; ++e) { const int k = k0 + e; const int m = (cp * k) & 127; float s, c; sincospif((float)m * (1.0f / 64.0f), &s, &c); v[e] = k < 128 ? (cs == 0 ? c : s) * 0.08838834764831845f : 0.f; }
            *(u32x4*)(CS + (size_t)row * 256 + k0) = pack8(v);
        }
        float2* rope = (float2*)(p.ws + WS_ROPE);
        for (int it = gt; it < 64 * 16; it += NGT) { const int pos = it >> 4, j = it & 15; const float inv = powf(10000.0f, -(float)j * (1.0f / 16.0f)); const float a = (float)pos * inv; rope[it] = make_float2(cosf(a), sinf(a)); }
        if (gt < DEPTH) { const float* lm = p.in[I_LAMB] + gt * 4 * HD; float s0 = 0.f, s1 = 0.f; for (int d = 0; d < HD; ++d) { s0 += lm[d] * lm[HD + d]; s1 += lm[2 * HD + d] * lm[3 * HD + d]; }
            ((float*)(p.ws + WS_LAM))[gt] = expf(s0) - expf(s1) + (0.8f - 0.6f * expf(-0.3f * (float)gt)); }
    }
}

__device__ __forceinline__ void norm_row_finish(const LAS float* tab, bf16* xrow, const float (&f)[4][8], int lane) {
    float ss = 0.f;
#pragma unroll
    for (int j = 0; j < 4; ++j)
#pragma unroll
        for (int i = 0; i < 8; i += 2) ss += f[j][i] * f[j][i] + f[j][i + 1] * f[j][i + 1];
    const float rstd = rsqrtf(wave_sum(ss) * (1.0f / DM) + EPS_RMS);
#pragma unroll
    for (int j = 0; j < 4; ++j) { const int ci = 4 * (lane + 64 * j); float o[8];
        const f32x4 ae = *(const LAS f32x4*)(tab + ci), ao = *(const LAS f32x4*)(tab + 1024 + ci), be = *(const LAS f32x4*)(tab + 2048 + ci), bo = *(const LAS f32x4*)(tab + 3072 + ci);
#pragma unroll
        for (int i = 0; i < 4; ++i) { o[i] = (f[j][i] * rstd) * ae[i] + be[i]; o[4 + i] = (f[j][4 + i] * rstd) * ao[i] + bo[i]; }
        *(u32x4*)(xrow + 8 * (lane + 64 * j)) = pack8(o); }
}
template <int NR> __device__ __forceinline__ void norm_rows_bf16(const bf16* h, bf16* xn, const LAS float* tab, int row0, int lane) {
    u32x4 raw[NR][4];
#pragma unroll
    for (int r = 0; r < NR; ++r) { const u32x4* xr = (const u32x4*)(h + (size_t)(row0 + r) * DM) + lane;
#pragma unroll
        for (int j = 0; j < 4; ++j) raw[r][j] = xr[64 * j]; }
#pragma unroll
    for (int r = 0; r < NR; ++r) { float f[4][8];
#pragma unroll
        for (int j = 0; j < 4; ++j) unpack8(raw[r][j], f[j]);
        norm_row_finish(tab, xn + (size_t)(row0 + r) * DM, f, lane); }
}
__device__ __forceinline__ void norm_row_f32(const float* src, bf16* xrow, const LAS float* tab, int lane) {
    const f32x4* xr = (const f32x4*)src + 2 * lane; float f[4][8];
#pragma unroll
    for (int j = 0; j < 4; ++j) { const f32x4 a = xr[128 * j], b = xr[128 * j + 1]; f[j][0] = a[0]; f[j][1] = a[1]; f[j][2] = a[2]; f[j][3] = a[3]; f[j][4] = b[0]; f[j][5] = b[1]; f[j][6] = b[2]; f[j][7] = b[3]; }
    norm_row_finish(tab, xrow, f, lane);
}
__device__ __forceinline__ void norm_mod_phase(const Params& p, const Ctx& F0, int layer, int which) {
    const Ctx F = fresh(F0);
    const bf16* h = (const bf16*)(p.ws + WS_H); bf16* xn = (bf16*)(p.ws + WS_XN);
    const float* g = p.in[which == 0 ? I_G1 : I_G2] + (size_t)layer * DM;
    const float* modl = (const float*)(p.ws + WS_MOD) + (size_t)layer * 3 * NMOD;
    const int shoff = which == 0 ? 0 : 3 * DM, scoff = shoff + DM;
    LAS float* tab = (LAS float*)F.lds;
    for (int u = F.vcu; u < 256; u += F.G) {
        __syncthreads();
        { const int c4 = 4 * F.tid, li = (F.tid & 1) * 1024 + 4 * (F.tid >> 1);
          const f32x4 gg = *(const f32x4*)(g + c4);
#pragma unroll
          for (int s2 = 0; s2 < 2; ++s2) { const float* md = modl + (size_t)(s2 == 0 ? (u >> 7) : 2) * NMOD;
              const f32x4 sc = *(const f32x4*)(md + scoff + c4), sh = *(const f32x4*)(md + shoff + c4);
              *(LAS f32x4*)(tab + s2 * 4096 + li) = gg * (1.0f + sc); *(LAS f32x4*)(tab + s2 * 4096 + 2048 + li) = sh; } }
        __syncthreads();
        const int row0 = 32 * u + 4 * F.wave;
        if (layer == 0 && which == 0) {
            for (int r = 0; r < 4; ++r) norm_row_f32(p.in[I_X] + (size_t)(row0 + r) * DM, xn + (size_t)(row0 + r) * DM, tab, F.lane);
            if (F.wave < 2) norm_row_f32(p.in[I_CTX] + (size_t)(2 * u + F.wave) * DM, xn + (size_t)(ML + 2 * u + F.wave) * DM, tab + 4096, F.lane);
        } else {
            norm_rows_bf16<4>(h, xn, tab, row0, F.lane);
            if (F.wave < 2) norm_rows_bf16<1>(h, xn, tab + 4096, ML + 2 * u + F.wave, F.lane);
        }
    }
}
__device__ __forceinline__ void mixer_prep_phase(const Params& p, const Ctx& F0, int layer) {
    const Ctx F = fresh(F0);
    const int gw = F.vcu * NWAVES + F.wave, NGW = F.G * NWAVES;
    const int gt = F.vcu * NTHR + F.tid, NGT = F.G * NTHR;
    const bf16* P = (const bf16*)(p.ws + WS_P);
    bf16* Qr = (bf16*)(p.ws + WS_QR); bf16* Kc = (bf16*)(p.ws + WS_KC); bf16* Vt = (bf16*)(p.ws + WS_VT); bf16* br = (bf16*)(p.ws + WS_BR);
    const float2* rope = (const float2*)(p.ws + WS_ROPE);
    for (int it = gt; it < MROWS * 128; it += NGT) {
        const int row = it >> 7, w = it & 127, tens = w >> 6, sub = w & 63, hh = sub >> 3, cc = (sub >> 2) & 1, ax = (sub >> 1) & 1, jh = sub & 1;
        const int base = hh * 128 + cc * 64 + ax * 32 + jh * 8;
        const RowInfo ri = row_info(row);
        const bf16* src = P + (size_t)row * NIN + (tens == 0 ? Q_OFF : K_OFF) + base;
        float x1[8], x2[8]; unpack8(*(const u32x4*)src, x1); unpack8(*(const u32x4*)(src + 16), x2);
        float o1[8], o2[8];
        if (!ri.ctx) { const int pa = ax == 0 ? (ri.pos >> 6) : (ri.pos & 63);
#pragma unroll
            for (int e = 0; e < 8; ++e) { const float2 cs = rope[pa * 16 + jh * 8 + e]; o1[e] = x1[e] * cs.x - x2[e] * cs.y; o2[e] = x2[e] * cs.x + x1[e] * cs.y; } }
        else {
#pragma unroll
            for (int e = 0; e < 8; ++e) { o1[e] = x1[e]; o2[e] = x2[e]; } }
        bf16* dst;
        if (tens == 0) {
#pragma unroll
            for (int e = 0; e < 8; ++e) { o1[e] *= QSCALE; o2[e] *= QSCALE; }
            dst = Qr + (size_t)row * QKW + base; }
        else dst = Kc + ((size_t)(ri.b * LK + ri.kv) * QKW + base);
        *(u32x4*)dst = pack8(o1); *(u32x4*)(dst + 16) = pack8(o2);
    }
    const float* cw = p.in[I_CONVW] + (size_t)layer * 3 * 512;
    for (int it = gt; it < MROWS * 64; it += NGT) {
        const int row = it >> 6, j0 = (it & 63) * 8; const RowInfo ri = row_info(row);
        const bf16* pr = P + (size_t)row * NIN + j0;
        float cb[8], a[8], b[8], acc[8];
        unpack8(*(const u32x4*)(pr + CB_OFF), cb);
        unpack8(*(const u32x4*)(pr + CC_OFF), a); unpack8(*(const u32x4*)(pr + CX_OFF), b);
#pragma unroll
        for (int e = 0; e < 8; ++e) acc[e] = a[e] * b[e] * cw[512 + j0 + e];
        if (ri.pos > 0) { unpack8(*(const u32x4*)(pr - NIN + CC_OFF), a); unpack8(*(const u32x4*)(pr - NIN + CX_OFF), b);
#pragma unroll
            for (int e = 0; e < 8; ++e) acc[e] += a[e] * b[e] * cw[j0 + e]; }
        if (ri.pos + 1 < ri.L) { unpack8(*(const u32x4*)(pr + NIN + CC_OFF), a); unpack8(*(const u32x4*)(pr + NIN + CX_OFF), b);
#pragma unroll
            for (int e = 0; e < 8; ++e) acc[e] += a[e] * b[e] * cw[1024 + j0 + e]; }
#pragma unroll
        for (int e = 0; e < 8; ++e) acc[e] *= cb[e];
        *(u32x4*)(br + (size_t)row * DM + 512 + j0) = pack8(acc);
    }
    LAS bf16* scr = (LAS bf16*)(F.lds + F.wave * 16384);
    for (int it = gw; it < (MROWS / 64) * 16; it += NGW) {
        const int tt = it >> 4, ct = it & 15, row0 = tt * 64; const RowInfo ri = row_info(row0);
#pragma unroll
        for (int i = 0; i < 8; ++i) { const int t = i * 8 + (F.lane >> 3), ch = F.lane & 7;
            const u32x4 w = *(const u32x4*)(P + (size_t)(row0 + t) * NIN + V_OFF + ct * 64 + ch * 8);
            const unsigned ww[4] = {w.x, w.y, w.z, w.w};
#pragma unroll
            for (int e = 0; e < 8; ++e) scr[(ch * 8 + e) * 72 + t] = (bf16)((ww[e >> 1] >> ((e & 1) * 16)) & 0xffffu); }
        LDS_WAIT(); asm volatile("" ::: "memory");
#pragma unroll
        for (int i = 0; i < 8; ++i) { const int col = i * 8 + (F.lane >> 3), ch = F.lane & 7;
            const u32x4 w = *(const LAS u32x4*)(scr + col * 72 + ch * 8);
            *(u32x4*)(Vt + ((size_t)(ri.b * QKW + ct * 64 + col) * LK + ri.kv + ch * 8)) = w; }
        LDS_WAIT(); asm volatile("" ::: "memory");
    }
}
__device__ __forceinline__ void ffn_act_phase(const Params& p, const Ctx& F0, int layer) {
    const Ctx F = fresh(F0);
    const int gt = F.vcu * NTHR + F.tid, NGT = F.G * NTHR;
    const bf16* Y = (const bf16*)(p.ws + WS_P); bf16* act = (bf16*)(p.ws + WS_ACT);
    const float* cw = p.in[I_FCONVW] + (size_t)layer * 3 * NUP;
    for (int it = gt; it < MROWS * (DFF / 8); it += NGT) {
        const int row = it / (DFF / 8), j0 = (it % (DFF / 8)) * 8; const RowInfo ri = row_info(row);
        const bf16* pr = Y + (size_t)row * NUP + j0;
        float a[8], v[8], ua[8], uv[8];
        unpack8(*(const u32x4*)pr, a); unpack8(*(const u32x4*)(pr + DFF), v);
#pragma unroll
        for (int e = 0; e < 8; ++e) { ua[e] = a[e] * cw[NUP + j0 + e]; uv[e] = v[e] * cw[NUP + DFF + j0 + e]; }
        if (ri.pos > 0) { unpack8(*(const u32x4*)(pr - NUP), a); unpack8(*(const u32x4*)(pr - NUP + DFF), v);
#pragma unroll
            for (int e = 0; e < 8; ++e) { ua[e] += a[e] * cw[j0 + e]; uv[e] += v[e] * cw[DFF + j0 + e]; } }
        if (ri.pos + 1 < ri.L) { unpack8(*(const u32x4*)(pr + NUP), a); unpack8(*(const u32x4*)(pr + NUP + DFF), v);
#pragma unroll
            for (int e = 0; e < 8; ++e) { ua[e] += a[e] * cw[2 * NUP + j0 + e]; uv[e] += v[e] * cw[2 * NUP + DFF + j0 + e]; } }
        float o[8];
#pragma unroll
        for (int e = 0; e < 8; ++e) o[e] = ua[e] * sigmoidf_(ua[e]) * uv[e];
        *(u32x4*)(act + (size_t)row * DFF + j0) = pack8(o);
    }
}
__device__ __forceinline__ void act_fix_phase(const Params& p, const Ctx& F0, int layer) {
    const Ctx F = fresh(F0);
    const int gt = F.vcu * NTHR + F.tid, NGT = F.G * NTHR;
    const float* halo = (const float*)(p.ws + WS_HALO); bf16* act = (bf16*)(p.ws + WS_ACT);
    const float* cw = p.in[I_FCONVW] + (size_t)layer * 3 * NUP;
    for (int it = gt; it < 30 * 2 * DFF; it += NGT) {
        const int j = it % DFF, rb = it / DFF, side = rb & 1, bi = rb >> 1, pm = bi + bi / 15;
        float ua, uv; int row;
        if (side == 0) {
            const float* hp = halo + (size_t)pm * 8 * DFF, *hn = halo + (size_t)(pm + 1) * 8 * DFF;
            ua = hp[(3 * 2 + 0) * DFF + j] + cw[2 * NUP + j] * hn[(0 * 2 + 0) * DFF + j]; uv = hp[(3 * 2 + 1) * DFF + j] + cw[2 * NUP + DFF + j] * hn[(0 * 2 + 1) * DFF + j]; row = pm * 256 + 255;
        } else {
            const float* hp = halo + (size_t)pm * 8 * DFF, *hn = halo + (size_t)(pm + 1) * 8 * DFF;
            ua = hn[(2 * 2 + 0) * DFF + j] + cw[j] * hp[(1 * 2 + 0) * DFF + j]; uv = hn[(2 * 2 + 1) * DFF + j] + cw[DFF + j] * hp[(1 * 2 + 1) * DFF + j]; row = (pm + 1) * 256;
        }
        act[(size_t)row * DFF + j] = (bf16)pk2(ua * sigmoidf_(ua) * uv, 0.f);
    }
}
__device__ __forceinline__ void final_norm_phase(const Params& p, const Ctx& F0) {
    const Ctx F = fresh(F0);
    const int gw = F.vcu * NWAVES + F.wave, NGW = F.G * NWAVES;
    const bf16* h = (const bf16*)(p.ws + WS_H); const float* g = p.in[I_GFIN];
    for (int row = gw; row < ML; row += NGW) {
        const u32x4* xr = (const u32x4*)(h + (size_t)row * DM) + F.lane;
        float v[4][8]; float ss = 0.f;
#pragma unroll
        for (int j = 0; j < 4; ++j) { unpack8(xr[64 * j], v[j]);
#pragma unroll
            for (int e = 0; e < 8; ++e) ss += v[j][e] * v[j][e]; }
        const float rstd = rsqrtf(wave_sum(ss) * (1.0f / DM) + EPS_RMS);
#pragma unroll
        for (int j = 0; j < 4; ++j) { const int col = 8 * (F.lane + 64 * j); const f32x4 g0 = *(const f32x4*)(g + col), g1 = *(const f32x4*)(g + col + 4);
            f32x4* orow = (f32x4*)(p.out + (size_t)row * DM + col);
            orow[0] = (f32x4){v[j][0], v[j][1], v[j][2], v[j][3]} * rstd * g0; orow[1] = (f32x4){v[j][4], v[j][5], v[j][6], v[j][7]} * rstd * g1; }
    }
}

constexpr float AT_TRIG = 65536.0f;
constexpr int AT_KP = 144;
constexpr int AT_K0 = 0, AT_K1 = 64 * AT_KP, AT_V = 2 * 64 * AT_KP, AT_STG = AT_V + 128 * AT_KP;
__device__ __forceinline__ float swap32_max(float v) { auto rr = __builtin_amdgcn_permlane32_swap(__float_as_uint(v), __float_as_uint(v), false, false); return fmaxf(__uint_as_float(rr[0]), __uint_as_float(rr[1])); }
__device__ __forceinline__ float swap32_sum(float v) { auto rr = __builtin_amdgcn_permlane32_swap(__float_as_uint(v), __float_as_uint(v), false, false); return __uint_as_float(rr[0]) + __uint_as_float(rr[1]); }
__device__ __forceinline__ void attn_unit(const Params& p, const Ctx& F0, int layer, int b, int h, int qrow0, int nk) {
    const Ctx F = fresh(F0);
    const bf16* Qr = (const bf16*)(p.ws + WS_QR); const bf16* Kc = (const bf16*)(p.ws + WS_KC) + (size_t)b * LK * QKW + h * 128; const bf16* Vt = (const bf16*)(p.ws + WS_VT) + (size_t)(b * QKW + h * 128) * LK;
    bf16* br = (bf16*)(p.ws + WS_BR);
    const int tid = F.tid, lane = F.lane, wid = F.wave, comp = wid >> 2, qw = wid & 3, r32 = lane & 31, hi = lane >> 5;
    LAS unsigned char* lds = F.lds;
    const int srow = tid >> 3, sch = tid & 7;
    const bf16* gk = Kc + (size_t)srow * QKW + sch * 8;
    const bf16* gv = Vt + (size_t)srow * LK + sch * 8;
    const int sk = srow * AT_KP + sch * 16;
    u32x4 st0, st1, st2, st3;
#define AT_LOAD(t) do { const bf16* k_ = gk + (size_t)(t) * 64 * QKW; const bf16* v_ = gv + (t) * 64; st0 = *(const u32x4*)k_; st1 = *(const u32x4*)(k_ + 64); st2 = *(const u32x4*)v_; st3 = *(const u32x4*)(v_ + (size_t)64 * LK); } while (0)
#define AT_STORE(s) do { LAS unsigned char* d_ = lds + (s) * AT_STG; *(LAS u32x4*)(d_ + AT_K0 + sk) = st0; *(LAS u32x4*)(d_ + AT_K1 + sk) = st1; *(LAS u32x4*)(d_ + AT_V + sk) = st2; *(LAS u32x4*)(d_ + AT_V + 64 * AT_KP + sk) = st3; } while (0)
    const int nt = nk / 64;
    AT_LOAD(0);
    bf16x8 qf[4];
    { const bf16* qp = Qr + (size_t)(qrow0 + qw * 32 + r32) * QKW + h * 128 + comp * 64 + hi * 8;
#pragma unroll
      for (int d0 = 0; d0 < 4; ++d0) qf[d0] = *(const bf16x8*)(qp + d0 * 16); }
    AT_STORE(0);
    f32x16 ot[4];
#pragma unroll
    for (int i = 0; i < 4; ++i)
#pragma unroll
        for (int r = 0; r < 16; ++r) ot[i][r] = 0.f;
    float mrun = 0.f, lrun = 0.f;
    const int krow = (r32 & 19) | ((r32 & 4) << 1) | ((r32 & 8) >> 1);
    const int kfo = (comp ? AT_K1 : AT_K0) + krow * AT_KP + hi * 16;
    const int vfo = AT_V + r32 * AT_KP + hi * 16;
    bf16x8 pprev[4];
#pragma unroll
    for (int i = 0; i < 4; ++i) pprev[i] = (bf16x8){0, 0, 0, 0, 0, 0, 0, 0};
    bf16x8 va0, va1, va2, va3, vb0, vb1, vb2, vb3;
    va0 = va1 = va2 = va3 = (bf16x8){0, 0, 0, 0, 0, 0, 0, 0};
#define AT_VRD(vb_, f_) (*(const LAS bf16x8*)((vb_) + ((f_) & 3) * 32 * AT_KP + ((f_) >> 2) * 32))
#define AT_SB() __builtin_amdgcn_sched_barrier(0)
#define AT_PVPRE(stage_) do { const LAS unsigned char* vb_ = lds + (stage_) * AT_STG + vfo; va0 = AT_VRD(vb_, 0); va1 = AT_VRD(vb_, 1); va2 = AT_VRD(vb_, 2); va3 = AT_VRD(vb_, 3); } while (0)
#define AT_MF(i_, v_, g_, pf_) ot[i_] = __builtin_amdgcn_mfma_f32_32x32x16_bf16(v_, pf_[g_], ot[i_], 0, 0, 0)
#define AT_PV(stage_, pf_) do { const LAS unsigned char* vb_ = lds + (stage_) * AT_STG + vfo; AT_SB(); \
        vb0 = AT_VRD(vb_, 4);  AT_MF(0, va0, 0, pf_); AT_SB(); vb1 = AT_VRD(vb_, 5);  AT_MF(1, va1, 0, pf_); AT_SB(); vb2 = AT_VRD(vb_, 6);  AT_MF(2, va2, 0, pf_); AT_SB(); vb3 = AT_VRD(vb_, 7);  AT_MF(3, va3, 0, pf_); AT_SB(); \
        va0 = AT_VRD(vb_, 8);  AT_MF(0, vb0, 1, pf_); AT_SB(); va1 = AT_VRD(vb_, 9);  AT_MF(1, vb1, 1, pf_); AT_SB(); va2 = AT_VRD(vb_, 10); AT_MF(2, vb2, 1, pf_); AT_SB(); va3 = AT_VRD(vb_, 11); AT_MF(3, vb3, 1, pf_); AT_SB(); \
        vb0 = AT_VRD(vb_, 12); AT_MF(0, va0, 2, pf_); AT_SB(); vb1 = AT_VRD(vb_, 13); AT_MF(1, va1, 2, pf_); AT_SB(); vb2 = AT_VRD(vb_, 14); AT_MF(2, va2, 2, pf_); AT_SB(); vb3 = AT_VRD(vb_, 15); AT_MF(3, va3, 2, pf_); AT_SB(); \
        AT_MF(0, vb0, 3, pf_); AT_MF(1, vb1, 3, pf_); AT_MF(2, vb2, 3, pf_); AT_MF(3, vb3, 3, pf_); AT_SB(); } while (0)
    __syncthreads();
    int s_prev = 2, s_cur = 0, s_next = 1;
    for (int t = 0; t < nt; ++t) {
        if (t + 1 < nt) AT_LOAD(t + 1);
        bf16x8 kf[8];
        { const LAS unsigned char* kb_ = lds + s_cur * AT_STG + kfo;
#pragma unroll
          for (int f = 0; f < 8; ++f) kf[f] = *(const LAS bf16x8*)(kb_ + (f >> 2) * 32 * AT_KP + (f & 3) * 32); }
        if (comp && t > 0) AT_PV(s_prev, pprev);
        const LAS unsigned char* sb = lds + s_cur * AT_STG;
        f32x16 sc[2];
        const bool ref0 = !__any(mrun != 0.f);
#define AT_QK() do { AT_SB(); _Pragma("unroll") for (int d0 = 0; d0 < 4; ++d0) { sc[0] = __builtin_amdgcn_mfma_f32_32x32x16_bf16(kf[d0], qf[d0], sc[0], 0, 0, 0); sc[1] = __builtin_amdgcn_mfma_f32_32x32x16_bf16(kf[4 + d0], qf[d0], sc[1], 0, 0, 0); } AT_SB(); } while (0)
        if (ref0) {
#pragma unroll
            for (int r = 0; r < 16; ++r) { sc[0][r] = 0.f; sc[1][r] = 0.f; }
            AT_QK();
        } else {
#pragma unroll
            for (int r = 0; r < 16; ++r) { sc[0][r] = -mrun; sc[1][r] = -mrun; }
            AT_QK();
        }
#undef AT_QK
        if (!comp) AT_PVPRE(s_cur);
        f32x16 ex[2];
#pragma unroll
        for (int kh = 0; kh < 2; ++kh)
#pragma unroll
            for (int r = 0; r < 16; ++r) ex[kh][r] = __builtin_amdgcn_exp2f(sc[kh][r]);
        float ps;
        { float a0 = ex[0][0], a1 = ex[1][0];
#pragma unroll
          for (int r = 1; r < 16; ++r) { a0 += ex[0][r]; if ((r & 3) == 3) asm volatile("" : "+v"(a0)); }
#pragma unroll
          for (int r = 1; r < 16; ++r) { a1 += ex[1][r]; if ((r & 3) == 1) asm volatile("" : "+v"(a1)); }
          ps = a0 + a1; }
        const float pst = swap32_sum(ps);
        if (t == 0 || __any(!(pst < AT_TRIG))) {
            float mx = fmaxf(sc[0][0], sc[1][0]);
#pragma unroll
            for (int r = 1; r < 16; ++r) mx = fmaxf(mx, fmaxf(sc[0][r], sc[1][r]));
            mx = swap32_max(mx);
            const float dl = (!(pst < AT_TRIG) || (t == 0 && fabsf(mx) > 16.f)) ? mx : 0.f;
            mrun += dl;
            const float alpha = __builtin_amdgcn_exp2f(-dl);
            lrun *= alpha;
            ps = 0.f;
#pragma unroll
            for (int kh = 0; kh < 2; ++kh)
#pragma unroll
                for (int r = 0; r < 16; ++r) { const float e = __builtin_amdgcn_exp2f(sc[kh][r] - dl); ex[kh][r] = e; ps += e; }
            if (t > 0) {
#pragma unroll
                for (int i = 0; i < 4; ++i)
#pragma unroll
                    for (int r = 0; r < 16; ++r) ot[i][r] *= alpha;
            }
        }
        lrun += ps;
#pragma unroll
        for (int kh = 0; kh < 2; ++kh)
#pragma unroll
            for (int s2 = 0; s2 < 2; ++s2) {
                u32x4 pw; pw.x = pk2(ex[kh][8 * s2 + 0], ex[kh][8 * s2 + 1]); pw.y = pk2(ex[kh][8 * s2 + 2], ex[kh][8 * s2 + 3]); pw.z = pk2(ex[kh][8 * s2 + 4], ex[kh][8 * s2 + 5]); pw.w = pk2(ex[kh][8 * s2 + 6], ex[kh][8 * s2 + 7]);
                pprev[kh * 2 + s2] = __builtin_bit_cast(bf16x8, pw);
            }
        if (!comp) AT_PV(s_cur, pprev);
        if (t + 1 < nt) AT_STORE(s_next);
        if (comp) AT_PVPRE(s_cur);
        __syncthreads();
        { const int tmp = s_prev; s_prev = s_cur; s_cur = s_next; s_next = tmp; }
    }
    if (comp) AT_PV(s_prev, pprev);
    __syncthreads();
#undef AT_PV
#undef AT_PVPRE
#undef AT_MF
#undef AT_VRD
    const float ltot = swap32_sum(lrun);
    const float lam = ((const float*)(p.ws + WS_LAM))[layer];
    const float inv = comp ? lam / ltot : 1.0f / ltot;
    LAS float* xb = (LAS float*)lds;
    if (comp) {
#pragma unroll
        for (int i = 0; i < 4; ++i)
#pragma unroll
            for (int r = 0; r < 16; ++r) xb[(qw * 64 + i * 16 + r) * 64 + lane] = ot[i][r] * inv;
    }
    __syncthreads();
    if (!comp) {
        float ss = 0.f;
#pragma unroll
        for (int i = 0; i < 4; ++i)
#pragma unroll
            for (int r = 0; r < 16; ++r) { const float o = ot[i][r] * inv - xb[(qw * 64 + i * 16 + r) * 64 + lane]; ot[i][r] = o; ss += o * o; }
        ss = swap32_sum(ss);
        const float lam_init = 0.8f - 0.6f * __expf(-0.3f * (float)layer);
        const float rs = rsqrtf(ss * (1.0f / 128.0f) + EPS_SUBLN) * (1.0f - lam_init);
        const float* sg = p.in[I_SUBG] + layer * VD;
        bf16* op = br + (size_t)(qrow0 + qw * 32 + r32) * DM + 1024 + h * 128;
#pragma unroll
        for (int i = 0; i < 4; ++i)
#pragma unroll
            for (int g4 = 0; g4 < 4; ++g4) { const int dv = 32 * i + 8 * g4 + 4 * hi; const f32x4 gg = *(const f32x4*)(sg + dv);
                u32x2 w; w.x = pk2(ot[i][4 * g4 + 0] * rs * gg[0], ot[i][4 * g4 + 1] * rs * gg[1]); w.y = pk2(ot[i][4 * g4 + 2] * rs * gg[2], ot[i][4 * g4 + 3] * rs * gg[3]);
                *(u32x2*)(op + dv) = w; }
    }
    __syncthreads();
#undef AT_LOAD
#undef AT_STORE
}
__device__ __forceinline__ void attn_phase(const Params& p, const Ctx& F, int layer) {
    for (int u = F.vcu; u < 512 + 32; u += F.G) {
        if (u < 512) { const int bh = u >> 5, qb = u & 31, b = bh >> 3, h = bh & 7; attn_unit(p, F, layer, b, h, b * SEQ + qb * 128, LK); }
        else { const int v = u - 512, bh = v >> 1, qb = v & 1, b = bh >> 3, h = bh & 7; attn_unit(p, F, layer, b, h, ML + b * CTXL + qb * 128, CTXL); }
    }
}

constexpr int FM_PITCH = 288, FM_WA = 0, FM_WC = 128 * FM_PITCH, FM_IMG = FM_WC + 64 * FM_PITCH, FM_IMGB = 64 * FM_PITCH;
__device__ __forceinline__ void fmix_phase(const Params& p, const Ctx& F0) {
    const Ctx F = fresh(F0);
    LAS unsigned char* lds = F.lds;
    const bf16* T = (const bf16*)(p.ws + WS_T); bf16* br = (bf16*)(p.ws + WS_BR); const float2* tw = (const float2*)(p.ws + WS_FTW);
    for (int idx = F.tid; idx < 128 * 16; idx += NTHR) { const int r = idx >> 4, ch = idx & 15; *(LAS u32x4*)(lds + FM_WA + r * FM_PITCH + ch * 16) = *(const u32x4*)((const bf16*)(p.ws + WS_FWA) + r * 128 + ch * 8); }
    for (int idx = F.tid; idx < 64 * 16; idx += NTHR) { const int r = idx >> 4, ch = idx & 15; *(LAS u32x4*)(lds + FM_WC + r * FM_PITCH + ch * 16) = *(const u32x4*)((const bf16*)(p.ws + WS_FWC) + r * 128 + ch * 8); }
    const int c = F.wave >> 1, h = F.wave & 1, l15 = F.lane & 15, kq = F.lane >> 4;
    LAS unsigned char* img = lds + FM_IMG + c * FM_IMGB;
    for (int u = F.vcu; u < 256; u += F.G) {
        const int batch = u >> 7, n0 = (u & 127) * 4;
        __syncthreads();
#pragma unroll
        for (int it = 0; it < 8; ++it) { const int cc = it >> 1, part = it & 1, a = F.lane, bg = F.wave;
            const u32x4 w = *(const u32x4*)(T + ((size_t)(batch * 512 + n0 + cc) * (2 * SEQ) + part * SEQ + 64 * a + 8 * bg));
            LAS bf16* d = (LAS bf16*)(lds + FM_IMG + cc * FM_IMGB + (8 * bg) * FM_PITCH + (part * 64 + a) * 2);
            const unsigned ww[4] = {w.x, w.y, w.z, w.w};
#pragma unroll
            for (int e = 0; e < 8; ++e) d[e * (FM_PITCH / 2)] = (bf16)((ww[e >> 1] >> ((e & 1) * 16)) & 0xffffu); }
        __syncthreads();
        f32x4 ya[4][4];
#pragma unroll
        for (int mi = 0; mi < 4; ++mi)
#pragma unroll
            for (int nt = 0; nt < 4; ++nt) ya[mi][nt] = (f32x4){0.f, 0.f, 0.f, 0.f};
#pragma unroll
        for (int ks = 0; ks < 4; ++ks) {
            bf16x8 af[4], bfr[4];
#pragma unroll
            for (int mi = 0; mi < 4; ++mi) { const int mt = (mi >> 1) * 4 + 2 * h + (mi & 1); af[mi] = *(const LAS bf16x8*)(lds + FM_WA + (16 * mt + l15) * FM_PITCH + (32 * ks + 8 * kq) * 2); }
#pragma unroll
            for (int nt = 0; nt < 4; ++nt) bfr[nt] = *(const LAS bf16x8*)(img + (16 * nt + l15) * FM_PITCH + (32 * ks + 8 * kq) * 2);
#pragma unroll
            for (int mi = 0; mi < 4; ++mi)
#pragma unroll
                for (int nt = 0; nt < 4; ++nt) ya[mi][nt] = __builtin_amdgcn_mfma_f32_16x16x32_bf16(af[mi], bfr[nt], ya[mi][nt], 0, 0, 0);
        }
        __syncthreads();
#pragma unroll
        for (int mi = 0; mi < 2; ++mi)
#pragma unroll
            for (int nt = 0; nt < 4; ++nt)
#pragma unroll
                for (int r = 0; r < 4; ++r) { const int ap = 16 * (2 * h + mi) + 4 * kq + r, b = 16 * nt + l15; const float2 cs = tw[ap * b];
                    const float yre = ya[mi][nt][r], yim = ya[2 + mi][nt][r];
                    LAS bf16* d = (LAS bf16*)(img + ap * FM_PITCH + b * 2);
                    d[0] = (bf16)f2bf(yre * cs.x + yim * cs.y); d[64] = (bf16)f2bf(yim * cs.x - yre * cs.y); }
        __syncthreads();
        f32x4 xa[2][4];
#pragma unroll
        for (int mi = 0; mi < 2; ++mi)
#pragma unroll
            for (int nt = 0; nt < 4; ++nt) xa[mi][nt] = (f32x4){0.f, 0.f, 0.f, 0.f};
#pragma unroll
        for (int ks = 0; ks < 4; ++ks) {
            bf16x8 af[2], bfr[4];
#pragma unroll
            for (int mi = 0; mi < 2; ++mi) af[mi] = *(const LAS bf16x8*)(img + (16 * (2 * h + mi) + l15) * FM_PITCH + (32 * ks + 8 * kq) * 2);
#pragma unroll
            for (int nt = 0; nt < 4; ++nt) bfr[nt] = *(const LAS bf16x8*)(lds + FM_WC + (16 * nt + l15) * FM_PITCH + (32 * ks + 8 * kq) * 2);
#pragma unroll
            for (int mi = 0; mi < 2; ++mi)
#pragma unroll
                for (int nt = 0; nt < 4; ++nt) xa[mi][nt] = __builtin_amdgcn_mfma_f32_16x16x32_bf16(af[mi], bfr[nt], xa[mi][nt], 0, 0, 0);
        }
        __syncthreads();
        LAS bf16* xs = (LAS bf16*)(lds + FM_IMG);
#pragma unroll
        for (int mi = 0; mi < 2; ++mi)
#pragma unroll
            for (int nt = 0; nt < 4; ++nt)
#pragma unroll
                for (int r = 0; r < 4; ++r) { const int ap = 16 * (2 * h + mi) + 4 * kq + r, bp = 16 * nt + l15; xs[(ap + 64 * bp) * 4 + c] = (bf16)f2bf(xa[mi][nt][r]); }
        __syncthreads();
#pragma unroll
        for (int it = 0; it < 8; ++it) { const int lp = F.tid + NTHR * it; *(u32x2*)(br + (size_t)(batch * SEQ + lp) * DM + n0) = *(const LAS u32x2*)(xs + lp * 4); }
    }
    __syncthreads();
}

constexpr int CG_STG = 32768, CG_B = 16384;
template <int MODE> __device__ __forceinline__ void ctx_gemm(const Params& p, const Ctx& F0, int layer) {
    const Ctx F = fresh(F0);
    const bf16* A; const bf16* Bt; int lda, K;
    if (MODE == 0) { A = (const bf16*)(p.ws + WS_BR); Bt = wl(p, layer, W_BM); lda = DM; K = DM; }
    else if (MODE == 1) { A = (const bf16*)(p.ws + WS_MRG); Bt = wl(p, layer, W_OUT); lda = DM; K = DM; }
    else if (MODE == 2) { A = (const bf16*)(p.ws + WS_ACT); Bt = wl(p, layer, W_DOWN); lda = DFF; K = DFF; }
    else { A = (const bf16*)(p.ws + WS_DC); Bt = (const bf16*)(p.ws + WS_TC); lda = 2 * CTXL; K = 2 * CTXL; }
    const int NU = MODE == 3 ? 64 : 256;
    const int ldb = lda, fr = F.lane & 15, fq = F.lane >> 4, nch = K / 128;
    LAS unsigned char* lds = F.lds;
    const int rb = F.wave >> 1, cb0 = 2 * (F.wave & 1);
    const int dr = 8 * F.wave + (F.lane >> 4), dp = F.lane & 15;
    for (int u = F.vcu; u < NU; u += F.G) {
        int row0 = ML + (u & 7) * 64, col0 = ((u >> 5) * 4 + ((u >> 3) & 3)) * 64;
        size_t arow = (size_t)row0, brow = (size_t)col0;
        if (MODE == 3) { const int b3 = u >> 5, rk = (u >> 3) & 3, ck = u & 7; row0 = ML + b3 * CTXL + rk * 64; col0 = ck * 64; arow = (size_t)rk * 64; brow = (size_t)b3 * 512 + ck * 64; }
        const bf16* ga0 = A + (size_t)(arow + dr) * lda + ((dp ^ (dr & 15)) << 3); const bf16* ga1 = A + (size_t)(arow + dr + 4) * lda + ((dp ^ ((dr + 4) & 15)) << 3);
        const bf16* gb0 = Bt + (size_t)(brow + dr) * ldb + ((dp ^ (dr & 15)) << 3); const bf16* gb1 = Bt + (size_t)(brow + dr + 4) * ldb + ((dp ^ ((dr + 4) & 15)) << 3);
#define CG_DMA(t) do { LAS unsigned char* d_ = lds + ((t) & 3) * CG_STG + F.wave * 2048; const int ko_ = (t) * 128; \
        __builtin_amdgcn_global_load_lds((const unsigned*)(ga0 + ko_), (LAS unsigned*)(d_), 16, 0, 0); __builtin_amdgcn_global_load_lds((const unsigned*)(ga1 + ko_), (LAS unsigned*)(d_ + 1024), 16, 0, 0); \
        __builtin_amdgcn_global_load_lds((const unsigned*)(gb0 + ko_), (LAS unsigned*)(d_ + CG_B), 16, 0, 0); __builtin_amdgcn_global_load_lds((const unsigned*)(gb1 + ko_), (LAS unsigned*)(d_ + CG_B + 1024), 16, 0, 0); } while (0)
        asm volatile("s_waitcnt vmcnt(0) lgkmcnt(0)\n\ts_barrier" ::: "memory");
        const int nsc = nch / 2;
        CG_DMA(0); CG_DMA(1);
        f32x4 acc[2] = {{0.f, 0.f, 0.f, 0.f}, {0.f, 0.f, 0.f, 0.f}}, tot[2] = {{0.f, 0.f, 0.f, 0.f}, {0.f, 0.f, 0.f, 0.f}};
        asm volatile("s_waitcnt vmcnt(0)\n\ts_barrier" ::: "memory");
        const int ao = (16 * rb + fr) * 256, bo = CG_B + (16 * cb0 + fr) * 256;
        for (int sc = 0; sc < nsc; ++sc) {
            if (sc + 1 < nsc) { CG_DMA(2 * sc + 2); CG_DMA(2 * sc + 3); }
#pragma unroll
            for (int hh = 0; hh < 2; ++hh) {
                const LAS unsigned char* sb = lds + ((2 * sc + hh) & 3) * CG_STG;
#pragma unroll
                for (int ks = 0; ks < 4; ++ks) { const int po = ((4 * ks + fq) ^ fr) << 4;
                    const bf16x8 af = *(const LAS bf16x8*)(sb + ao + po), b0 = *(const LAS bf16x8*)(sb + bo + po), b1 = *(const LAS bf16x8*)(sb + bo + 16 * 256 + po);
                    acc[0] = __builtin_amdgcn_mfma_f32_16x16x32_bf16(b0, af, acc[0], 0, 0, 0); acc[1] = __builtin_amdgcn_mfma_f32_16x16x32_bf16(b1, af, acc[1], 0, 0, 0); }
            }
            if (MODE == 0 && (sc == 1 || sc == 3 || sc == 7)) {
                const int goff = sc == 1 ? 0 : (sc == 3 ? DM : 2 * DM);
#pragma unroll
                for (int j = 0; j < 2; ++j) { const unsigned gw = *(const unsigned*)((const unsigned char*)(p.ws + WS_G8) + (size_t)(row0 + 16 * rb + fr) * NG8 + goff + col0 + 16 * (cb0 + j) + 4 * fq);
#pragma unroll
                    for (int i = 0; i < 4; ++i) { tot[j][i] += ((float)((gw >> (8 * i)) & 255u) * (1.0f / 255.0f)) * acc[j][i]; acc[j][i] = 0.f; } }
            }
            asm volatile("s_waitcnt vmcnt(0) lgkmcnt(0)\n\ts_barrier" ::: "memory");
        }
#undef CG_DMA
#pragma unroll
        for (int j = 0; j < 2; ++j) { const int row = row0 + 16 * rb + fr, col = col0 + 16 * (cb0 + j) + 4 * fq;
            if (MODE == 0) { u32x2 w; w.x = pk2(tot[j][0], tot[j][1]); w.y = pk2(tot[j][2], tot[j][3]); *(u32x2*)((bf16*)(p.ws + WS_MRG) + (size_t)row * DM + col) = w; }
            else if (MODE == 3) { u32x2 w; w.x = pk2(acc[j][0], acc[j][1]); w.y = pk2(acc[j][2], acc[j][3]); *(u32x2*)((bf16*)(p.ws + WS_BR) + (size_t)row * DM + col) = w; }
            else { const f32x4 gt = *(const f32x4*)((const float*)(p.ws + WS_MOD) + ((size_t)layer * 3 + 2) * NMOD + (MODE == 1 ? 2 * DM : 5 * DM) + col);
                bf16* hp = (bf16*)(p.ws + WS_H) + (size_t)row * DM + col;
                f32x4 sv;
                if (MODE == 1 && layer == 0) sv = *(const f32x4*)(p.in[I_CTX] + (size_t)(row - ML) * DM + col);
                else { const u32x2 hw = *(const u32x2*)hp; sv = (f32x4){bflo(hw.x), bfhi(hw.x), bflo(hw.y), bfhi(hw.y)}; }
                const f32x4 r = sv + gt * acc[j];
                u32x2 w; w.x = pk2(r[0], r[1]); w.y = pk2(r[2], r[3]); *(u32x2*)hp = w; } }
    }
    asm volatile("s_waitcnt vmcnt(0) lgkmcnt(0)" ::: "memory");
    __syncthreads();
}

constexpr int STEPS_PER_LAYER = 10, N_STEPS = 1 + DEPTH * STEPS_PER_LAYER + 1;
enum { SK_GEMM = 1, SK_ATTN = 2 };
struct Args { Params p; int lo, hi, li, skip; };
template <class E> __device__ __forceinline__ void run_gemm(const Ctx& F, const GemmJob& j, const E& e, int rot) {
    int c = (int)((blockIdx.x + (unsigned)rot) % (unsigned)F.G); asm volatile("" : "+s"(c));
    pg8::Sched S; S.init(j, F.G, c);
    int wv = F.wave; asm volatile("" : "+s"(wv));
    pg8::gemm_phase<E>(F.lds, j, S, e, wv);
}
__global__ void __launch_bounds__(NTHR, 2) mega(Args a) {
    extern __shared__ __attribute__((aligned(16))) unsigned char lds_raw[];
    Ctx F; F.lds = (LAS unsigned char*)lds_raw; F.tid = threadIdx.x; F.lane = F.tid & 63; F.wave = __builtin_amdgcn_readfirstlane(F.tid >> 6);
    F.G = gridDim.x; { const int bx = blockIdx.x; F.vcu = (F.G % 8 == 0) ? (bx % 8) * (F.G / 8) + bx / 8 : bx; }
    const Params& p = a.p;
    volatile LAS unsigned* MISC = (volatile LAS unsigned*)(F.lds + MISC_OFF);
    if (F.tid < 64) MISC[F.tid] = 0u;
    __syncthreads();
    XcdBarrier bar; bar.bar = (unsigned*)(p.ws + WS_CTL) + CW_BAR + a.li * 4096; bar.x = 0; bar.st = MISC + 8;
    if (a.hi - a.lo > 1) bar = xcd_barrier_post(bar.bar, MISC + 8);
    const int lo = a.lo, hi = a.hi;
    const bool do_gemm = !(a.skip & SK_GEMM), do_attn = !(a.skip & SK_ATTN);
#define IN(k) (lo <= (k) && (k) < hi)
#define SEAM(k) do { if (IN(k) && IN((k) + 1)) xcd_barrier(bar); } while (0)
#define REPEAT(k, body) do { _Pragma("nounroll") for (int r_ = 0; r_ < ((PROBE_STEP == (k)) ? 1 + PROBE_REP : 1); ++r_) { const bool first_ = (r_ == 0); (void)first_; body; if (r_ + 1 < ((PROBE_STEP == (k)) ? 1 + PROBE_REP : 1)) xcd_barrier(bar); } } while (0)
    if (IN(0)) REPEAT(10, { prologue(p, F); __syncthreads(); });
    SEAM(0);
    for (int l = 0; l < DEPTH; ++l) {
        const int s0 = 1 + l * STEPS_PER_LAYER;
        if (IN(s0 + 0)) REPEAT(0, norm_mod_phase(p, F, l, 0));
        SEAM(s0 + 0);
        if (IN(s0 + 1) && do_gemm) REPEAT(1, run_gemm(F, job_win(p, l), EWin{(bf16*)(p.ws + WS_P), (unsigned char*)(p.ws + WS_G8)}, 0));
        SEAM(s0 + 1);
        if (IN(s0 + 2)) REPEAT(2, {
            mixer_prep_phase(p, F, l); __syncthreads();
            if (do_gemm) { run_gemm(F, job_f1(p, false), epi_f1(p, false), 0); run_gemm(F, job_f1(p, true), epi_f1(p, true), F.G - 128); }
        });
        SEAM(s0 + 2);
        if (IN(s0 + 3)) {
#if MK_FFT
            REPEAT(30, { if (do_gemm) { fmix_phase(p, F); ctx_gemm<3>(p, F, l); } });
#else
            REPEAT(30, { if (do_gemm) { run_gemm(F, job_f2(p, false), epi_f2(p, false), 0); run_gemm(F, job_f2(p, true), epi_f2(p, true), F.G - 64); } });
#endif
            REPEAT(31, { if (do_attn) attn_phase(p, F, l); });
        }
        SEAM(s0 + 3);
        if (IN(s0 + 4) && do_gemm) REPEAT(4, { run_gemm(F, job_merge1(p, l), EMerge1{(const unsigned char*)(p.ws + WS_G8), (bf16*)(p.ws + WS_MRG)}, 0); if (l + 1 < DEPTH) ctx_gemm<0>(p, F, l); });
        SEAM(s0 + 4);
        if (IN(s0 + 5) && do_gemm) REPEAT(5, { if (first_) { run_gemm(F, job_out(p, l, ML), epi_resid(p, l, 0), 0); if (l + 1 < DEPTH) ctx_gemm<1>(p, F, l); } else run_gemm(F, job_out(p, l, ML), EStore{(bf16*)(p.ws + WS_MACC), DM, 0, 0}, 0); });
        SEAM(s0 + 5);
        if (IN(s0 + 6)) REPEAT(6, norm_mod_phase(p, F, l, 1));
        SEAM(s0 + 6);
#if MK_FUSE_ACT
        if (IN(s0 + 7) && do_gemm) REPEAT(7, run_gemm(F, job_up(p, l), EUpAct{(bf16*)(p.ws + WS_ACT), p.in[I_FCONVW] + (size_t)l * 3 * NUP, (float*)(p.ws + WS_HALO), (LAS float*)(F.lds + MISC_OFF + 1024)}, 0));
#else
        if (IN(s0 + 7) && do_gemm) REPEAT(7, run_gemm(F, job_up(p, l), epi_p(p), 0));
#endif
        SEAM(s0 + 7);
#if MK_FUSE_ACT
        if (IN(s0 + 8)) REPEAT(8, act_fix_phase(p, F, l));
#else
        if (IN(s0 + 8)) REPEAT(8, ffn_act_phase(p, F, l));
#endif
        SEAM(s0 + 8);
        if (IN(s0 + 9) && do_gemm) REPEAT(9, { if (first_) { run_gemm(F, job_down(p, l, ML), epi_resid(p, l, 1), 0); if (l + 1 < DEPTH) ctx_gemm<2>(p, F, l); } else run_gemm(F, job_down(p, l, ML), EStore{(bf16*)(p.ws + WS_MACC), DM, 0, 0}, 0); });
        SEAM(s0 + 9);
    }
    if (IN(N_STEPS - 1)) final_norm_phase(p, F);
#undef REPEAT
#undef IN
#undef SEAM
}

extern "C" void kernel_launch(void* const* d_in, const int* in_sizes, int n_in, void* d_out, int out_size, void* d_ws, size_t ws_size, hipStream_t stream) {
    static int grid = 0;
    if (grid == 0) {
        if (n_in != 20 || out_size != ML * DM || ws_size < WS_END) { fprintf(stderr, "kernel_launch: unexpected shapes (n_in %d out %d ws %zu)\n", n_in, out_size, ws_size); grid = -1; return; }
        int dev = 0, cus = 0, per_cu = 0;
        if (hipGetDevice(&dev) != hipSuccess || hipDeviceGetAttribute(&cus, hipDeviceAttributeMultiprocessorCount, dev) != hipSuccess) { grid = -1; return; }
        if (hipFuncSetAttribute((const void*)mega, hipFuncAttributeMaxDynamicSharedMemorySize, LDS_BYTES) != hipSuccess) { fprintf(stderr, "kernel_launch: hipFuncSetAttribute failed\n"); grid = -1; return; }
        if (hipOccupancyMaxActiveBlocksPerMultiprocessor(&per_cu, (const void*)mega, NTHR, LDS_BYTES) != hipSuccess || per_cu < 1) fprintf(stderr, "kernel_launch: occupancy query says %d\n", per_cu);
        (void)hipGetLastError();
        grid = cus;
    }
    if (grid < 0) return;
    (void)hipMemsetAsync((char*)d_ws + WS_CTL, 0, CTL_BYTES, stream);
    Args a{};
    for (int i = 0; i < 20; ++i) a.p.in[i] = (const float*)d_in[i];
    a.p.out = (float*)d_out; a.p.ws = (unsigned char*)d_ws;
    const Params& p = a.p;
#if MK_ONE_LAUNCH
    a.lo = 0; a.hi = N_STEPS; a.li = 0; a.skip = 0;
    hipLaunchKernelGGL(mega, dim3(grid), dim3(NTHR), LDS_BYTES, stream, a);
#else
    a.skip = (MK_SIMPLE_GEMM ? SK_GEMM : 0) | (MK_SIMPLE_ATTN ? SK_ATTN : 0);
    int li = 0;
    for (int s = 0; s < N_STEPS; ++s) {
        a.lo = s; a.hi = s + 1; a.li = li++;
        const int l = (s - 1) / STEPS_PER_LAYER, k = (s - 1) % STEPS_PER_LAYER;
        const bool layer_step = s >= 1 && s < N_STEPS - 1;
        const bool pure_gemm = layer_step && (k == 1 || k == 4 || k == 5 || k == 7 || k == 9);
        if (!(pure_gemm && MK_SIMPLE_GEMM)) hipLaunchKernelGGL(mega, dim3(grid), dim3(NTHR), LDS_BYTES, stream, a);
        if (!layer_step) continue;
        if (MK_SIMPLE_GEMM) {
            if (k == 1) launch_sgemm(job_win(p, l), epi_p(p), stream);
            if (k == 2) { launch_sgemm(job_f1(p, false), epi_f1(p, false), stream); launch_sgemm(job_f1(p, true), epi_f1(p, true), stream); }
            if (k == 3) { launch_sgemm(job_f2(p, false), epi_f2(p, false), stream); launch_sgemm(job_f2(p, true), epi_f2(p, true), stream); }
            if (k == 4) for (int pass = 0; pass < 3; ++pass) launch_sgemm(job_merge(p, l, pass), epi_merge(p, pass), stream);
            if (k == 5) launch_sgemm(job_out(p, l), epi_resid(p, l, 0), stream);
            if (k == 7) launch_sgemm(job_up(p, l), epi_p(p), stream);
            if (k == 9) launch_sgemm(job_down(p, l), epi_resid(p, l, 1), stream);
        }
        if (MK_SIMPLE_ATTN && k == 3) hipLaunchKernelGGL(k_sattn, dim3(MROWS * NH), dim3(64), 0, stream, p, l);
    }
#endif
}
```

```cpp
#include <hip/hip_runtime.h>
#include <cstdio>
#include <cstdint>

#ifndef MK_ONE_LAUNCH
#define MK_ONE_LAUNCH 1
#endif
#ifndef MK_SIMPLE_GEMM
#define MK_SIMPLE_GEMM 0
#endif
#ifndef MK_FUSE_ACT
#define MK_FUSE_ACT (!MK_SIMPLE_GEMM)
#endif
#ifndef MK_FFT
#define MK_FFT (!MK_SIMPLE_GEMM)
#endif
#ifndef PROBE_STEP
#define PROBE_STEP (-1)
#endif
#ifndef PROBE_REP
#define PROBE_REP 1
#endif
#ifndef MK_SIMPLE_ATTN
#define MK_SIMPLE_ATTN 0
#endif

#define LAS __attribute__((address_space(3)))
#define GAS __attribute__((address_space(1)))
typedef unsigned short bf16;
typedef short bf16x8 __attribute__((ext_vector_type(8)));
typedef float f32x4 __attribute__((ext_vector_type(4)));
typedef float f32x16 __attribute__((ext_vector_type(16)));
typedef unsigned u32x4 __attribute__((ext_vector_type(4)));
typedef unsigned u32x2 __attribute__((ext_vector_type(2)));

constexpr int DM = 2048, NBATCH = 2, SEQ = 4096, CTXL = 256, DEPTH = 4;
constexpr int ML = NBATCH * SEQ, MC = NBATCH * CTXL, MROWS = ML + MC;
constexpr int NIN = 11264, DFF = 5632, NUP = 2 * DFF, NMOD = 6 * DM;
constexpr int CB_OFF = 512, CC_OFF = 1024, CX_OFF = 1536, Q_OFF = 2048, K_OFF = 3072, V_OFF = 4096, GF_OFF = 5120, GC_OFF = 7168, GA_OFF = 9216;
constexpr int NH = 8, HD = 64, VD = 128, QKW = 1024, LK = CTXL + SEQ;
constexpr float QSCALE = 0.125f * 1.4426950408889634f;
constexpr float EPS_RMS = 1e-6f, EPS_SUBLN = 1e-5f;

constexpr size_t MiB = 1u << 20;
constexpr size_t WS_CTL = 0, CTL_BYTES = 4 * MiB;
constexpr size_t WS_MOD = 4 * MiB;
constexpr size_t WS_LAM = 5 * MiB;
constexpr size_t WS_ROPE = WS_LAM + 256;
constexpr size_t WS_CS128 = WS_LAM + 65536;
constexpr size_t WS_DC = WS_CS128 + 131072;
constexpr size_t WS_FWA = WS_DC + 262144;
constexpr size_t WS_FWC = WS_FWA + 32768;
constexpr size_t WS_FTW = WS_FWC + 16384;
constexpr size_t WS_DL = 6 * MiB;
constexpr size_t WS_G8 = WS_DL;
constexpr int NG8 = 3 * DM;
constexpr size_t WS_H = 70 * MiB;
constexpr size_t WS_XN = 138 * MiB;
constexpr size_t WS_P = 172 * MiB;
constexpr size_t WS_QR = 359 * MiB;
constexpr size_t WS_KC = 376 * MiB;
constexpr size_t WS_VT = 393 * MiB;
constexpr size_t WS_T = 410 * MiB;
constexpr size_t WS_TC = 426 * MiB;
constexpr size_t WS_BR = 427 * MiB;
constexpr size_t WS_MACC = 461 * MiB;
constexpr size_t WS_HALO = 501 * MiB;
constexpr size_t WS_MRG = 529 * MiB;
constexpr size_t WS_ACT = 563 * MiB;
constexpr size_t WS_W = 657 * MiB;
constexpr size_t W_IN = 0, W_BM = 44 * MiB, W_OUT = 52 * MiB, W_UP = 60 * MiB, W_DOWN = 104 * MiB, W_LAYER = 126 * MiB;
constexpr size_t WS_END = WS_W + 4 * W_LAYER;

struct Params { const float* in[20]; float* out; unsigned char* ws; };
enum { I_X = 0, I_C, I_CTX, I_CCTX, I_WMOD, I_BMOD, I_G1, I_G2, I_WIN, I_CONVW, I_LAMB, I_SUBG, I_WBF, I_WBC, I_WBA, I_WOUT, I_WUP, I_FCONVW, I_WDOWN, I_GFIN };

__host__ __device__ __forceinline__ unsigned f2bf(float f) { unsigned u = __builtin_bit_cast(unsigned, f); return (u + 0x7fffu + ((u >> 16) & 1u)) >> 16; }
typedef float f32x2_t __attribute__((ext_vector_type(2))); typedef __bf16 bf16x2_t __attribute__((ext_vector_type(2)));
__device__ __forceinline__ unsigned pk2(float lo, float hi) { f32x2_t v = {lo, hi}; bf16x2_t b = __builtin_convertvector(v, bf16x2_t); return __builtin_bit_cast(unsigned, b); }
__device__ __forceinline__ float bflo(unsigned w) { return __uint_as_float(w << 16); }
__device__ __forceinline__ float bfhi(unsigned w) { return __uint_as_float(w & 0xffff0000u); }
__device__ __forceinline__ void unpack8(const u32x4 w, float* f) { f[0] = bflo(w.x); f[1] = bfhi(w.x); f[2] = bflo(w.y); f[3] = bfhi(w.y); f[4] = bflo(w.z); f[5] = bfhi(w.z); f[6] = bflo(w.w); f[7] = bfhi(w.w); }
__device__ __forceinline__ u32x4 pack8(const float* f) { u32x4 w; w.x = pk2(f[0], f[1]); w.y = pk2(f[2], f[3]); w.z = pk2(f[4], f[5]); w.w = pk2(f[6], f[7]); return w; }
#define DPP_ADD(v, ctrl) v += __builtin_bit_cast(float, __builtin_amdgcn_mov_dpp(__builtin_bit_cast(int, v), ctrl, 0xf, 0xf, true))
__device__ __forceinline__ float wave_sum(float v) {
    DPP_ADD(v, 0xB1); DPP_ADD(v, 0x4E); DPP_ADD(v, 0x141); DPP_ADD(v, 0x140);
    { auto rr = __builtin_amdgcn_permlane16_swap(__float_as_uint(v), __float_as_uint(v), false, false); v = __uint_as_float(rr[0]) + __uint_as_float(rr[1]); }
    { auto rr = __builtin_amdgcn_permlane32_swap(__float_as_uint(v), __float_as_uint(v), false, false); v = __uint_as_float(rr[0]) + __uint_as_float(rr[1]); }
    return v;
}
__device__ __forceinline__ float wave_max(float v) {
#pragma unroll
    for (int o = 1; o < 64; o <<= 1) v = fmaxf(v, __shfl_xor(v, o));
    return v;
}
__device__ __forceinline__ float sigmoidf_(float x) { return 1.0f / (1.0f + __expf(-x)); }
__device__ __forceinline__ int lane_id_opaque() { unsigned m = ~0u; asm volatile("" : "+s"(m)); return (int)__builtin_amdgcn_mbcnt_hi(m, __builtin_amdgcn_mbcnt_lo(m, 0u)); }
struct RowInfo { int b, pos, L, mrow, kv; bool ctx; };
__host__ __device__ __forceinline__ RowInfo row_info(int row) {
    RowInfo r;
    if (row < ML) { r.b = row >> 12; r.pos = row & (SEQ - 1); r.L = SEQ; r.mrow = r.b; r.kv = CTXL + r.pos; r.ctx = false; }
    else { const int rr = row - ML; r.b = rr >> 8; r.pos = rr & (CTXL - 1); r.L = CTXL; r.mrow = 2; r.kv = r.pos; r.ctx = true; }
    return r;
}

struct GemmJob { const bf16* A; const bf16* Bt; int lda, ldb, M, N, K, Z, zdiv, pad; long sA1, sA2, sB1, sB2; };
__host__ __device__ __forceinline__ long job_aoff(const GemmJob& j, int z) { return (long)(z / j.zdiv) * j.sA1 + (long)(z % j.zdiv) * j.sA2; }
__host__ __device__ __forceinline__ long job_boff(const GemmJob& j, int z) { return (long)(z / j.zdiv) * j.sB1 + (long)(z % j.zdiv) * j.sB2; }

struct EStore {
    static constexpr bool HAS_MID = false, WHOLE = false, PERM = true;
    bf16* C; int ldc, pad; long sC;
    __device__ __forceinline__ void apply8(int z, int row, int col, f32x4 v0, f32x4 v1) const {
        u32x4 w; w.x = pk2(v0[0], v0[1]); w.y = pk2(v0[2], v0[3]); w.z = pk2(v1[0], v1[1]); w.w = pk2(v1[2], v1[3]);
        *(u32x4*)(C + (size_t)z * sC + (size_t)row * ldc + col) = w;
    }
};
struct ETr {
    static constexpr bool HAS_MID = false, WHOLE = false, PERM = true;
    bf16* T; int L, pad;
    __device__ __forceinline__ void apply8(int z, int row, int col, f32x4 v0, f32x4 v1) const {
        u32x4 w; w.x = pk2(v0[0], v0[1]); w.y = pk2(v0[2], v0[3]); w.z = pk2(v1[0], v1[1]); w.w = pk2(v1[2], v1[3]);
        const int b = z >> 2, g = z & 3;
        *(u32x4*)(T + ((size_t)(b * 512 + g * 128 + (row & 127)) * (size_t)(2 * L) + (size_t)(row >> 7) * L + col)) = w;
    }
};
struct EMerge {
    static constexpr bool HAS_MID = false, WHOLE = false, PERM = true;
    const bf16* P; float* macc; bf16* mrg; int goff, pass;
    __device__ __forceinline__ void apply8(int, int row, int col, f32x4 v0, f32x4 v1) const {
        const u32x4 gw = *(const u32x4*)(P + (size_t)row * NIN + goff + col);
        float g[8]; unpack8(gw, g);
        float v[8] = {v0[0], v0[1], v0[2], v0[3], v1[0], v1[1], v1[2], v1[3]};
        float* mp = macc + (size_t)row * DM + col;
        if (pass > 0) { const f32x4 a = *(const f32x4*)mp, b = *(const f32x4*)(mp + 4);
#pragma unroll
            for (int i = 0; i < 4; ++i) { v[i] = sigmoidf_(g[i]) * v[i] + a[i]; v[4 + i] = sigmoidf_(g[4 + i]) * v[4 + i] + b[i]; } }
        else {
#pragma unroll
            for (int i = 0; i < 8; ++i) v[i] = sigmoidf_(g[i]) * v[i]; }
        if (pass < 2) { *(f32x4*)mp = (f32x4){v[0], v[1], v[2], v[3]}; *(f32x4*)(mp + 4) = (f32x4){v[4], v[5], v[6], v[7]}; }
        else *(u32x4*)(mrg + (size_t)row * DM + col) = pack8(v);
    }
};
struct EMerge1 {
    static constexpr bool HAS_MID = true, WHOLE = false, PERM = true; static constexpr int MID0 = 512 / 64, MID1 = 1024 / 64;
    const unsigned char* g8; bf16* mrg;
    __device__ __forceinline__ void mid8(int seg, int row, int col, f32x4& v0, f32x4& v1) const {
        const unsigned char* gp = g8 + (size_t)row * NG8 + col + (seg == 0 ? 0 : DM);
        const u32x2 qa = *(const u32x2*)gp, qb = *(const u32x2*)(gp + DM);
#pragma unroll
        for (int i = 0; i < 8; ++i) { const unsigned wa = i < 4 ? qa.x : qa.y, wb = i < 4 ? qb.x : qb.y;
            const float r = (float)((wa >> (8 * (i & 3))) & 255u) * __builtin_amdgcn_rcpf((float)((wb >> (8 * (i & 3))) & 255u));
            if (i < 4) v0[i] *= r; else v1[i - 4] *= r; }
    }
    __device__ __forceinline__ void apply8(int, int row, int col, f32x4 v0, f32x4 v1) const {
        const u32x2 q = *(const u32x2*)(g8 + (size_t)row * NG8 + 2 * DM + col);
        float v[8];
#pragma unroll
        for (int i = 0; i < 8; ++i) { const unsigned w = i < 4 ? q.x : q.y; v[i] = (i < 4 ? v0[i] : v1[i - 4]) * ((float)((w >> (8 * (i & 3))) & 255u) * (1.0f / 255.0f)); }
        *(u32x4*)(mrg + (size_t)row * DM + col) = pack8(v);
    }
};
struct EWin {
    static constexpr bool HAS_MID = false, WHOLE = false, PERM = true;
    bf16* P; unsigned char* g8;
    __device__ __forceinline__ void apply8(int, int row, int col, f32x4 v0, f32x4 v1) const {
        if (col < GF_OFF) { u32x4 w; w.x = pk2(v0[0], v0[1]); w.y = pk2(v0[2], v0[3]); w.z = pk2(v1[0], v1[1]); w.w = pk2(v1[2], v1[3]); *(u32x4*)(P + (size_t)row * NIN + col) = w; }
        else {
            unsigned q[8];
#pragma unroll
            for (int i = 0; i < 8; ++i) { const float g = i < 4 ? v0[i] : v1[i - 4]; q[i] = (unsigned)fminf(fmaxf(255.0f * __builtin_amdgcn_rcpf(1.0f + __expf(-g)) + 0.5f, 1.0f), 255.0f); }
            u32x2 w; w.x = q[0] | (q[1] << 8) | (q[2] << 16) | (q[3] << 24); w.y = q[4] | (q[5] << 8) | (q[6] << 16) | (q[7] << 24);
            *(u32x2*)(g8 + (size_t)row * NG8 + (col - GF_OFF)) = w; }
    }
};
struct EResid {
    static constexpr bool HAS_MID = false, WHOLE = false, PERM = true;
    bf16* h; const float* modl; const float* xin; const float* cin; int goff, pad;
    __device__ __forceinline__ void apply8(int, int row, int col, f32x4 v0, f32x4 v1) const {
        const RowInfo ri = row_info(row);
        const float* gp = modl + (size_t)ri.mrow * NMOD + goff + col;
        const f32x4 g0 = *(const f32x4*)gp, g1 = *(const f32x4*)(gp + 4);
        bf16* hp = h + (size_t)row * DM + col;
        float a[8];
        if (xin) { const float* sp = row < ML ? xin + (size_t)row * DM + col : cin + (size_t)(row - ML) * DM + col; const f32x4 s0 = *(const f32x4*)sp, s1 = *(const f32x4*)(sp + 4);
#pragma unroll
            for (int i = 0; i < 4; ++i) { a[i] = s0[i]; a[4 + i] = s1[i]; } }
        else unpack8(*(const u32x4*)hp, a);
#pragma unroll
        for (int i = 0; i < 4; ++i) { a[i] += g0[i] * v0[i]; a[4 + i] += g1[i] * v1[i]; }
        *(u32x4*)hp = pack8(a);
    }
};

__device__ __forceinline__ float dpp_shr1(float oldv, float src) { return __builtin_bit_cast(float, __builtin_amdgcn_update_dpp(__builtin_bit_cast(int, oldv), __builtin_bit_cast(int, src), 0x111, 0xf, 0xf, false)); }
__device__ __forceinline__ float dpp_shl1(float oldv, float src) { return __builtin_bit_cast(float, __builtin_amdgcn_update_dpp(__builtin_bit_cast(int, oldv), __builtin_bit_cast(int, src), 0x101, 0xf, 0xf, false)); }
__device__ __forceinline__ float dpp_ror1(float src) { return __builtin_bit_cast(float, __builtin_amdgcn_mov_dpp(__builtin_bit_cast(int, src), 0x121, 0xf, 0xf, true)); }
__device__ __forceinline__ float dpp_ror15(float src) { return __builtin_bit_cast(float, __builtin_amdgcn_mov_dpp(__builtin_bit_cast(int, src), 0x12F, 0xf, 0xf, true)); }
struct EUpAct {
    static constexpr bool HAS_MID = false, WHOLE = true, PERM = true;
    bf16* act; const float* cw; float* halo; LAS float* edge;
    __device__ __forceinline__ void whole(const f32x4 (&acc)[2][2][4][2], int pm, int pn, int wr, int wc, int, int) const {
        const int ln_ = lane_id_opaque(), fr = ln_ & 15, fq = ln_ >> 4;
        int cb = 32 * wc + 8 * fq; asm volatile("" : "+v"(cb));
#pragma unroll
        for (int ai = 0; ai < 2; ++ai) { const int g = 2 * ai + wr;
#pragma unroll
            for (int bj = 0; bj < 2; ++bj)
#pragma unroll
                for (int n = 0; n < 2; ++n) {
                    if (fr == 0) *(LAS f32x4*)(edge + (g * 2 + 0) * 256 + 128 * bj + cb + 4 * n) = acc[ai][bj][0][n];
                    if (fr == 15) *(LAS f32x4*)(edge + (g * 2 + 1) * 256 + 128 * bj + cb + 4 * n) = acc[ai][bj][3][n]; } }
        LAS float* cwl = edge + 2048;
        { const int tid_ = (wr * 4 + wc) * 64 + ln_;
#pragma unroll
          for (int q = 0; q < 2; ++q) { const int idx = tid_ + 512 * q; if (idx < 768) { const int t = idx >> 8, c = idx & 255; cwl[idx] = cw[(size_t)t * NUP + (c >> 7) * DFF + 128 * pn + (c & 127)]; } } }
        asm volatile("s_waitcnt lgkmcnt(0)\n\ts_barrier" ::: "memory");
        const bool seq_first = pm >= 32 || (pm & 15) == 0, seq_last = pm >= 32 || (pm & 15) == 15;
        const int j0 = 128 * pn + cb;
        LAS float* uh = edge + 2048 + 768;
#pragma unroll
        for (int ai = 0; ai < 2; ++ai) { const int g = 2 * ai + wr; unsigned opk[4][2];
#pragma unroll
            for (int n = 0; n < 2; ++n) {
                asm volatile("" ::: "memory");
                f32x4 w[2][3];
#pragma unroll
                for (int bj = 0; bj < 2; ++bj)
#pragma unroll
                    for (int t = 0; t < 3; ++t) w[bj][t] = *(const LAS f32x4*)(cwl + t * 256 + bj * 128 + cb + 4 * n);
                float o[4][4];
#pragma unroll
                for (int e = 0; e < 4; ++e) {
                    float u[2][4];
#pragma unroll
                    for (int bj = 0; bj < 2; ++bj) {
                        float x0 = acc[ai][bj][0][n][e], x1 = acc[ai][bj][1][n][e], x2 = acc[ai][bj][2][n][e], x3 = acc[ai][bj][3][n][e];
                        asm volatile("" : "+v"(x0), "+v"(x1), "+v"(x2), "+v"(x3));
                        const float epv = g > 0 ? edge[((g - 1) * 2 + 1) * 256 + 128 * bj + cb + 4 * n + e] : 0.f, env = g < 3 ? edge[((g + 1) * 2 + 0) * 256 + 128 * bj + cb + 4 * n + e] : 0.f;
                        const float p0 = dpp_shr1(epv, x0), p1 = dpp_shr1(dpp_ror1(x0), x1), p2 = dpp_shr1(dpp_ror1(x1), x2), p3 = dpp_shr1(dpp_ror1(x2), x3);
                        const float q0 = dpp_shl1(dpp_ror15(x1), x0), q1 = dpp_shl1(dpp_ror15(x2), x1), q2 = dpp_shl1(dpp_ror15(x3), x2), q3 = dpp_shl1(env, x3);
                        const float w0 = w[bj][0][e], w1 = w[bj][1][e], w2 = w[bj][2][e];
                        u[bj][0] = w0 * p0 + w1 * x0 + w2 * q0; u[bj][1] = w0 * p1 + w1 * x1 + w2 * q1; u[bj][2] = w0 * p2 + w1 * x2 + w2 * q2; u[bj][3] = w0 * p3 + w1 * x3 + w2 * q3;
                        { const bool tgt_ = ai == 0 ? (wr == 0 && fr == 0) : (wr == 1 && fr == 15);
                          uh[tgt_ ? (ai == 0 ? 0 : 256) + 128 * bj + cb + 4 * n + e : 512 + ln_] = ai == 0 ? u[bj][0] : u[bj][3]; }
                        asm volatile("" : "+v"(u[bj][0]), "+v"(u[bj][1]), "+v"(u[bj][2]), "+v"(u[bj][3]));
                    }
#pragma unroll
                    for (int m = 0; m < 4; ++m) { const float a = u[0][m]; o[m][e] = a * __builtin_amdgcn_rcpf(1.0f + __expf(-a)) * u[1][m]; }
                    asm volatile("" : "+v"(o[0][e]), "+v"(o[1][e]), "+v"(o[2][e]), "+v"(o[3][e]));
                }
                if (n == 0) {
#pragma unroll
                    for (int m = 0; m < 4; ++m) { opk[m][0] = pk2(o[m][0], o[m][1]); opk[m][1] = pk2(o[m][2], o[m][3]); }
                } else {
#pragma unroll
                    for (int m = 0; m < 4; ++m) { u32x4 pw; pw.x = opk[m][0]; pw.y = opk[m][1]; pw.z = pk2(o[m][0], o[m][1]); pw.w = pk2(o[m][2], o[m][3]); *(u32x4*)(act + (size_t)(pm * 256 + ai * 128 + wr * 64 + m * 16 + fr) * DFF + j0) = pw; }
                }
            }
        }
        asm volatile("s_waitcnt lgkmcnt(0)\n\ts_barrier" ::: "memory");
        { const int tid_ = (wr * 4 + wc) * 64 + ln_, k = tid_ >> 7, c = tid_ & 127;
          if ((k & 1) ? !seq_last : !seq_first) {
              const LAS float* src = k == 0 ? edge : (k == 1 ? edge + 7 * 256 : (k == 2 ? uh : uh + 256));
              float* hg = halo + (size_t)pm * 8 * DFF + (size_t)(k * 2) * DFF + 128 * pn + c;
              hg[0] = src[c]; hg[DFF] = src[128 + c]; } }
    }
};
__host__ __device__ __forceinline__ const bf16* wl(const Params& p, int layer, size_t off) { return (const bf16*)(p.ws + WS_W + (size_t)layer * W_LAYER + off); }
__host__ __device__ __forceinline__ GemmJob job_win(const Params& p, int l) { return GemmJob{(const bf16*)(p.ws + WS_XN), wl(p, l, W_IN), DM, DM, MROWS, NIN, DM, 1, 1, 0, 0, 0, 0, 0}; }
__host__ __device__ __forceinline__ GemmJob job_up(const Params& p, int l) { return GemmJob{(const bf16*)(p.ws + WS_XN), wl(p, l, W_UP), DM, DM, (l + 1 < DEPTH || MK_SIMPLE_GEMM) ? MROWS : ML, NUP, DM, 1, 1, 0, 0, 0, 0, 0}; }
__host__ __device__ __forceinline__ GemmJob job_out(const Params& p, int l, int M = MROWS) { return GemmJob{(const bf16*)(p.ws + WS_MRG), wl(p, l, W_OUT), DM, DM, M, DM, DM, 1, 1, 0, 0, 0, 0, 0}; }
__host__ __device__ __forceinline__ GemmJob job_down(const Params& p, int l, int M = MROWS) { return GemmJob{(const bf16*)(p.ws + WS_ACT), wl(p, l, W_DOWN), DFF, DFF, M, DM, DFF, 1, 1, 0, 0, 0, 0, 0}; }
__host__ __device__ __forceinline__ GemmJob job_merge1(const Params& p, int l) { return GemmJob{(const bf16*)(p.ws + WS_BR), wl(p, l, W_BM), DM, DM, ML, DM, DM, 1, 1, 0, 0, 0, 0, 0}; }
__host__ __device__ __forceinline__ GemmJob job_merge(const Params& p, int l, int pass) {
    const int koff = pass == 0 ? 0 : (pass == 1 ? 512 : 1024), K = pass == 2 ? 1024 : 512;
    return GemmJob{(const bf16*)(p.ws + WS_BR) + koff, wl(p, l, W_BM) + koff, DM, DM, MROWS, DM, K, 1, 1, 0, 0, 0, 0, 0};
}
__host__ __device__ __forceinline__ GemmJob job_f1(const Params& p, bool ctx) {
    const bf16* P = (const bf16*)(p.ws + WS_P);
    if (!ctx) return GemmJob{(const bf16*)(p.ws + WS_CS128), P, 256, NIN, 256, SEQ, 256, 8, 4, 0, 0, 0, (long)SEQ * NIN, 128};
    return GemmJob{(const bf16*)(p.ws + WS_CS128), P + (size_t)ML * NIN, 256, NIN, 256, CTXL, 256, 8, 4, 0, 0, 0, (long)CTXL * NIN, 128};
}
__host__ __device__ __forceinline__ GemmJob job_f2(const Params& p, bool ctx) {
    if (!ctx) return GemmJob{(const bf16*)(p.ws + WS_DL), (const bf16*)(p.ws + WS_T), 2 * SEQ, 2 * SEQ, SEQ, 512, 2 * SEQ, 2, 1, 0, 0, 0, (long)512 * 2 * SEQ, 0};
    return GemmJob{(const bf16*)(p.ws + WS_DC), (const bf16*)(p.ws + WS_TC), 2 * CTXL, 2 * CTXL, CTXL, 512, 2 * CTXL, 2, 1, 0, 0, 0, (long)512 * 2 * CTXL, 0};
}
__host__ __device__ __forceinline__ EStore epi_p(const Params& p) { return EStore{(bf16*)(p.ws + WS_P), NIN, 0, 0}; }
__host__ __device__ __forceinline__ EStore epi_f2(const Params& p, bool ctx) {
    if (!ctx) return EStore{(bf16*)(p.ws + WS_BR), DM, 0, (long)SEQ * DM};
    return EStore{(bf16*)(p.ws + WS_BR) + (size_t)ML * DM, DM, 0, (long)CTXL * DM};
}
__host__ __device__ __forceinline__ ETr epi_f1(const Params& p, bool ctx) { return ctx ? ETr{(bf16*)(p.ws + WS_TC), CTXL, 0} : ETr{(bf16*)(p.ws + WS_T), SEQ, 0}; }
__host__ __device__ __forceinline__ EMerge epi_merge(const Params& p, int pass) {
    return EMerge{(const bf16*)(p.ws + WS_P), (float*)(p.ws + WS_MACC), (bf16*)(p.ws + WS_MRG), pass == 0 ? GF_OFF : (pass == 1 ? GC_OFF : GA_OFF), pass};
}
__host__ __device__ __forceinline__ EResid epi_resid(const Params& p, int l, int which) {
    const bool first = (l == 0 && which == 0);
    return EResid{(bf16*)(p.ws + WS_H), (const float*)(p.ws + WS_MOD) + (size_t)l * 3 * NMOD, first ? p.in[I_X] : nullptr, first ? p.in[I_CTX] : nullptr, which == 0 ? 2 * DM : 5 * DM, 0};
}

template <class E> __global__ void __launch_bounds__(256) k_sgemm(GemmJob j, E e) {
    __shared__ float As[32][65], Bs[32][65];
    const int z = blockIdx.z, m0 = blockIdx.y * 64, n0 = blockIdx.x * 64, tid = threadIdx.x;
    const bf16* A = j.A + job_aoff(j, z); const bf16* Bt = j.Bt + job_boff(j, z);
    const int lr = tid >> 2, lc = (tid & 3) * 8, ty = tid >> 3, tx = tid & 7;
    float acc[2][8];
#pragma unroll
    for (int a = 0; a < 2; ++a)
#pragma unroll
        for (int b = 0; b < 8; ++b) acc[a][b] = 0.f;
    for (int k0 = 0; k0 < j.K; k0 += 32) {
        const u32x4 aw = *(const u32x4*)(A + (size_t)(m0 + lr) * j.lda + k0 + lc);
        const u32x4 bw = *(const u32x4*)(Bt + (size_t)(n0 + lr) * j.ldb + k0 + lc);
        float af[8], bf[8]; unpack8(aw, af); unpack8(bw, bf);
        __syncthreads();
#pragma unroll
        for (int i = 0; i < 8; ++i) { As[lc + i][lr] = af[i]; Bs[lc + i][lr] = bf[i]; }
        __syncthreads();
#pragma unroll 8
        for (int kk = 0; kk < 32; ++kk) {
            const float a0 = As[kk][2 * ty], a1 = As[kk][2 * ty + 1];
#pragma unroll
            for (int b = 0; b < 8; ++b) { const float bv = Bs[kk][8 * tx + b]; acc[0][b] += a0 * bv; acc[1][b] += a1 * bv; }
        }
    }
#pragma unroll
    for (int a = 0; a < 2; ++a)
        e.apply8(z, m0 + 2 * ty + a, n0 + 8 * tx, (f32x4){acc[a][0], acc[a][1], acc[a][2], acc[a][3]}, (f32x4){acc[a][4], acc[a][5], acc[a][6], acc[a][7]});
}
template <class E> static void launch_sgemm(const GemmJob& j, const E& e, hipStream_t st) {
    hipLaunchKernelGGL((k_sgemm<E>), dim3(j.N / 64, j.M / 64, j.Z), dim3(256), 0, st, j, e);
}

__global__ void __launch_bounds__(64) k_sattn(Params p, int layer) {
    __shared__ float S0[LK], S1[LK], q[128];
    const int row = blockIdx.x >> 3, h = blockIdx.x & 7, lane = threadIdx.x;
    const RowInfo ri = row_info(row);
    const int nk = ri.ctx ? CTXL : LK;
    const bf16* Qr = (const bf16*)(p.ws + WS_QR); const bf16* Kc = (const bf16*)(p.ws + WS_KC); const bf16* Vt = (const bf16*)(p.ws + WS_VT);
    bf16* br = (bf16*)(p.ws + WS_BR);
    const float lam = ((const float*)(p.ws + WS_LAM))[layer];
    const float lam_init = 0.8f - 0.6f * expf(-0.3f * (float)layer);
    q[lane] = __uint_as_float(((unsigned)Qr[(size_t)row * QKW + h * 128 + lane]) << 16);
    q[64 + lane] = __uint_as_float(((unsigned)Qr[(size_t)row * QKW + h * 128 + 64 + lane]) << 16);
    __syncthreads();
    float m0 = -1e30f, m1 = -1e30f;
    for (int j = lane; j < nk; j += 64) {
        const bf16* kp = Kc + ((size_t)(ri.b * LK + j) * QKW + h * 128);
        float s0 = 0.f, s1 = 0.f;
#pragma unroll
        for (int c = 0; c < 8; ++c) { float f[8]; unpack8(*(const u32x4*)(kp + c * 8), f);
#pragma unroll
            for (int i = 0; i < 8; ++i) s0 += q[c * 8 + i] * f[i]; }
#pragma unroll
        for (int c = 0; c < 8; ++c) { float f[8]; unpack8(*(const u32x4*)(kp + 64 + c * 8), f);
#pragma unroll
            for (int i = 0; i < 8; ++i) s1 += q[64 + c * 8 + i] * f[i]; }
        S0[j] = s0; S1[j] = s1; m0 = fmaxf(m0, s0); m1 = fmaxf(m1, s1);
    }
    m0 = wave_max(m0); m1 = wave_max(m1);
    float l0 = 0.f, l1 = 0.f;
    for (int j = lane; j < nk; j += 64) { const float e0 = exp2f(S0[j] - m0), e1 = exp2f(S1[j] - m1); S0[j] = e0; S1[j] = e1; l0 += e0; l1 += e1; }
    l0 = wave_sum(l0); l1 = wave_sum(l1);
    const float i0 = 1.0f / l0, i1 = lam / l1;
    for (int j = lane; j < nk; j += 64) S0[j] = S0[j] * i0 - S1[j] * i1;
    __syncthreads();
    float o[2];
#pragma unroll
    for (int t = 0; t < 2; ++t) {
        const int dv = lane + 64 * t;
        const bf16* vp = Vt + ((size_t)(ri.b * QKW + h * 128 + dv) * LK);
        float s = 0.f;
        for (int j = 0; j < nk; j += 8) { float f[8]; unpack8(*(const u32x4*)(vp + j), f);
#pragma unroll
            for (int i = 0; i < 8; ++i) s += S0[j + i] * f[i]; }
        o[t] = s;
    }
    const float ss = wave_sum(o[0] * o[0] + o[1] * o[1]);
    const float rs = rsqrtf(ss * (1.0f / 128.0f) + EPS_SUBLN) * (1.0f - lam_init);
    const float* sg = p.in[I_SUBG] + layer * VD;
#pragma unroll
    for (int t = 0; t < 2; ++t) { const int dv = lane + 64 * t; br[(size_t)row * DM + 1024 + h * 128 + dv] = (bf16)f2bf(o[t] * rs * sg[dv]); }
}

namespace pg8 {
constexpr int BM = 256, BK = 64, HALF = 128, HTB = HALF * BK * 2, STAGE_BYTES = 8 * HTB, NXCD = 8, WGM = 8;
__host__ __device__ __forceinline__ int lds_byte(int r, int c) { const int st = (r >> 4) * 2 + (c >> 5), rr = r & 15, cc = c & 31, ob = rr * 64 + cc * 2; return st * 1024 + (ob ^ (((ob >> 9) & 1) << 5)); }
__host__ __device__ __forceinline__ void stage_rc(int b, int& R, int& C) { const int st = b / 1024, sb = b % 1024, swz = sb ^ (((sb >> 9) & 1) << 5); R = (st >> 1) * 16 + swz / 64; C = (st & 1) * 32 + (swz % 64) / 2; }
__host__ __device__ __forceinline__ int perm32(int rho) { const int n = rho >> 4, i = rho & 15; return 8 * (i >> 2) + 4 * n + (i & 3); }
struct Unit { int pm, pn, z; size_t aoff, boff; };
struct Sched {
    int nM, nN, tiles, total, G, c, lda, ldb, zdiv; long sA1, sA2, sB1, sB2;
    __device__ __forceinline__ void init(const GemmJob& j, int G_, int c_) { nM = j.M / BM; nN = j.N / BM; tiles = nM * nN; total = tiles * j.Z; G = G_; c = c_; lda = j.lda; ldb = j.ldb; zdiv = j.zdiv; sA1 = j.sA1; sA2 = j.sA2; sB1 = j.sB1; sB2 = j.sB2; }
    __device__ __forceinline__ bool next(int i, Unit& u) const {
        const long L = (long)i * G + c; if (L >= total) return false;
        const int z = (int)(L / tiles); int wgid = (int)(L % tiles);
        { const int q = tiles / NXCD, r = tiles % NXCD, xcd = wgid % NXCD, off = wgid / NXCD; wgid = (xcd < r ? xcd * (q + 1) : r * (q + 1) + (xcd - r) * q) + off; }
        const int nig = WGM * nN, gid = wgid / nig, fm = gid * WGM, gsz = (nM - fm) < WGM ? (nM - fm) : WGM;
        u.pm = fm + ((wgid % nig) % gsz); u.pn = (wgid % nig) / gsz; u.z = z;
        const long z1 = z / zdiv, z2 = z % zdiv;
        u.aoff = (size_t)(z1 * sA1 + z2 * sA2 + (long)u.pm * BM * lda) * 2; u.boff = (size_t)(z1 * sB1 + z2 * sB2 + (long)u.pn * BM * ldb) * 2;
        return true;
    }
};
template <class E> __device__ __forceinline__ void run_epi(const E& e, const f32x4 (&acc)[2][2][4][2], const Unit& u, int wr, int wc, int, int) {
    const int ln_ = lane_id_opaque(), fr = ln_ & 15, fq = ln_ >> 4;
    int row0 = u.pm * BM + wr * 64 + fr, col0 = u.pn * BM + wc * 64 + 8 * fq;
    asm volatile("" : "+v"(row0), "+v"(col0));
    const int colq = col0 - 4 * fq; (void)colq;
#pragma unroll
    for (int ai = 0; ai < 2; ++ai)
#pragma unroll
        for (int m = 0; m < 4; ++m)
#pragma unroll
            for (int bj = 0; bj < 2; ++bj) {
                if constexpr (E::PERM) e.apply8(u.z, row0 + ai * HALF + m * 16, col0 + bj * 32, acc[ai][bj][m][0], acc[ai][bj][m][1]);
                else { e.apply4(u.z, row0 + ai * HALF + m * 16, colq + bj * 32, acc[ai][bj][m][0]); e.apply4(u.z, row0 + ai * HALF + m * 16, colq + bj * 32 + 16, acc[ai][bj][m][1]); } }
}
template <class E> __device__ __forceinline__ void run_mid(const E& e, f32x4 (&acc)[2][2][4][2], const Unit& u, int seg, int wr, int wc, int, int) {
    const int ln_ = lane_id_opaque(), fr = ln_ & 15, fq = ln_ >> 4;
    int row0 = u.pm * BM + wr * 64 + fr, col0 = u.pn * BM + wc * 64 + 8 * fq;
    asm volatile("" : "+v"(row0), "+v"(col0));
#pragma unroll
    for (int ai = 0; ai < 2; ++ai)
#pragma unroll
        for (int m = 0; m < 4; ++m)
#pragma unroll
            for (int bj = 0; bj < 2; ++bj) e.mid8(seg, row0 + ai * HALF + m * 16, col0 + bj * 32, acc[ai][bj][m][0], acc[ai][bj][m][1]);
}
template <class E>
__device__ __forceinline__ void gemm_phase(LAS unsigned char* lds, const GemmJob g, const Sched& S, const E& e, int wave_) {
    int tid = wave_ * 64 + lane_id_opaque(); asm volatile("" : "+v"(tid));
    const int wid = wave_, lane = tid & 63, wr = wid >> 2, wc = wid & 3, fr = lane & 15, fq = lane >> 4;
    const int K = g.K, nt = K / BK;
    unsigned voffA[2], voffB[2];
#pragma unroll
    for (int i = 0; i < 2; ++i) { int R, C; stage_rc(tid * 16 + i * 8192, R, C); const int Rb = (R >> 5) * 64 + (E::PERM ? perm32(R & 31) : (R & 31));
        voffA[i] = (unsigned)(R * g.lda + C) * 2u; voffB[i] = (unsigned)(Rb * g.ldb + C) * 2u; }
    const size_t kstep = (size_t)(BK * 2);
    const size_t hstepA = (size_t)HALF * g.lda * 2, hstepB = (size_t)32 * g.ldb * 2;
    const unsigned ldsw = (unsigned)wid * 1024u;
    const int aoff = lds_byte(wr * 64 + fr, fq * 8), boff = lds_byte(wc * 32 + fr, fq * 8);
#define PG8_SA(b, h) (((b) * 2 + (h)) * HTB)
#define PG8_SB(b, h) ((4 + (b) * 2 + (h)) * HTB)
#define PG8_STAGE(bufoff, gbase, voff) do { _Pragma("unroll") for (int _i = 0; _i < 2; ++_i) \
        __builtin_amdgcn_global_load_lds((const unsigned*)((const char*)(gbase) + (voff)[_i]), (LAS unsigned*)(lds + (bufoff) + ldsw + _i * 8192), 16, 0, 0); } while (0)
#define PG8_LDA(dst, b, h) do { _Pragma("unroll") for (int m = 0; m < 4; ++m) _Pragma("unroll") for (int k = 0; k < 2; ++k) dst[m][k] = *(const LAS bf16x8*)(lds + PG8_SA(b, h) + aoff + m * 2048 + k * 1024); } while (0)
#define PG8_LDB(dst, b, h) do { _Pragma("unroll") for (int n = 0; n < 2; ++n) _Pragma("unroll") for (int k = 0; k < 2; ++k) dst[n][k] = *(const LAS bf16x8*)(lds + PG8_SB(b, h) + boff + n * 2048 + k * 1024); } while (0)
#define PG8_MMA(ai, bj, At, Bt) do { __builtin_amdgcn_s_setprio(1); _Pragma("unroll") for (int m = 0; m < 4; ++m) _Pragma("unroll") for (int n = 0; n < 2; ++n) _Pragma("unroll") for (int k = 0; k < 2; ++k) \
        acc[ai][bj][m][n] = __builtin_amdgcn_mfma_f32_16x16x32_bf16(Bt[n][k], At[m][k], acc[ai][bj][m][n], 0, 0, 0); __builtin_amdgcn_s_setprio(0); } while (0)
#define PG8_WAIT_V(n) asm volatile("s_waitcnt vmcnt(" #n ")" ::: "memory")
#define PG8_WAIT_L(n) asm volatile("s_waitcnt lgkmcnt(" #n ")" ::: "memory")
#define PG8_BAR __builtin_amdgcn_s_barrier()
#define PG8_SCHED __builtin_amdgcn_sched_barrier(0)
    Unit cur, nxt; int ui = 0;
    if (!S.next(0, cur)) return;
    f32x4 acc[2][2][4][2];
#pragma unroll
    for (int a = 0; a < 2; ++a)
#pragma unroll
        for (int b = 0; b < 2; ++b)
#pragma unroll
            for (int m = 0; m < 4; ++m)
#pragma unroll
                for (int n = 0; n < 2; ++n) acc[a][b][m][n] = (f32x4){0.f, 0.f, 0.f, 0.f};
    bf16x8 At[4][2], B0[2][2], B1[2][2];
    const char* cA = (const char*)g.A + cur.aoff; const char* cB = (const char*)g.Bt + cur.boff;
    PG8_STAGE(PG8_SB(0, 0), cB, voffB); PG8_STAGE(PG8_SB(0, 1), cB + hstepB, voffB); PG8_STAGE(PG8_SA(0, 0), cA, voffA); PG8_STAGE(PG8_SA(0, 1), cA + hstepA, voffA);
    if (wr == 1) PG8_BAR;
    PG8_WAIT_V(2); PG8_BAR;
    PG8_STAGE(PG8_SB(1, 0), cB + kstep, voffB); PG8_STAGE(PG8_SA(1, 0), cA + kstep, voffA); PG8_STAGE(PG8_SB(1, 1), cB + hstepB + kstep, voffB);
    PG8_WAIT_V(6); PG8_BAR;
    for (;;) {
        const bool has_next = S.next(ui + 1, nxt);
        const char* nA = has_next ? (const char*)g.A + nxt.aoff : cA; const char* nB = has_next ? (const char*)g.Bt + nxt.boff : cB;
        for (int t = 0; t < nt; t += 2) {
            const bool last = (t == nt - 2);
            const char* a1 = cA + (size_t)(t + 1) * kstep;
            const char* a2 = last ? nA : cA + (size_t)(t + 2) * kstep; const char* b2 = last ? nB : cB + (size_t)(t + 2) * kstep;
            const char* a3 = a2 + kstep; const char* b3 = b2 + kstep;
            PG8_LDB(B0, 0, 0); PG8_LDB(B1, 0, 1); PG8_SCHED; PG8_LDA(At, 0, 0); PG8_STAGE(PG8_SA(1, 1), a1 + hstepA, voffA);
            PG8_WAIT_V(8); PG8_WAIT_L(0); PG8_BAR; PG8_MMA(0, 0, At, B0); PG8_MMA(0, 1, At, B1); PG8_BAR; PG8_SCHED;
            PG8_LDA(At, 0, 1); PG8_STAGE(PG8_SB(0, 0), b2, voffB); PG8_STAGE(PG8_SB(0, 1), b2 + hstepB, voffB); PG8_STAGE(PG8_SA(0, 0), a2, voffA);
            PG8_WAIT_V(8); PG8_WAIT_L(0); PG8_BAR; PG8_MMA(1, 0, At, B0); PG8_MMA(1, 1, At, B1); PG8_BAR; PG8_SCHED;
            PG8_LDB(B0, 1, 0); PG8_LDB(B1, 1, 1); PG8_SCHED; PG8_LDA(At, 1, 0); PG8_STAGE(PG8_SA(0, 1), a2 + hstepA, voffA);
            PG8_WAIT_V(8); PG8_WAIT_L(0); PG8_BAR; PG8_MMA(0, 0, At, B0); PG8_MMA(0, 1, At, B1); PG8_BAR; PG8_SCHED;
            PG8_LDA(At, 1, 1); PG8_STAGE(PG8_SB(1, 0), b3, voffB); PG8_STAGE(PG8_SB(1, 1), b3 + hstepB, voffB); PG8_STAGE(PG8_SA(1, 0), a3, voffA);
            PG8_WAIT_V(8); PG8_WAIT_L(0); PG8_BAR; PG8_MMA(1, 0, At, B0); PG8_MMA(1, 1, At, B1); PG8_BAR; PG8_SCHED;
            if constexpr (E::HAS_MID) { if (t + 2 == E::MID0 || t + 2 == E::MID1) run_mid(e, acc, cur, (t + 2 == E::MID0) ? 0 : 1, wr, wc, fr, fq); }
        }
        if (wr == 0) PG8_BAR;
        if constexpr (E::WHOLE) e.whole(acc, cur.pm, cur.pn, wr, wc, fr, fq); else run_epi(e, acc, cur, wr, wc, fr, fq);
        if (!has_next) break;
#pragma unroll
        for (int a = 0; a < 2; ++a)
#pragma unroll
            for (int b = 0; b < 2; ++b)
#pragma unroll
                for (int m = 0; m < 4; ++m)
#pragma unroll
                    for (int n = 0; n < 2; ++n) acc[a][b][m][n] = (f32x4){0.f, 0.f, 0.f, 0.f};
        cur = nxt; cA = nA; cB = nB; ++ui;
        if (wr == 1) PG8_BAR;
    }
    PG8_WAIT_V(0);
    PG8_BAR;
#undef PG8_SA
#undef PG8_SB
#undef PG8_STAGE
#undef PG8_LDA
#undef PG8_LDB
#undef PG8_MMA
#undef PG8_WAIT_V
#undef PG8_WAIT_L
#undef PG8_BAR
#undef PG8_SCHED
}
}

#define XB_TMO      128
#define XB_XCNT(j)  (256  + 64 * (j))
#define XB_XSUB(j)  (1280 + 64 * (j))
#define XB_XGEN(j)  (2304 + 64 * (j))
#define XB_TOP      3328
#define XB_TOPGEN   3392
#define XCD_BAR_WORDS 3456
#define XB_SPIN_CAP (1u << 18)
__device__ __forceinline__ unsigned xb_ld(unsigned* p)              { return __hip_atomic_load(p, __ATOMIC_RELAXED, __HIP_MEMORY_SCOPE_AGENT); }
__device__ __forceinline__ unsigned xb_add(unsigned* p, unsigned v) { return __hip_atomic_fetch_add(p, v, __ATOMIC_RELAXED, __HIP_MEMORY_SCOPE_AGENT); }
__device__ __forceinline__ unsigned xb_xcc_id() { return (unsigned)__builtin_amdgcn_s_getreg((3 << 11) | 20) & 0xFu; }
#define XB_SPIN(cond, bar) do { unsigned _sp = 0; while (cond) { __builtin_amdgcn_s_sleep(1); \
    if ((++_sp & 255u) == 0u) { if (xb_ld(&(bar)[XB_TMO])) break; if (_sp > XB_SPIN_CAP) { atomicAdd(&(bar)[XB_TMO], 1u); break; } } } } while (0)
struct XcdBarrier { unsigned* bar; unsigned x; volatile LAS unsigned* st; };
__device__ __forceinline__ XcdBarrier xcd_barrier_post(unsigned* bar, volatile LAS unsigned* st) {
    XcdBarrier b; b.bar = bar; b.x = xb_xcc_id(); b.st = st;
    if (threadIdx.x == 0) (void)xb_add(&bar[XB_XCNT(b.x)], 1u);
    return b;
}
__device__ __forceinline__ void xcd_barrier_complete(unsigned* bar, unsigned x, unsigned& nloc, unsigned& nx) {
    const unsigned G = gridDim.x * gridDim.y * gridDim.z;
    unsigned sum, cnt, mine, sp = 0u;
    for (;;) {
        sum = 0u; cnt = 0u; mine = 0u;
#pragma unroll
        for (unsigned j = 0; j < 16; ++j) { const unsigned c = xb_ld(&bar[XB_XCNT(j)]); sum += c; cnt += (c > 0u) ? 1u : 0u; mine = (j == x) ? c : mine; }
        if (sum == G) break;
        __builtin_amdgcn_s_sleep(1);
        if ((++sp & 255u) == 0u) { if (xb_ld(&bar[XB_TMO])) break; if (sp > XB_SPIN_CAP) { atomicAdd(&bar[XB_TMO], 1u); break; } }
    }
    nloc = mine > 0u ? mine : 1u; nx = cnt > 0u ? cnt : 1u;
}
__device__ __forceinline__ void xcd_barrier(const XcdBarrier& b) {
    asm volatile("s_waitcnt vmcnt(0)" ::: "memory");
    __syncthreads();
    if (threadIdx.x == 0) {
        unsigned* bar = b.bar;
        __builtin_amdgcn_s_waitcnt(0);
        unsigned nloc = b.st[0], nx = b.st[1];
        if (nloc == 0u) { xcd_barrier_complete(bar, b.x, nloc, nx); b.st[0] = nloc; b.st[1] = nx; }
        const unsigned old = xb_add(&bar[XB_XSUB(b.x)], 1u);
        const unsigned gen = old / nloc;
        if (old + 1u == (gen + 1u) * nloc) {
            __builtin_amdgcn_fence(__ATOMIC_RELEASE, "agent");
            asm volatile("s_waitcnt vmcnt(0)" ::: "memory");
            const unsigned og = xb_add(&bar[XB_TOP], 1u);
            const unsigned tg = og / nx;
            if (og + 1u == (tg + 1u) * nx) xb_add(&bar[XB_TOPGEN], 1u);
            else XB_SPIN(xb_ld(&bar[XB_TOPGEN]) == tg, bar);
            __builtin_amdgcn_fence(__ATOMIC_ACQUIRE, "agent");
            xb_add(&bar[XB_XGEN(b.x)], 1u);
            asm volatile("s_waitcnt vmcnt(0)" ::: "memory");
        } else {
            XB_SPIN(xb_ld(&bar[XB_XGEN(b.x)]) == gen, bar);
            __builtin_amdgcn_fence(__ATOMIC_ACQUIRE, "agent");
            asm volatile("s_waitcnt vmcnt(0)" ::: "memory");
        }
    }
    __syncthreads();
}

constexpr int NWAVES = 8, NTHR = 512;
constexpr int RING_BYTES = 131072, MISC_OFF = RING_BYTES, LDS_BYTES = 147456;
constexpr int CW_BAR = 4096;
#define LDS_WAIT() asm volatile("s_waitcnt lgkmcnt(0)" ::: "memory")

struct Ctx { LAS unsigned char* lds; int tid, lane, wave, vcu, G; };
__device__ __forceinline__ Ctx fresh(const Ctx& F0) { Ctx F = F0; int v = F0.vcu, w = F0.wave; asm volatile("" : "+s"(v), "+s"(w)); int t = w * 64 + lane_id_opaque(); asm volatile("" : "+v"(t)); F.tid = t; F.lane = t & 63; F.vcu = v; F.wave = w; return F; }

template <bool UPPERM = false> __device__ __forceinline__ void transpose_item(const float* W, int N, bf16* WT, int ldt, int col_off, LAS float* scr, int item, int lane) {
    const int nblk = N / 32, kb = item / nblk, nb = item % nblk, k0 = 64 * kb, n0 = 32 * nb;
    { const int kr = lane >> 3, c4 = lane & 7;
      f32x4 v[8];
#pragma unroll
      for (int i = 0; i < 8; ++i) v[i] = *(const f32x4*)(W + (size_t)(k0 + 8 * i + kr) * N + n0 + 4 * c4);
#pragma unroll
      for (int i = 0; i < 8; ++i)
#pragma unroll
          for (int j = 0; j < 4; ++j) scr[(8 * i + kr) * 33 + 4 * c4 + j] = v[i][j]; }
    LDS_WAIT(); asm volatile("" ::: "memory");
    const int c = lane & 7;
#pragma unroll
    for (int j = 0; j < 4; ++j) { const int n = (lane >> 3) + 8 * j; const LAS float* s = scr + (8 * c) * 33 + n;
        u32x4 o; o.x = pk2(s[0 * 33], s[1 * 33]); o.y = pk2(s[2 * 33], s[3 * 33]); o.z = pk2(s[4 * 33], s[5 * 33]); o.w = pk2(s[6 * 33], s[7 * 33]);
        int nr = n0 + n; if (UPPERM) { const int av = nr >= DFF, j = nr - av * DFF; nr = (j >> 7) * 256 + ((j >> 5) & 3) * 64 + av * 32 + (j & 31); }
        *(u32x4*)(WT + (size_t)nr * ldt + col_off + k0 + 8 * c) = o; }
    LDS_WAIT(); asm volatile("" ::: "memory");
}
__device__ __forceinline__ void prologue(const Params& p, const Ctx& F0) {
    const Ctx F = fresh(F0);
    const int gw = F.vcu * NWAVES + F.wave, NGW = F.G * NWAVES;
    const int gt = F.vcu * NTHR + F.tid, NGT = F.G * NTHR;
    {
        LAS float* sv = (LAS float*)F.lds;
        LAS float* red = (LAS float*)(F.lds + 24576);
        for (int i = F.tid; i < 3 * DM; i += NTHR) { const int r = i / DM, k = i % DM; const float x = r < 2 ? p.in[I_C][r * DM + k] : p.in[I_CCTX][k]; sv[i] = x / (1.0f + __expf(-x)); }
        __syncthreads();
        const int ng = F.tid & 15, ks = F.tid >> 4;
        float* mod = (float*)(p.ws + WS_MOD);
        for (int it = F.vcu; it < DEPTH * (NMOD / 64); it += F.G) {
            const int l = it / (NMOD / 64), n0 = (it % (NMOD / 64)) * 64;
            const float* W = p.in[I_WMOD] + ((size_t)l * DM + ks * 64) * NMOD + n0 + 4 * ng;
            f32x4 a0 = {0, 0, 0, 0}, a1 = {0, 0, 0, 0}, a2 = {0, 0, 0, 0};
#pragma unroll 8
            for (int kk = 0; kk < 64; ++kk) { const f32x4 w = *(const f32x4*)(W + (size_t)kk * NMOD); const int k = ks * 64 + kk; a0 += sv[k] * w; a1 += sv[DM + k] * w; a2 += sv[2 * DM + k] * w; }
            *(LAS f32x4*)(red + (ks * 3 + 0) * 64 + 4 * ng) = a0; *(LAS f32x4*)(red + (ks * 3 + 1) * 64 + 4 * ng) = a1; *(LAS f32x4*)(red + (ks * 3 + 2) * 64 + 4 * ng) = a2;
            __syncthreads();
            if (F.tid < 192) { const int r = F.tid >> 6, n = F.tid & 63; float s = p.in[I_BMOD][(size_t)l * NMOD + n0 + n];
                for (int q = 0; q < 32; ++q) s += red[(q * 3 + r) * 64 + n];
                mod[((size_t)l * 3 + r) * NMOD + n0 + n] = s; }
            __syncthreads();
        }
    }
    {
        LAS float* scr = (LAS float*)(F.lds + F.wave * 16384);
        constexpr int I_IN = (DM / 64) * (NIN / 32), I_BF = (512 / 64) * (DM / 32), I_BA = (1024 / 64) * (DM / 32), I_OUT = (DM / 64) * (DM / 32), I_DN = (DFF / 64) * (DM / 32);
        constexpr int PER_LAYER = 2 * I_IN + 2 * I_BF + I_BA + I_OUT + I_DN;
        for (int it = gw; it < DEPTH * PER_LAYER; it += NGW) {
            const int l = it / PER_LAYER; int r = it % PER_LAYER;
            unsigned char* wb = p.ws + WS_W + (size_t)l * W_LAYER;
            if (r < I_IN) { transpose_item(p.in[I_WIN] + (size_t)l * DM * NIN, NIN, (bf16*)(wb + W_IN), DM, 0, scr, r, F.lane); continue; } r -= I_IN;
            if (r < I_IN) { transpose_item<MK_FUSE_ACT != 0>(p.in[I_WUP] + (size_t)l * DM * NUP, NUP, (bf16*)(wb + W_UP), DM, 0, scr, r, F.lane); continue; } r -= I_IN;
            if (r < I_BF) { transpose_item(p.in[I_WBF] + (size_t)l * 512 * DM, DM, (bf16*)(wb + W_BM), DM, 0, scr, r, F.lane); continue; } r -= I_BF;
            if (r < I_BF) { transpose_item(p.in[I_WBC] + (size_t)l * 512 * DM, DM, (bf16*)(wb + W_BM), DM, 512, scr, r, F.lane); continue; } r -= I_BF;
            if (r < I_BA) { transpose_item(p.in[I_WBA] + (size_t)l * 1024 * DM, DM, (bf16*)(wb + W_BM), DM, 1024, scr, r, F.lane); continue; } r -= I_BA;
            if (r < I_OUT) { transpose_item(p.in[I_WOUT] + (size_t)l * DM * DM, DM, (bf16*)(wb + W_OUT), DM, 0, scr, r, F.lane); continue; } r -= I_OUT;
            transpose_item(p.in[I_WDOWN] + (size_t)l * DFF * DM, DM, (bf16*)(wb + W_DOWN), DFF, 0, scr, r, F.lane);
        }
    }
    {
#if MK_FFT
        { bf16* WA = (bf16*)(p.ws + WS_FWA); bf16* WC = (bf16*)(p.ws + WS_FWC); float2* tw = (float2*)(p.ws + WS_FTW);
          for (int it = gt; it < 128 * 128; it += NGT) { const int r = it >> 7, k = it & 127, pr = r >> 6, ap = r & 63, pk = k >> 6, a = k & 63; float sn, cs; sincospif((float)((ap * a) & 63) * (1.0f / 32.0f), &sn, &cs);
              const float v = (pr == 0 ? (pk == 0 ? cs : -sn) : (pk == 0 ? -sn : -cs)) * 0.125f; WA[it] = (bf16)f2bf(v); }
          for (int it = gt; it < 64 * 128; it += NGT) { const int bp = it >> 7, k = it & 127, pk = k >> 6, b = k & 63; float sn, cs; sincospif((float)((bp * b) & 63) * (1.0f / 32.0f), &sn, &cs); WC[it] = (bf16)f2bf((pk == 0 ? cs : sn) * 0.125f); }
          for (int it = gt; it < 4096; it += NGT) { float sn, cs; sincospif((float)it * (1.0f / 2048.0f), &sn, &cs); tw[it] = make_float2(cs, sn); } }
#else
        bf16* DL = (bf16*)(p.ws + WS_DL);
        for (int it = gt; it < SEQ * 1024; it += NGT) {
            const int lp = it >> 10, j0 = (it & 1023) * 8; float v[8];
#pragma unroll
            for (int e = 0; e < 8; ++e) { const int j = j0 + e, l = j & (SEQ - 1); const int m = (lp * l) & (SEQ - 1); float s, c; sincospif((float)m * (1.0f / 2048.0f), &s, &c); v[e] = (j < SEQ ? c : -s) * (1.0f / 64.0f); }
            *(u32x4*)(DL + (size_t)lp * (2 * SEQ) + j0) = pack8(v);
        }
#endif
        bf16* DC = (bf16*)(p.ws + WS_DC);
        for (int it = gt; it < CTXL * 64; it += NGT) {
            const int lp = it >> 6, j0 = (it & 63) * 8; float v[8];
#pragma unroll
            for (int e = 0; e < 8; ++e) { const int j = j0 + e, l = j & (CTXL - 1); const int m = (lp * l) & (CTXL - 1); float s, c; sincospif((float)m * (1.0f / 128.0f), &s, &c); v[e] = (j < CTXL ? c : -s) * (1.0f / 16.0f); }
            *(u32x4*)(DC + (size_t)lp * (2 * CTXL) + j0) = pack8(v);
        }
        bf16* CS = (bf16*)(p.ws + WS_CS128);
        for (int it = gt; it < 256 * 32; it += NGT) {
            const int row = it >> 5, k0 = (it & 31) * 8, cs = row >> 7, cp = row & 127; float v[8];
#pragma unroll
            for (int e = 0; e < 8; ++e) { const int k = k0 + e; const int m = (cp * k) & 127; float s, c; sincospif((float)m * (1.0f / 64.0f), &s, &c); v[e] = k < 128 ? (cs == 0 ? c : s) * 0.08838834764831845f : 0.f; }
            *(u32x4*)(CS + (size_t)row * 256 + k0) = pack8(v);
        }
        float2* rope = (float2*)(p.ws + WS_ROPE);
        for (int it = gt; it < 64 * 16; it += NGT) { const int pos = it >> 4, j = it & 15; const float inv = powf(10000.0f, -(float)j * (1.0f / 16.0f)); const float a = (float)pos * inv; rope[it] = make_float2(cosf(a), sinf(a)); }
        if (gt < DEPTH) { const float* lm = p.in[I_LAMB] + gt * 4 * HD; float s0 = 0.f, s1 = 0.f; for (int d = 0; d < HD; ++d) { s0 += lm[d] * lm[HD + d]; s1 += lm[2 * HD + d] * lm[3 * HD + d]; }
            ((float*)(p.ws + WS_LAM))[gt] = expf(s0) - expf(s1) + (0.8f - 0.6f * expf(-0.3f * (float)gt)); }
    }
}

__device__ __forceinline__ void norm_row_finish(const LAS float* tab, bf16* xrow, const float (&f)[4][8], int lane) {
    float ss = 0.f;
#pragma unroll
    for (int j = 0; j < 4; ++j)
#pragma unroll
        for (int i = 0; i < 8; i += 2) ss += f[j][i] * f[j][i] + f[j][i + 1] * f[j][i + 1];
    const float rstd = rsqrtf(wave_sum(ss) * (1.0f / DM) + EPS_RMS);
#pragma unroll
    for (int j = 0; j < 4; ++j) { const int ci = 4 * (lane + 64 * j); float o[8];
        const f32x4 ae = *(const LAS f32x4*)(tab + ci), ao = *(const LAS f32x4*)(tab + 1024 + ci), be = *(const LAS f32x4*)(tab + 2048 + ci), bo = *(const LAS f32x4*)(tab + 3072 + ci);
#pragma unroll
        for (int i = 0; i < 4; ++i) { o[i] = (f[j][i] * rstd) * ae[i] + be[i]; o[4 + i] = (f[j][4 + i] * rstd) * ao[i] + bo[i]; }
        *(u32x4*)(xrow + 8 * (lane + 64 * j)) = pack8(o); }
}
template <int NR> __device__ __forceinline__ void norm_rows_bf16(const bf16* h, bf16* xn, const LAS float* tab, int row0, int lane) {
    u32x4 raw[NR][4];
#pragma unroll
    for (int r = 0; r < NR; ++r) { const u32x4* xr = (const u32x4*)(h + (size_t)(row0 + r) * DM) + lane;
#pragma unroll
        for (int j = 0; j < 4; ++j) raw[r][j] = xr[64 * j]; }
#pragma unroll
    for (int r = 0; r < NR; ++r) { float f[4][8];
#pragma unroll
        for (int j = 0; j < 4; ++j) unpack8(raw[r][j], f[j]);
        norm_row_finish(tab, xn + (size_t)(row0 + r) * DM, f, lane); }
}
__device__ __forceinline__ void norm_row_f32(const float* src, bf16* xrow, const LAS float* tab, int lane) {
    const f32x4* xr = (const f32x4*)src + 2 * lane; float f[4][8];
#pragma unroll
    for (int j = 0; j < 4; ++j) { const f32x4 a = xr[128 * j], b = xr[128 * j + 1]; f[j][0] = a[0]; f[j][1] = a[1]; f[j][2] = a[2]; f[j][3] = a[3]; f[j][4] = b[0]; f[j][5] = b[1]; f[j][6] = b[2]; f[j][7] = b[3]; }
    norm_row_finish(tab, xrow, f, lane);
}
__device__ __forceinline__ void norm_mod_phase(const Params& p, const Ctx& F0, int layer, int which) {
    const Ctx F = fresh(F0);
    const bf16* h = (const bf16*)(p.ws + WS_H); bf16* xn = (bf16*)(p.ws + WS_XN);
    const float* g = p.in[which == 0 ? I_G1 : I_G2] + (size_t)layer * DM;
    const float* modl = (const float*)(p.ws + WS_MOD) + (size_t)layer * 3 * NMOD;
    const int shoff = which == 0 ? 0 : 3 * DM, scoff = shoff + DM;
    LAS float* tab = (LAS float*)F.lds;
    for (int u = F.vcu; u < 256; u += F.G) {
        __syncthreads();
        { const int c4 = 4 * F.tid, li = (F.tid & 1) * 1024 + 4 * (F.tid >> 1);
          const f32x4 gg = *(const f32x4*)(g + c4);
#pragma unroll
          for (int s2 = 0; s2 < 2; ++s2) { const float* md = modl + (size_t)(s2 == 0 ? (u >> 7) : 2) * NMOD;
              const f32x4 sc = *(const f32x4*)(md + scoff + c4), sh = *(const f32x4*)(md + shoff + c4);
              *(LAS f32x4*)(tab + s2 * 4096 + li) = gg * (1.0f + sc); *(LAS f32x4*)(tab + s2 * 4096 + 2048 + li) = sh; } }
        __syncthreads();
        const int row0 = 32 * u + 4 * F.wave;
        if (layer == 0 && which == 0) {
            for (int r = 0; r < 4; ++r) norm_row_f32(p.in[I_X] + (size_t)(row0 + r) * DM, xn + (size_t)(row0 + r) * DM, tab, F.lane);
            if (F.wave < 2) norm_row_f32(p.in[I_CTX] + (size_t)(2 * u + F.wave) * DM, xn + (size_t)(ML + 2 * u + F.wave) * DM, tab + 4096, F.lane);
        } else {
            norm_rows_bf16<4>(h, xn, tab, row0, F.lane);
            if (F.wave < 2 && !(which == 1 && layer + 1 == DEPTH)) norm_rows_bf16<1>(h, xn, tab + 4096, ML + 2 * u + F.wave, F.lane);
        }
    }
}
__device__ __forceinline__ void mixer_prep_phase(const Params& p, const Ctx& F0, int layer) {
    const Ctx F = fresh(F0);
    const int gw = F.vcu * NWAVES + F.wave, NGW = F.G * NWAVES;
    const int gt = F.vcu * NTHR + F.tid, NGT = F.G * NTHR;
    const bf16* P = (const bf16*)(p.ws + WS_P);
    bf16* Qr = (bf16*)(p.ws + WS_QR); bf16* Kc = (bf16*)(p.ws + WS_KC); bf16* Vt = (bf16*)(p.ws + WS_VT); bf16* br = (bf16*)(p.ws + WS_BR);
    const float2* rope = (const float2*)(p.ws + WS_ROPE);
    for (int it = gt; it < MROWS * 128; it += NGT) {
        const int row = it >> 7, w = it & 127, tens = w >> 6, sub = w & 63, hh = sub >> 3, cc = (sub >> 2) & 1, ax = (sub >> 1) & 1, jh = sub & 1;
        const int base = hh * 128 + cc * 64 + ax * 32 + jh * 8;
        const RowInfo ri = row_info(row);
        const bf16* src = P + (size_t)row * NIN + (tens == 0 ? Q_OFF : K_OFF) + base;
        float x1[8], x2[8]; unpack8(*(const u32x4*)src, x1); unpack8(*(const u32x4*)(src + 16), x2);
        float o1[8], o2[8];
        if (!ri.ctx) { const int pa = ax == 0 ? (ri.pos >> 6) : (ri.pos & 63);
#pragma unroll
            for (int e = 0; e < 8; ++e) { const float2 cs = rope[pa * 16 + jh * 8 + e]; o1[e] = x1[e] * cs.x - x2[e] * cs.y; o2[e] = x2[e] * cs.x + x1[e] * cs.y; } }
        else {
#pragma unroll
            for (int e = 0; e < 8; ++e) { o1[e] = x1[e]; o2[e] = x2[e]; } }
        bf16* dst;
        if (tens == 0) {
#pragma unroll
            for (int e = 0; e < 8; ++e) { o1[e] *= QSCALE; o2[e] *= QSCALE; }
            dst = Qr + (size_t)row * QKW + base; }
        else dst = Kc + ((size_t)(ri.b * LK + ri.kv) * QKW + base);
        *(u32x4*)dst = pack8(o1); *(u32x4*)(dst + 16) = pack8(o2);
    }
    const float* cw = p.in[I_CONVW] + (size_t)layer * 3 * 512;
    for (int it = gt; it < MROWS * 64; it += NGT) {
        const int row = it >> 6, j0 = (it & 63) * 8; const RowInfo ri = row_info(row);
        const bf16* pr = P + (size_t)row * NIN + j0;
        float cb[8], a[8], b[8], acc[8];
        unpack8(*(const u32x4*)(pr + CB_OFF), cb);
        unpack8(*(const u32x4*)(pr + CC_OFF), a); unpack8(*(const u32x4*)(pr + CX_OFF), b);
#pragma unroll
        for (int e = 0; e < 8; ++e) acc[e] = a[e] * b[e] * cw[512 + j0 + e];
        if (ri.pos > 0) { unpack8(*(const u32x4*)(pr - NIN + CC_OFF), a); unpack8(*(const u32x4*)(pr - NIN + CX_OFF), b);
#pragma unroll
            for (int e = 0; e < 8; ++e) acc[e] += a[e] * b[e] * cw[j0 + e]; }
        if (ri.pos + 1 < ri.L) { unpack8(*(const u32x4*)(pr + NIN + CC_OFF), a); unpack8(*(const u32x4*)(pr + NIN + CX_OFF), b);
#pragma unroll
            for (int e = 0; e < 8; ++e) acc[e] += a[e] * b[e] * cw[1024 + j0 + e]; }
#pragma unroll
        for (int e = 0; e < 8; ++e) acc[e] *= cb[e];
        *(u32x4*)(br + (size_t)row * DM + 512 + j0) = pack8(acc);
    }
    LAS bf16* scr = (LAS bf16*)(F.lds + F.wave * 16384);
    for (int it = gw; it < (MROWS / 64) * 16; it += NGW) {
        const int tt = it >> 4, ct = it & 15, row0 = tt * 64; const RowInfo ri = row_info(row0);
#pragma unroll
        for (int i = 0; i < 8; ++i) { const int t = i * 8 + (F.lane >> 3), ch = F.lane & 7;
            const u32x4 w = *(const u32x4*)(P + (size_t)(row0 + t) * NIN + V_OFF + ct * 64 + ch * 8);
            const unsigned ww[4] = {w.x, w.y, w.z, w.w};
#pragma unroll
            for (int e = 0; e < 8; ++e) scr[(ch * 8 + e) * 72 + t] = (bf16)((ww[e >> 1] >> ((e & 1) * 16)) & 0xffffu); }
        LDS_WAIT(); asm volatile("" ::: "memory");
#pragma unroll
        for (int i = 0; i < 8; ++i) { const int col = i * 8 + (F.lane >> 3), ch = F.lane & 7;
            const u32x4 w = *(const LAS u32x4*)(scr + col * 72 + ch * 8);
            *(u32x4*)(Vt + ((size_t)(ri.b * QKW + ct * 64 + col) * LK + ri.kv + ch * 8)) = w; }
        LDS_WAIT(); asm volatile("" ::: "memory");
    }
}
__device__ __forceinline__ void ffn_act_phase(const Params& p, const Ctx& F0, int layer) {
    const Ctx F = fresh(F0);
    const int gt = F.vcu * NTHR + F.tid, NGT = F.G * NTHR;
    const bf16* Y = (const bf16*)(p.ws + WS_P); bf16* act = (bf16*)(p.ws + WS_ACT);
    const float* cw = p.in[I_FCONVW] + (size_t)layer * 3 * NUP;
    for (int it = gt; it < MROWS * (DFF / 8); it += NGT) {
        const int row = it / (DFF / 8), j0 = (it % (DFF / 8)) * 8; const RowInfo ri = row_info(row);
        const bf16* pr = Y + (size_t)row * NUP + j0;
        float a[8], v[8], ua[8], uv[8];
        unpack8(*(const u32x4*)pr, a); unpack8(*(const u32x4*)(pr + DFF), v);
#pragma unroll
        for (int e = 0; e < 8; ++e) { ua[e] = a[e] * cw[NUP + j0 + e]; uv[e] = v[e] * cw[NUP + DFF + j0 + e]; }
        if (ri.pos > 0) { unpack8(*(const u32x4*)(pr - NUP), a); unpack8(*(const u32x4*)(pr - NUP + DFF), v);
#pragma unroll
            for (int e = 0; e < 8; ++e) { ua[e] += a[e] * cw[j0 + e]; uv[e] += v[e] * cw[DFF + j0 + e]; } }
        if (ri.pos + 1 < ri.L) { unpack8(*(const u32x4*)(pr + NUP), a); unpack8(*(const u32x4*)(pr + NUP + DFF), v);
#pragma unroll
            for (int e = 0; e < 8; ++e) { ua[e] += a[e] * cw[2 * NUP + j0 + e]; uv[e] += v[e] * cw[2 * NUP + DFF + j0 + e]; } }
        float o[8];
#pragma unroll
        for (int e = 0; e < 8; ++e) o[e] = ua[e] * sigmoidf_(ua[e]) * uv[e];
        *(u32x4*)(act + (size_t)row * DFF + j0) = pack8(o);
    }
}
__device__ __forceinline__ void act_fix_phase(const Params& p, const Ctx& F0, int layer) {
    const Ctx F = fresh(F0);
    const int gt = F.vcu * NTHR + F.tid, NGT = F.G * NTHR;
    const float* halo = (const float*)(p.ws + WS_HALO); bf16* act = (bf16*)(p.ws + WS_ACT);
    const float* cw = p.in[I_FCONVW] + (size_t)layer * 3 * NUP;
    for (int it = gt; it < 30 * 2 * DFF; it += NGT) {
        const int j = it % DFF, rb = it / DFF, side = rb & 1, bi = rb >> 1, pm = bi + bi / 15;
        float ua, uv; int row;
        if (side == 0) {
            const float* hp = halo + (size_t)pm * 8 * DFF, *hn = halo + (size_t)(pm + 1) * 8 * DFF;
            ua = hp[(3 * 2 + 0) * DFF + j] + cw[2 * NUP + j] * hn[(0 * 2 + 0) * DFF + j]; uv = hp[(3 * 2 + 1) * DFF + j] + cw[2 * NUP + DFF + j] * hn[(0 * 2 + 1) * DFF + j]; row = pm * 256 + 255;
        } else {
            const float* hp = halo + (size_t)pm * 8 * DFF, *hn = halo + (size_t)(pm + 1) * 8 * DFF;
            ua = hn[(2 * 2 + 0) * DFF + j] + cw[j] * hp[(1 * 2 + 0) * DFF + j]; uv = hn[(2 * 2 + 1) * DFF + j] + cw[DFF + j] * hp[(1 * 2 + 1) * DFF + j]; row = (pm + 1) * 256;
        }
        act[(size_t)row * DFF + j] = (bf16)pk2(ua * sigmoidf_(ua) * uv, 0.f);
    }
}
__device__ __forceinline__ void final_norm_phase(const Params& p, const Ctx& F0) {
    const Ctx F = fresh(F0);
    const int gw = F.vcu * NWAVES + F.wave, NGW = F.G * NWAVES;
    const bf16* h = (const bf16*)(p.ws + WS_H); const float* g = p.in[I_GFIN];
    for (int row = gw; row < ML; row += NGW) {
        const u32x4* xr = (const u32x4*)(h + (size_t)row * DM) + F.lane;
        float v[4][8]; float ss = 0.f;
#pragma unroll
        for (int j = 0; j < 4; ++j) { unpack8(xr[64 * j], v[j]);
#pragma unroll
            for (int e = 0; e < 8; ++e) ss += v[j][e] * v[j][e]; }
        const float rstd = rsqrtf(wave_sum(ss) * (1.0f / DM) + EPS_RMS);
#pragma unroll
        for (int j = 0; j < 4; ++j) { const int col = 8 * (F.lane + 64 * j); const f32x4 g0 = *(const f32x4*)(g + col), g1 = *(const f32x4*)(g + col + 4);
            f32x4* orow = (f32x4*)(p.out + (size_t)row * DM + col);
            orow[0] = (f32x4){v[j][0], v[j][1], v[j][2], v[j][3]} * rstd * g0; orow[1] = (f32x4){v[j][4], v[j][5], v[j][6], v[j][7]} * rstd * g1; }
    }
}

constexpr float AT_TRIG = 65536.0f;
constexpr int AT_KP = 144;
constexpr int AT_K0 = 0, AT_K1 = 8192, AT_V = 16384, AT_STG = 32768;
__device__ __forceinline__ float swap32_max(float v) { auto rr = __builtin_amdgcn_permlane32_swap(__float_as_uint(v), __float_as_uint(v), false, false); return fmaxf(__uint_as_float(rr[0]), __uint_as_float(rr[1])); }
__device__ __forceinline__ float swap32_sum(float v) { auto rr = __builtin_amdgcn_permlane32_swap(__float_as_uint(v), __float_as_uint(v), false, false); return __uint_as_float(rr[0]) + __uint_as_float(rr[1]); }
__device__ __forceinline__ void attn_unit(const Params& p, const Ctx& F0, int layer, int b, int h, int qrow0, int nk) {
    const Ctx F = fresh(F0);
    const bf16* Qr = (const bf16*)(p.ws + WS_QR); const bf16* Kc = (const bf16*)(p.ws + WS_KC) + (size_t)b * LK * QKW + h * 128; const bf16* Vt = (const bf16*)(p.ws + WS_VT) + (size_t)(b * QKW + h * 128) * LK;
    bf16* br = (bf16*)(p.ws + WS_BR);
    const int tid = F.tid, lane = F.lane, wid = F.wave, comp = wid >> 2, qw = wid & 3, r32 = lane & 31, hi = lane >> 5;
    LAS unsigned char* lds = F.lds;
    const int drow = wid * 8 + (lane >> 3), dch = ((lane & 7) ^ ((drow >> 1) & 7)) * 8;
    const bf16* gk = Kc + (size_t)drow * QKW + dch;
    const bf16* gv = Vt + (size_t)drow * LK + dch;
    const unsigned lds0 = (unsigned)(size_t)lds;
    const unsigned dk = lds0 + AT_K0 + wid * 1024, dv_ = lds0 + AT_V + wid * 1024;
#define AT_GLDS(g_, l_) do { unsigned sv_; const unsigned lb_ = (unsigned)__builtin_amdgcn_readfirstlane((int)(l_)); \
        asm volatile("s_mov_b32 %0, m0\n\ts_mov_b32 m0, %2\n\ts_nop 0\n\tglobal_load_lds_dwordx4 %1, off\n\ts_mov_b32 m0, %0" : "=&s"(sv_) : "v"(g_), "s"(lb_) : "memory"); } while (0)
#define AT_DMA(t, s) do { const bf16* k_ = gk + (size_t)(t) * 64 * QKW; const bf16* v_ = gv + (t) * 64; const unsigned so_ = (unsigned)((s) * AT_STG); \
        AT_GLDS(k_, dk + so_); AT_GLDS(k_ + 64, dk + so_ + (AT_K1 - AT_K0)); AT_GLDS(v_, dv_ + so_); AT_GLDS(v_ + (size_t)64 * LK, dv_ + so_ + 8192); } while (0)
#define AT_WAIT_BAR() asm volatile("s_waitcnt vmcnt(0) lgkmcnt(0)\n\ts_barrier" ::: "memory")
    const int nt = nk / 64;
    AT_DMA(0, 0);
    bf16x8 qf[4];
    { const bf16* qp = Qr + (size_t)(qrow0 + qw * 32 + r32) * QKW + h * 128 + comp * 64 + hi * 8;
#pragma unroll
      for (int d0 = 0; d0 < 4; ++d0) qf[d0] = *(const bf16x8*)(qp + d0 * 16); }
    f32x16 ot[4];
#pragma unroll
    for (int i = 0; i < 4; ++i)
#pragma unroll
        for (int r = 0; r < 16; ++r) ot[i][r] = 0.f;
    float mrun = 0.f, lrun = 0.f;
    const int krow = (r32 & 19) | ((r32 & 4) << 1) | ((r32 & 8) >> 1);
    const int zk = hi ^ ((krow >> 1) & 7), zv = hi ^ ((r32 >> 1) & 7);
    const int kfo = (comp ? AT_K1 : AT_K0) + krow * 128, vfo = AT_V + r32 * 128;
    int kpo[4], vpo[4];
#pragma unroll
    for (int j = 0; j < 4; ++j) { kpo[j] = ((2 * j) ^ zk) * 16; vpo[j] = ((2 * j) ^ zv) * 16; }
    bf16x8 pprev[4];
#pragma unroll
    for (int i = 0; i < 4; ++i) pprev[i] = (bf16x8){0, 0, 0, 0, 0, 0, 0, 0};
    bf16x8 va0, va1, va2, va3, vb0, vb1, vb2, vb3;
    va0 = va1 = va2 = va3 = (bf16x8){0, 0, 0, 0, 0, 0, 0, 0};
#define AT_VRD(vb_, f_) (*(const LAS bf16x8*)((vb_) + ((f_) & 3) * 4096 + vpo[(f_) >> 2]))
#define AT_SB() __builtin_amdgcn_sched_barrier(0)
#define AT_PVPRE(stage_) do { const LAS unsigned char* vb_ = lds + (stage_) * AT_STG + vfo; va0 = AT_VRD(vb_, 0); va1 = AT_VRD(vb_, 1); va2 = AT_VRD(vb_, 2); va3 = AT_VRD(vb_, 3); } while (0)
#define AT_MF(i_, v_, g_, pf_) ot[i_] = __builtin_amdgcn_mfma_f32_32x32x16_bf16(v_, pf_[g_], ot[i_], 0, 0, 0)
#define AT_PV(stage_, pf_) do { const LAS unsigned char* vb_ = lds + (stage_) * AT_STG + vfo; AT_SB(); \
        vb0 = AT_VRD(vb_, 4);  AT_MF(0, va0, 0, pf_); AT_SB(); vb1 = AT_VRD(vb_, 5);  AT_MF(1, va1, 0, pf_); AT_SB(); vb2 = AT_VRD(vb_, 6);  AT_MF(2, va2, 0, pf_); AT_SB(); vb3 = AT_VRD(vb_, 7);  AT_MF(3, va3, 0, pf_); AT_SB(); \
        va0 = AT_VRD(vb_, 8);  AT_MF(0, vb0, 1, pf_); AT_SB(); va1 = AT_VRD(vb_, 9);  AT_MF(1, vb1, 1, pf_); AT_SB(); va2 = AT_VRD(vb_, 10); AT_MF(2, vb2, 1, pf_); AT_SB(); va3 = AT_VRD(vb_, 11); AT_MF(3, vb3, 1, pf_); AT_SB(); \
        vb0 = AT_VRD(vb_, 12); AT_MF(0, va0, 2, pf_); AT_SB(); vb1 = AT_VRD(vb_, 13); AT_MF(1, va1, 2, pf_); AT_SB(); vb2 = AT_VRD(vb_, 14); AT_MF(2, va2, 2, pf_); AT_SB(); vb3 = AT_VRD(vb_, 15); AT_MF(3, va3, 2, pf_); AT_SB(); \
        AT_MF(0, vb0, 3, pf_); AT_MF(1, vb1, 3, pf_); AT_MF(2, vb2, 3, pf_); AT_MF(3, vb3, 3, pf_); AT_SB(); } while (0)
    AT_WAIT_BAR();
    int s_prev = 0, s_cur = 1, s_next = 2;
    bf16x8 kf[8]; f32x16 sc[2];
#define AT_MFMA(a_, b_, c_) __builtin_amdgcn_mfma_f32_32x32x16_bf16(a_, b_, c_, 0, 0, 0)
#define AT_KRD(stage_) do { const LAS unsigned char* kb_ = lds + (stage_) * AT_STG + kfo; _Pragma("unroll") for (int f = 0; f < 8; ++f) kf[f] = *(const LAS bf16x8*)(kb_ + (f >> 2) * 4096 + kpo[f & 3]); } while (0)
#define AT_QKC() do { AT_SB(); _Pragma("unroll") for (int d0 = 0; d0 < 4; ++d0) { sc[0] = AT_MFMA(kf[d0], qf[d0], sc[0]); sc[1] = AT_MFMA(kf[4 + d0], qf[d0], sc[1]); } AT_SB(); } while (0)
#define AT_QK() do { if (!__any(mrun != 0.f)) { _Pragma("unroll") for (int r = 0; r < 16; ++r) { sc[0][r] = 0.f; sc[1][r] = 0.f; } AT_QKC(); } \
                     else { _Pragma("unroll") for (int r = 0; r < 16; ++r) { sc[0][r] = -mrun; sc[1][r] = -mrun; } AT_QKC(); } } while (0)
#define AT_PACK() do { _Pragma("unroll") for (int kh = 0; kh < 2; ++kh) _Pragma("unroll") for (int s2 = 0; s2 < 2; ++s2) { u32x4 pw; \
        pw.x = pk2(sc[kh][8 * s2 + 0], sc[kh][8 * s2 + 1]); pw.y = pk2(sc[kh][8 * s2 + 2], sc[kh][8 * s2 + 3]); pw.z = pk2(sc[kh][8 * s2 + 4], sc[kh][8 * s2 + 5]); pw.w = pk2(sc[kh][8 * s2 + 6], sc[kh][8 * s2 + 7]); \
        pprev[kh * 2 + s2] = __builtin_bit_cast(bf16x8, pw); } } while (0)
#define AT_E2(k_) do { sc[(k_) >> 3][2 * ((k_) & 7)] = __builtin_amdgcn_exp2f(sc[(k_) >> 3][2 * ((k_) & 7)]); sc[(k_) >> 3][2 * ((k_) & 7) + 1] = __builtin_amdgcn_exp2f(sc[(k_) >> 3][2 * ((k_) & 7) + 1]); } while (0)
#define AT_A2(k_) do { if ((k_) < 8) { a0 += sc[0][2 * ((k_) & 7)]; a0 += sc[0][2 * ((k_) & 7) + 1]; } else { a1 += sc[1][2 * ((k_) & 7)]; a1 += sc[1][2 * ((k_) & 7) + 1]; } } while (0)
#define AT_GAP(k_) do { AT_E2(k_); if ((k_) > 0) AT_A2((k_) > 0 ? (k_) - 1 : 0); asm volatile("" : "+v"(sc[(k_) >> 3]), "+v"(a0), "+v"(a1)); AT_SB(); } while (0)
#define AT_PVX(stage_, pf_) do { const LAS unsigned char* vb_ = lds + (stage_) * AT_STG + vfo; AT_SB(); \
        vb0 = AT_VRD(vb_, 4);  AT_MF(0, va0, 0, pf_); AT_GAP(0);  vb1 = AT_VRD(vb_, 5);  AT_MF(1, va1, 0, pf_); AT_GAP(1);  vb2 = AT_VRD(vb_, 6);  AT_MF(2, va2, 0, pf_); AT_GAP(2);  vb3 = AT_VRD(vb_, 7);  AT_MF(3, va3, 0, pf_); AT_GAP(3); \
        va0 = AT_VRD(vb_, 8);  AT_MF(0, vb0, 1, pf_); AT_GAP(4);  va1 = AT_VRD(vb_, 9);  AT_MF(1, vb1, 1, pf_); AT_GAP(5);  va2 = AT_VRD(vb_, 10); AT_MF(2, vb2, 1, pf_); AT_GAP(6);  va3 = AT_VRD(vb_, 11); AT_MF(3, vb3, 1, pf_); AT_GAP(7); \
        vb0 = AT_VRD(vb_, 12); AT_MF(0, va0, 2, pf_); AT_GAP(8);  vb1 = AT_VRD(vb_, 13); AT_MF(1, va1, 2, pf_); AT_GAP(9);  vb2 = AT_VRD(vb_, 14); AT_MF(2, va2, 2, pf_); AT_GAP(10); vb3 = AT_VRD(vb_, 15); AT_MF(3, va3, 2, pf_); AT_GAP(11); \
        AT_MF(0, vb0, 3, pf_); AT_GAP(12); AT_MF(1, vb1, 3, pf_); AT_GAP(13); AT_MF(2, vb2, 3, pf_); AT_GAP(14); AT_MF(3, vb3, 3, pf_); AT_GAP(15); AT_A2(15); } while (0)
    {
        if (nt > 1) AT_DMA(1, 1);
        AT_KRD(0); AT_QK();
        float mx = fmaxf(sc[0][0], sc[1][0]);
#pragma unroll
        for (int r = 1; r < 16; ++r) mx = fmaxf(mx, fmaxf(sc[0][r], sc[1][r]));
        mx = swap32_max(mx);
        const float dl = fabsf(mx) > 16.f ? mx : 0.f;
        mrun = dl;
        float ps = 0.f;
#pragma unroll
        for (int kh = 0; kh < 2; ++kh)
#pragma unroll
            for (int r = 0; r < 16; ++r) { const float e = __builtin_amdgcn_exp2f(sc[kh][r] - dl); sc[kh][r] = e; ps += e; }
        lrun = ps;
        AT_PACK();
        AT_PVPRE(0);
        AT_WAIT_BAR();
    }
    for (int t = 1; t < nt; ++t) {
        if (t + 1 < nt) AT_DMA(t + 1, s_next);
        AT_KRD(s_cur);
        AT_QK();
        float a0 = 0.f, a1 = 0.f;
        AT_PVX(s_prev, pprev);
        float ps = a0 + a1;
        const float pst = swap32_sum(ps);
        if (__any(!(pst < AT_TRIG))) {
            AT_QK();
            float mx = fmaxf(sc[0][0], sc[1][0]);
#pragma unroll
            for (int r = 1; r < 16; ++r) mx = fmaxf(mx, fmaxf(sc[0][r], sc[1][r]));
            mx = swap32_max(mx);
            const float dl = !(pst < AT_TRIG) ? mx : 0.f;
            mrun += dl;
            const float alpha = __builtin_amdgcn_exp2f(-dl);
            lrun *= alpha;
            ps = 0.f;
#pragma unroll
            for (int kh = 0; kh < 2; ++kh)
#pragma unroll
                for (int r = 0; r < 16; ++r) { const float e = __builtin_amdgcn_exp2f(sc[kh][r] - dl); sc[kh][r] = e; ps += e; }
#pragma unroll
            for (int i = 0; i < 4; ++i)
#pragma unroll
                for (int r = 0; r < 16; ++r) ot[i][r] *= alpha;
        }
        lrun += ps;
        AT_PACK();
        AT_PVPRE(s_cur);
        AT_WAIT_BAR();
        { const int tmp = s_prev; s_prev = s_cur; s_cur = s_next; s_next = tmp; }
    }
    AT_PV(s_prev, pprev);
#undef AT_PVX
#undef AT_GAP
#undef AT_A2
#undef AT_E2
#undef AT_PACK
#undef AT_QK
#undef AT_QKC
#undef AT_KRD
#undef AT_MFMA
    __syncthreads();
#undef AT_PV
#undef AT_PVPRE
#undef AT_MF
#undef AT_VRD
    const float ltot = swap32_sum(lrun);
    const float lam = ((const float*)(p.ws + WS_LAM))[layer];
    const float inv = comp ? lam / ltot : 1.0f / ltot;
    LAS float* xb = (LAS float*)lds;
    if (comp) {
#pragma unroll
        for (int i = 0; i < 4; ++i)
#pragma unroll
            for (int r = 0; r < 16; ++r) xb[(qw * 64 + i * 16 + r) * 64 + lane] = ot[i][r] * inv;
    }
    __syncthreads();
    if (!comp) {
        float ss = 0.f;
#pragma unroll
        for (int i = 0; i < 4; ++i)
#pragma unroll
            for (int r = 0; r < 16; ++r) { const float o = ot[i][r] * inv - xb[(qw * 64 + i * 16 + r) * 64 + lane]; ot[i][r] = o; ss += o * o; }
        ss = swap32_sum(ss);
        const float lam_init = 0.8f - 0.6f * __expf(-0.3f * (float)layer);
        const float rs = rsqrtf(ss * (1.0f / 128.0f) + EPS_SUBLN) * (1.0f - lam_init);
        const float* sg = p.in[I_SUBG] + layer * VD;
        bf16* op = br + (size_t)(qrow0 + qw * 32 + r32) * DM + 1024 + h * 128;
#pragma unroll
        for (int i = 0; i < 4; ++i)
#pragma unroll
            for (int g4 = 0; g4 < 4; ++g4) { const int dv = 32 * i + 8 * g4 + 4 * hi; const f32x4 gg = *(const f32x4*)(sg + dv);
                u32x2 w; w.x = pk2(ot[i][4 * g4 + 0] * rs * gg[0], ot[i][4 * g4 + 1] * rs * gg[1]); w.y = pk2(ot[i][4 * g4 + 2] * rs * gg[2], ot[i][4 * g4 + 3] * rs * gg[3]);
                *(u32x2*)(op + dv) = w; }
    }
    __syncthreads();
#undef AT_DMA
#undef AT_GLDS
#undef AT_WAIT_BAR
}
__device__ __forceinline__ void attn_phase(const Params& p, const Ctx& F, int layer) {
    const int nunit = layer + 1 < DEPTH ? 512 + 32 : 512;
    for (int u = F.vcu; u < nunit; u += F.G) {
        if (u < 512) { const int bh = u >> 5, qb = u & 31, b = bh >> 3, h = bh & 7; attn_unit(p, F, layer, b, h, b * SEQ + qb * 128, LK); }
        else { const int v = u - 512, bh = v >> 1, qb = v & 1, b = bh >> 3, h = bh & 7; attn_unit(p, F, layer, b, h, ML + b * CTXL + qb * 128, CTXL); }
    }
}

constexpr int FM_PITCH = 288, FM_WA = 0, FM_WC = 128 * FM_PITCH, FM_IMG = FM_WC + 64 * FM_PITCH, FM_IMGB = 64 * FM_PITCH;
__device__ __forceinline__ void fmix_phase(const Params& p, const Ctx& F0) {
    const Ctx F = fresh(F0);
    LAS unsigned char* lds = F.lds;
    const bf16* T = (const bf16*)(p.ws + WS_T); bf16* br = (bf16*)(p.ws + WS_BR); const float2* tw = (const float2*)(p.ws + WS_FTW);
    for (int idx = F.tid; idx < 128 * 16; idx += NTHR) { const int r = idx >> 4, ch = idx & 15; *(LAS u32x4*)(lds + FM_WA + r * FM_PITCH + ch * 16) = *(const u32x4*)((const bf16*)(p.ws + WS_FWA) + r * 128 + ch * 8); }
    for (int idx = F.tid; idx < 64 * 16; idx += NTHR) { const int r = idx >> 4, ch = idx & 15; *(LAS u32x4*)(lds + FM_WC + r * FM_PITCH + ch * 16) = *(const u32x4*)((const bf16*)(p.ws + WS_FWC) + r * 128 + ch * 8); }
    const int c = F.wave >> 1, h = F.wave & 1, l15 = F.lane & 15, kq = F.lane >> 4;
    LAS unsigned char* img = lds + FM_IMG + c * FM_IMGB;
    for (int u = F.vcu; u < 256; u += F.G) {
        const int batch = u >> 7, n0 = (u & 127) * 4;
        __syncthreads();
#pragma unroll
        for (int it = 0; it < 8; ++it) { const int cc = it >> 1, part = it & 1, a = F.lane, bg = F.wave;
            const u32x4 w = *(const u32x4*)(T + ((size_t)(batch * 512 + n0 + cc) * (2 * SEQ) + part * SEQ + 64 * a + 8 * bg));
            LAS bf16* d = (LAS bf16*)(lds + FM_IMG + cc * FM_IMGB + (8 * bg) * FM_PITCH + (part * 64 + a) * 2);
            const unsigned ww[4] = {w.x, w.y, w.z, w.w};
#pragma unroll
            for (int e = 0; e < 8; ++e) d[e * (FM_PITCH / 2)] = (bf16)((ww[e >> 1] >> ((e & 1) * 16)) & 0xffffu); }
        __syncthreads();
        f32x4 ya[4][4];
#pragma unroll
        for (int mi = 0; mi < 4; ++mi)
#pragma unroll
            for (int nt = 0; nt < 4; ++nt) ya[mi][nt] = (f32x4){0.f, 0.f, 0.f, 0.f};
#pragma unroll
        for (int ks = 0; ks < 4; ++ks) {
            bf16x8 af[4], bfr[4];
#pragma unroll
            for (int mi = 0; mi < 4; ++mi) { const int mt = (mi >> 1) * 4 + 2 * h + (mi & 1); af[mi] = *(const LAS bf16x8*)(lds + FM_WA + (16 * mt + l15) * FM_PITCH + (32 * ks + 8 * kq) * 2); }
#pragma unroll
            for (int nt = 0; nt < 4; ++nt) bfr[nt] = *(const LAS bf16x8*)(img + (16 * nt + l15) * FM_PITCH + (32 * ks + 8 * kq) * 2);
#pragma unroll
            for (int mi = 0; mi < 4; ++mi)
#pragma unroll
                for (int nt = 0; nt < 4; ++nt) ya[mi][nt] = __builtin_amdgcn_mfma_f32_16x16x32_bf16(af[mi], bfr[nt], ya[mi][nt], 0, 0, 0);
        }
        __syncthreads();
#pragma unroll
        for (int mi = 0; mi < 2; ++mi)
#pragma unroll
            for (int nt = 0; nt < 4; ++nt)
#pragma unroll
                for (int r = 0; r < 4; ++r) { const int ap = 16 * (2 * h + mi) + 4 * kq + r, b = 16 * nt + l15; const float2 cs = tw[ap * b];
                    const float yre = ya[mi][nt][r], yim = ya[2 + mi][nt][r];
                    LAS bf16* d = (LAS bf16*)(img + ap * FM_PITCH + b * 2);
                    d[0] = (bf16)f2bf(yre * cs.x + yim * cs.y); d[64] = (bf16)f2bf(yim * cs.x - yre * cs.y); }
        __syncthreads();
        f32x4 xa[2][4];
#pragma unroll
        for (int mi = 0; mi < 2; ++mi)
#pragma unroll
            for (int nt = 0; nt < 4; ++nt) xa[mi][nt] = (f32x4){0.f, 0.f, 0.f, 0.f};
#pragma unroll
        for (int ks = 0; ks < 4; ++ks) {
            bf16x8 af[2], bfr[4];
#pragma unroll
            for (int mi = 0; mi < 2; ++mi) af[mi] = *(const LAS bf16x8*)(img + (16 * (2 * h + mi) + l15) * FM_PITCH + (32 * ks + 8 * kq) * 2);
#pragma unroll
            for (int nt = 0; nt < 4; ++nt) bfr[nt] = *(const LAS bf16x8*)(lds + FM_WC + (16 * nt + l15) * FM_PITCH + (32 * ks + 8 * kq) * 2);
#pragma unroll
            for (int mi = 0; mi < 2; ++mi)
#pragma unroll
                for (int nt = 0; nt < 4; ++nt) xa[mi][nt] = __builtin_amdgcn_mfma_f32_16x16x32_bf16(af[mi], bfr[nt], xa[mi][nt], 0, 0, 0);
        }
        __syncthreads();
        LAS bf16* xs = (LAS bf16*)(lds + FM_IMG);
#pragma unroll
        for (int mi = 0; mi < 2; ++mi)
#pragma unroll
            for (int nt = 0; nt < 4; ++nt)
#pragma unroll
                for (int r = 0; r < 4; ++r) { const int ap = 16 * (2 * h + mi) + 4 * kq + r, bp = 16 * nt + l15; xs[(ap + 64 * bp) * 4 + c] = (bf16)f2bf(xa[mi][nt][r]); }
        __syncthreads();
#pragma unroll
        for (int it = 0; it < 8; ++it) { const int lp = F.tid + NTHR * it; *(u32x2*)(br + (size_t)(batch * SEQ + lp) * DM + n0) = *(const LAS u32x2*)(xs + lp * 4); }
    }
    __syncthreads();
}

constexpr int CG_STG = 32768, CG_B = 16384;
template <int MODE> __device__ __forceinline__ void ctx_gemm(const Params& p, const Ctx& F0, int layer) {
    const Ctx F = fresh(F0);
    const bf16* A; const bf16* Bt; int lda, K;
    if (MODE == 0) { A = (const bf16*)(p.ws + WS_BR); Bt = wl(p, layer, W_BM); lda = DM; K = DM; }
    else if (MODE == 1) { A = (const bf16*)(p.ws + WS_MRG); Bt = wl(p, layer, W_OUT); lda = DM; K = DM; }
    else if (MODE == 2) { A = (const bf16*)(p.ws + WS_ACT); Bt = wl(p, layer, W_DOWN); lda = DFF; K = DFF; }
    else { A = (const bf16*)(p.ws + WS_DC); Bt = (const bf16*)(p.ws + WS_TC); lda = 2 * CTXL; K = 2 * CTXL; }
    const int NU = MODE == 3 ? 64 : 256;
    const int ldb = lda, fr = F.lane & 15, fq = F.lane >> 4, nch = K / 128;
    LAS unsigned char* lds = F.lds;
    const int rb = F.wave >> 1, cb0 = 2 * (F.wave & 1);
    const int dr = 8 * F.wave + (F.lane >> 4), dp = F.lane & 15;
    for (int u = F.vcu; u < NU; u += F.G) {
        int row0 = ML + (u & 7) * 64, col0 = ((u >> 5) * 4 + ((u >> 3) & 3)) * 64;
        size_t arow = (size_t)row0, brow = (size_t)col0;
        if (MODE == 3) { const int b3 = u >> 5, rk = (u >> 3) & 3, ck = u & 7; row0 = ML + b3 * CTXL + rk * 64; col0 = ck * 64; arow = (size_t)rk * 64; brow = (size_t)b3 * 512 + ck * 64; }
        const bf16* ga0 = A + (size_t)(arow + dr) * lda + ((dp ^ (dr & 15)) << 3); const bf16* ga1 = A + (size_t)(arow + dr + 4) * lda + ((dp ^ ((dr + 4) & 15)) << 3);
        const bf16* gb0 = Bt + (size_t)(brow + dr) * ldb + ((dp ^ (dr & 15)) << 3); const bf16* gb1 = Bt + (size_t)(brow + dr + 4) * ldb + ((dp ^ ((dr + 4) & 15)) << 3);
#define CG_DMA(t) do { LAS unsigned char* d_ = lds + ((t) & 3) * CG_STG + F.wave * 2048; const int ko_ = (t) * 128; \
        __builtin_amdgcn_global_load_lds((const unsigned*)(ga0 + ko_), (LAS unsigned*)(d_), 16, 0, 0); __builtin_amdgcn_global_load_lds((const unsigned*)(ga1 + ko_), (LAS unsigned*)(d_ + 1024), 16, 0, 0); \
        __builtin_amdgcn_global_load_lds((const unsigned*)(gb0 + ko_), (LAS unsigned*)(d_ + CG_B), 16, 0, 0); __builtin_amdgcn_global_load_lds((const unsigned*)(gb1 + ko_), (LAS unsigned*)(d_ + CG_B + 1024), 16, 0, 0); } while (0)
        asm volatile("s_waitcnt vmcnt(0) lgkmcnt(0)\n\ts_barrier" ::: "memory");
        const int nsc = nch / 2;
        CG_DMA(0); CG_DMA(1);
        f32x4 acc[2] = {{0.f, 0.f, 0.f, 0.f}, {0.f, 0.f, 0.f, 0.f}}, tot[2] = {{0.f, 0.f, 0.f, 0.f}, {0.f, 0.f, 0.f, 0.f}};
        asm volatile("s_waitcnt vmcnt(0)\n\ts_barrier" ::: "memory");
        const int ao = (16 * rb + fr) * 256, bo = CG_B + (16 * cb0 + fr) * 256;
        for (int sc = 0; sc < nsc; ++sc) {
            if (sc + 1 < nsc) { CG_DMA(2 * sc + 2); CG_DMA(2 * sc + 3); }
#pragma unroll
            for (int hh = 0; hh < 2; ++hh) {
                const LAS unsigned char* sb = lds + ((2 * sc + hh) & 3) * CG_STG;
#pragma unroll
                for (int ks = 0; ks < 4; ++ks) { const int po = ((4 * ks + fq) ^ fr) << 4;
                    const bf16x8 af = *(const LAS bf16x8*)(sb + ao + po), b0 = *(const LAS bf16x8*)(sb + bo + po), b1 = *(const LAS bf16x8*)(sb + bo + 16 * 256 + po);
                    acc[0] = __builtin_amdgcn_mfma_f32_16x16x32_bf16(b0, af, acc[0], 0, 0, 0); acc[1] = __builtin_amdgcn_mfma_f32_16x16x32_bf16(b1, af, acc[1], 0, 0, 0); }
            }
            if (MODE == 0 && (sc == 1 || sc == 3 || sc == 7)) {
                const int goff = sc == 1 ? 0 : (sc == 3 ? DM : 2 * DM);
#pragma unroll
                for (int j = 0; j < 2; ++j) { const unsigned gw = *(const unsigned*)((const unsigned char*)(p.ws + WS_G8) + (size_t)(row0 + 16 * rb + fr) * NG8 + goff + col0 + 16 * (cb0 + j) + 4 * fq);
#pragma unroll
                    for (int i = 0; i < 4; ++i) { tot[j][i] += ((float)((gw >> (8 * i)) & 255u) * (1.0f / 255.0f)) * acc[j][i]; acc[j][i] = 0.f; } }
            }
            asm volatile("s_waitcnt vmcnt(0) lgkmcnt(0)\n\ts_barrier" ::: "memory");
        }
#undef CG_DMA
#pragma unroll
        for (int j = 0; j < 2; ++j) { const int row = row0 + 16 * rb + fr, col = col0 + 16 * (cb0 + j) + 4 * fq;
            if (MODE == 0) { u32x2 w; w.x = pk2(tot[j][0], tot[j][1]); w.y = pk2(tot[j][2], tot[j][3]); *(u32x2*)((bf16*)(p.ws + WS_MRG) + (size_t)row * DM + col) = w; }
            else if (MODE == 3) { u32x2 w; w.x = pk2(acc[j][0], acc[j][1]); w.y = pk2(acc[j][2], acc[j][3]); *(u32x2*)((bf16*)(p.ws + WS_BR) + (size_t)row * DM + col) = w; }
            else { const f32x4 gt = *(const f32x4*)((const float*)(p.ws + WS_MOD) + ((size_t)layer * 3 + 2) * NMOD + (MODE == 1 ? 2 * DM : 5 * DM) + col);
                bf16* hp = (bf16*)(p.ws + WS_H) + (size_t)row * DM + col;
                f32x4 sv;
                if (MODE == 1 && layer == 0) sv = *(const f32x4*)(p.in[I_CTX] + (size_t)(row - ML) * DM + col);
                else { const u32x2 hw = *(const u32x2*)hp; sv = (f32x4){bflo(hw.x), bfhi(hw.x), bflo(hw.y), bfhi(hw.y)}; }
                const f32x4 r = sv + gt * acc[j];
                u32x2 w; w.x = pk2(r[0], r[1]); w.y = pk2(r[2], r[3]); *(u32x2*)hp = w; } }
    }
    asm volatile("s_waitcnt vmcnt(0) lgkmcnt(0)" ::: "memory");
    __syncthreads();
}

constexpr int STEPS_PER_LAYER = 10, N_STEPS = 1 + DEPTH * STEPS_PER_LAYER + 1;
enum { SK_GEMM = 1, SK_ATTN = 2 };
struct Args { Params p; int lo, hi, li, skip; };
template <class E> __device__ __forceinline__ void run_gemm(const Ctx& F, const GemmJob& j, const E& e, int rot) {
    int c = (int)((blockIdx.x + (unsigned)rot) % (unsigned)F.G); asm volatile("" : "+s"(c));
    pg8::Sched S; S.init(j, F.G, c);
    int wv = F.wave; asm volatile("" : "+s"(wv));
    pg8::gemm_phase<E>(F.lds, j, S, e, wv);
}
__global__ void __launch_bounds__(NTHR, 2) mega(Args a) {
    extern __shared__ __attribute__((aligned(16))) unsigned char lds_raw[];
    Ctx F; F.lds = (LAS unsigned char*)lds_raw; F.tid = threadIdx.x; F.lane = F.tid & 63; F.wave = __builtin_amdgcn_readfirstlane(F.tid >> 6);
    F.G = gridDim.x; { const int bx = blockIdx.x; F.vcu = (F.G % 8 == 0) ? (bx % 8) * (F.G / 8) + bx / 8 : bx; }
    const Params& p = a.p;
    volatile LAS unsigned* MISC = (volatile LAS unsigned*)(F.lds + MISC_OFF);
    if (F.tid < 64) MISC[F.tid] = 0u;
    __syncthreads();
    XcdBarrier bar; bar.bar = (unsigned*)(p.ws + WS_CTL) + CW_BAR + a.li * 4096; bar.x = 0; bar.st = MISC + 8;
    if (a.hi - a.lo > 1) bar = xcd_barrier_post(bar.bar, MISC + 8);
    const int lo = a.lo, hi = a.hi;
    const bool do_gemm = !(a.skip & SK_GEMM), do_attn = !(a.skip & SK_ATTN);
#define IN(k) (lo <= (k) && (k) < hi)
#define SEAM(k) do { if (IN(k) && IN((k) + 1)) xcd_barrier(bar); } while (0)
#define REPEAT(k, body) do { _Pragma("nounroll") for (int r_ = 0; r_ < ((PROBE_STEP == (k)) ? 1 + PROBE_REP : 1); ++r_) { const bool first_ = (r_ == 0); (void)first_; body; if (r_ + 1 < ((PROBE_STEP == (k)) ? 1 + PROBE_REP : 1)) xcd_barrier(bar); } } while (0)
    if (IN(0)) REPEAT(10, { prologue(p, F); __syncthreads(); });
    SEAM(0);
    for (int l = 0; l < DEPTH; ++l) {
        const int s0 = 1 + l * STEPS_PER_LAYER;
        if (IN(s0 + 0)) REPEAT(0, norm_mod_phase(p, F, l, 0));
        SEAM(s0 + 0);
        if (IN(s0 + 1) && do_gemm) REPEAT(1, run_gemm(F, job_win(p, l), EWin{(bf16*)(p.ws + WS_P), (unsigned char*)(p.ws + WS_G8)}, 0));
        SEAM(s0 + 1);
        if (IN(s0 + 2)) REPEAT(2, {
            mixer_prep_phase(p, F, l); __syncthreads();
            if (do_gemm) { run_gemm(F, job_f1(p, false), epi_f1(p, false), 0); run_gemm(F, job_f1(p, true), epi_f1(p, true), F.G - 128); }
        });
        SEAM(s0 + 2);
        if (IN(s0 + 3)) {
#if MK_FFT
            REPEAT(30, { if (do_gemm) { fmix_phase(p, F); if (l + 1 < DEPTH) ctx_gemm<3>(p, F, l); } });
#else
            REPEAT(30, { if (do_gemm) { run_gemm(F, job_f2(p, false), epi_f2(p, false), 0); run_gemm(F, job_f2(p, true), epi_f2(p, true), F.G - 64); } });
#endif
            REPEAT(31, { if (do_attn) attn_phase(p, F, l); });
        }
        SEAM(s0 + 3);
        if (IN(s0 + 4) && do_gemm) REPEAT(4, { run_gemm(F, job_merge1(p, l), EMerge1{(const unsigned char*)(p.ws + WS_G8), (bf16*)(p.ws + WS_MRG)}, 0); if (l + 1 < DEPTH) ctx_gemm<0>(p, F, l); });
        SEAM(s0 + 4);
        if (IN(s0 + 5) && do_gemm) REPEAT(5, { if (first_) { run_gemm(F, job_out(p, l, ML), epi_resid(p, l, 0), 0); if (l + 1 < DEPTH) ctx_gemm<1>(p, F, l); } else run_gemm(F, job_out(p, l, ML), EStore{(bf16*)(p.ws + WS_MACC), DM, 0, 0}, 0); });
        SEAM(s0 + 5);
        if (IN(s0 + 6)) REPEAT(6, norm_mod_phase(p, F, l, 1));
        SEAM(s0 + 6);
#if MK_FUSE_ACT
        if (IN(s0 + 7) && do_gemm) REPEAT(7, run_gemm(F, job_up(p, l), EUpAct{(bf16*)(p.ws + WS_ACT), p.in[I_FCONVW] + (size_t)l * 3 * NUP, (float*)(p.ws + WS_HALO), (LAS float*)(F.lds + MISC_OFF + 1024)}, 0));
#else
        if (IN(s0 + 7) && do_gemm) REPEAT(7, run_gemm(F, job_up(p, l), epi_p(p), 0));
#endif
        SEAM(s0 + 7);
#if MK_FUSE_ACT
        if (IN(s0 + 8)) REPEAT(8, act_fix_phase(p, F, l));
#else
        if (IN(s0 + 8)) REPEAT(8, ffn_act_phase(p, F, l));
#endif
        SEAM(s0 + 8);
        if (IN(s0 + 9) && do_gemm) REPEAT(9, { if (first_) { run_gemm(F, job_down(p, l, ML), epi_resid(p, l, 1), 0); if (l + 1 < DEPTH) ctx_gemm<2>(p, F, l); } else run_gemm(F, job_down(p, l, ML), EStore{(bf16*)(p.ws + WS_MACC), DM, 0, 0}, 0); });
        SEAM(s0 + 9);
    }
    if (IN(N_STEPS - 1)) final_norm_phase(p, F);
#undef REPEAT
#undef IN
#undef SEAM
}

extern "C" void kernel_launch(void* const* d_in, const int* in_sizes, int n_in, void* d_out, int out_size, void* d_ws, size_t ws_size, hipStream_t stream) {
    static int grid = 0;
    if (grid == 0) {
        if (n_in != 20 || out_size != ML * DM || ws_size < WS_END) { fprintf(stderr, "kernel_launch: unexpected shapes (n_in %d out %d ws %zu)\n", n_in, out_size, ws_size); grid = -1; return; }
        int dev = 0, cus = 0, per_cu = 0;
        if (hipGetDevice(&dev) != hipSuccess || hipDeviceGetAttribute(&cus, hipDeviceAttributeMultiprocessorCount, dev) != hipSuccess) { grid = -1; return; }
        if (hipFuncSetAttribute((const void*)mega, hipFuncAttributeMaxDynamicSharedMemorySize, LDS_BYTES) != hipSuccess) { fprintf(stderr, "kernel_launch: hipFuncSetAttribute failed\n"); grid = -1; return; }
        if (hipOccupancyMaxActiveBlocksPerMultiprocessor(&per_cu, (const void*)mega, NTHR, LDS_BYTES) != hipSuccess || per_cu < 1) fprintf(stderr, "kernel_launch: occupancy query says %d\n", per_cu);
        (void)hipGetLastError();
        grid = cus;
    }
    if (grid < 0) return;
    (void)hipMemsetAsync((char*)d_ws + WS_CTL, 0, CTL_BYTES, stream);
    Args a{};
    for (int i = 0; i < 20; ++i) a.p.in[i] = (const float*)d_in[i];
    a.p.out = (float*)d_out; a.p.ws = (unsigned char*)d_ws;
    const Params& p = a.p;
#if MK_ONE_LAUNCH
    a.lo = 0; a.hi = N_STEPS; a.li = 0; a.skip = 0;
    hipLaunchKernelGGL(mega, dim3(grid), dim3(NTHR), LDS_BYTES, stream, a);
#else
    a.skip = (MK_SIMPLE_GEMM ? SK_GEMM : 0) | (MK_SIMPLE_ATTN ? SK_ATTN : 0);
    int li = 0;
    for (int s = 0; s < N_STEPS; ++s) {
        a.lo = s; a.hi = s + 1; a.li = li++;
        const int l = (s - 1) / STEPS_PER_LAYER, k = (s - 1) % STEPS_PER_LAYER;
        const bool layer_step = s >= 1 && s < N_STEPS - 1;
        const bool pure_gemm = layer_step && (k == 1 || k == 4 || k == 5 || k == 7 || k == 9);
        if (!(pure_gemm && MK_SIMPLE_GEMM)) hipLaunchKernelGGL(mega, dim3(grid), dim3(NTHR), LDS_BYTES, stream, a);
        if (!layer_step) continue;
        if (MK_SIMPLE_GEMM) {
            if (k == 1) launch_sgemm(job_win(p, l), epi_p(p), stream);
            if (k == 2) { launch_sgemm(job_f1(p, false), epi_f1(p, false), stream); launch_sgemm(job_f1(p, true), epi_f1(p, true), stream); }
            if (k == 3) { launch_sgemm(job_f2(p, false), epi_f2(p, false), stream); launch_sgemm(job_f2(p, true), epi_f2(p, true), stream); }
            if (k == 4) for (int pass = 0; pass < 3; ++pass) launch_sgemm(job_merge(p, l, pass), epi_merge(p, pass), stream);
            if (k == 5) launch_sgemm(job_out(p, l), epi_resid(p, l, 0), stream);
            if (k == 7) launch_sgemm(job_up(p, l), epi_p(p), stream);
            if (k == 9) launch_sgemm(job_down(p, l), epi_resid(p, l, 1), stream);
        }
        if (MK_SIMPLE_ATTN && k == 3) hipLaunchKernelGGL(k_sattn, dim3(MROWS * NH), dim3(64), 0, stream, p, l);
    }
#endif
}
```
